# Optimizing an MI355X kernel written in HIP

```python
import jax, jax.numpy as jnp
from jax import lax
import numpy as np

D_MODEL = 1024
BATCH = 16
SEQ = 2048
DEPTH = 4

HEAD_DIM = 64
A_HEADS = 8
A_KV_HEADS = 2
B_GROUPS = ((128, 1), (512, 4), (2048, 16))
B_HEADS_PER_GROUP = 4
B_HEADS = len(B_GROUPS) * B_HEADS_PER_GROUP
GRID_W = 64
ROPE_THETA = 10000.0
Q_BLOCK = 128
N_EXPERTS = 16
N_GROUPS = 4
EXPERTS_PER_GROUP = N_EXPERTS // N_GROUPS
TOP_K = 2
D_EXPERT = 256
LN_EPS = 1e-5
RMS_EPS = 1e-6
DN_ALPHA = (2.0 * DEPTH) ** 0.25
DN_BETA = (8.0 * DEPTH) ** -0.25

A_Q = A_HEADS * HEAD_DIM
A_KV = A_KV_HEADS * HEAD_DIM
B_W = B_HEADS * HEAD_DIM
B_OUT = B_HEADS_PER_GROUP * HEAD_DIM
N_IN = A_Q + 2 * A_KV + 3 * B_W + 2 * D_MODEL
IN_SPLITS = (A_Q, A_Q + A_KV, A_Q + 2 * A_KV, A_Q + 2 * A_KV + B_W,
             A_Q + 2 * A_KV + 2 * B_W, A_Q + 2 * A_KV + 3 * B_W)

kernel_name = "hybrid_gqa_dilated_moe_encoder"


def _layer_norm(x, g=None, b=None):
    xf = x.astype(jnp.float32)
    mu = jnp.mean(xf, -1, keepdims=True)
    var = jnp.mean(jnp.square(xf - mu), -1, keepdims=True)
    y = (xf - mu) * lax.rsqrt(var + LN_EPS)
    if g is not None:
        y = y * g.astype(jnp.float32) + b.astype(jnp.float32)
    return y.astype(x.dtype)


def _rms_norm(x, g):
    xf = x.astype(jnp.float32)
    y = xf * lax.rsqrt(jnp.mean(jnp.square(xf), -1, keepdims=True) + RMS_EPS)
    return (y * g.astype(jnp.float32)).astype(x.dtype)


def _axial_rope_tables(seq):
    rows = seq // GRID_W
    row = jnp.repeat(jnp.arange(rows), GRID_W).astype(jnp.float32)
    col = jnp.tile(jnp.arange(GRID_W), rows).astype(jnp.float32)
    axis_dim = HEAD_DIM // 2
    inv = ROPE_THETA ** (-jnp.arange(0, axis_dim, 2, dtype=jnp.float32) / axis_dim)
    ang = jnp.concatenate([row[:, None] * inv, col[:, None] * inv], -1)
    return jnp.cos(ang), jnp.sin(ang)


def _apply_rope(x, cos, sin):
    xf = x.astype(jnp.float32).reshape(x.shape[:-1] + (HEAD_DIM // 2, 2))
    x0, x1 = xf[..., 0], xf[..., 1]
    c = cos[None, :, None, :]
    s = sin[None, :, None, :]
    out = jnp.stack([x0 * c - x1 * s, x0 * s + x1 * c], -1).reshape(x.shape)
    return out.astype(x.dtype)


def _alibi_slopes(n):
    return jnp.exp2(-8.0 * jnp.arange(1, n + 1, dtype=jnp.float32) / n)


def _global_gqa(q, k, v):
    b, s = q.shape[0], q.shape[1]
    rep = A_HEADS // A_KV_HEADS
    nblk = s // Q_BLOCK
    scale = HEAD_DIM ** -0.5
    qb = q.reshape(b, nblk, Q_BLOCK, A_KV_HEADS, rep, HEAD_DIM).transpose(1, 0, 2, 3, 4, 5)

    def block(qi):
        sc = jnp.einsum('bqgrd,bkgd->bgrqk', qi, k).astype(jnp.float32) * scale
        p = jax.nn.softmax(sc, axis=-1)
        return jnp.einsum('bgrqk,bkgd->bqgrd', p.astype(v.dtype), v)

    o = lax.map(block, qb)
    return o.transpose(1, 0, 2, 3, 4, 5).reshape(b, s, A_Q)


def _dilated_group(q, k, v, window, dilation, slopes):
    b, s, h = q.shape[0], q.shape[1], q.shape[2]
    reach = window // (2 * dilation)
    offs = dilation * jnp.arange(-reach, reach + 1)
    nblk = s // Q_BLOCK
    scale = HEAD_DIM ** -0.5
    qb = q.reshape(b, nblk, Q_BLOCK, h, HEAD_DIM).transpose(1, 0, 2, 3, 4)
    starts = jnp.arange(nblk) * Q_BLOCK
    bias = -slopes[:, None] * jnp.abs(offs).astype(jnp.float32)[None, :]

    def block(args):
        qi, t0 = args
        pos = t0 + jnp.arange(Q_BLOCK)[:, None] + offs[None, :]
        valid = (pos >= 0) & (pos < s)
        idx = jnp.clip(pos, 0, s - 1)
        kg = jnp.take(k, idx, axis=1)
        vg = jnp.take(v, idx, axis=1)
        sc = jnp.einsum('bqhd,bqkhd->bhqk', qi, kg).astype(jnp.float32) * scale + bias[None, :, None, :]
        sc = jnp.where(valid[None, None], sc, -jnp.inf)
        lse = jax.nn.logsumexp(sc, axis=-1)
        p = jnp.exp(sc - lse[..., None])
        o = jnp.einsum('bhqk,bqkhd->bqhd', p.astype(v.dtype), vg)
        return o, lse.transpose(0, 2, 1)

    o, lse = lax.map(block, (qb, starts))
    o = o.transpose(1, 0, 2, 3, 4).reshape(b, s, h, HEAD_DIM)
    lse = lse.transpose(1, 0, 2, 3).reshape(b, s, h)
    return o, lse


def _mixer(h, w_in, qn_g, kn_g, w_pa, w_pb, w_o, cos, sin, slopes):
    b, s, _ = h.shape
    proj = h @ w_in
    qa, ka, va, qd, kd, vd, gates = jnp.split(proj, IN_SPLITS, axis=-1)
    qa = _apply_rope(_rms_norm(qa.reshape(b, s, A_HEADS, HEAD_DIM), qn_g), cos, sin)
    ka = _apply_rope(_rms_norm(ka.reshape(b, s, A_KV_HEADS, HEAD_DIM), kn_g), cos, sin)
    va = va.reshape(b, s, A_KV_HEADS, HEAD_DIM)
    out_a = _global_gqa(qa, ka, va)
    qd = qd.reshape(b, s, B_HEADS, HEAD_DIM)
    kd = kd.reshape(b, s, B_HEADS, HEAD_DIM)
    vd = vd.reshape(b, s, B_HEADS, HEAD_DIM)
    outs, lses = [], []
    for g, (window, dilation) in enumerate(B_GROUPS):
        sl = slice(g * B_HEADS_PER_GROUP, (g + 1) * B_HEADS_PER_GROUP)
        o, l = _dilated_group(qd[:, :, sl], kd[:, :, sl], vd[:, :, sl], window, dilation, slopes[sl])
        outs.append(o)
        lses.append(l)
    wts = jax.nn.softmax(jnp.stack(lses, 0), axis=0)
    out_b = jnp.sum(wts[..., None].astype(h.dtype) * jnp.stack(outs, 0), 0).reshape(b, s, B_OUT)
    g_a, g_b = jnp.split(jax.nn.sigmoid(gates), 2, axis=-1)
    merged = g_a * (out_a @ w_pa) + g_b * (out_b @ w_pb)
    return merged @ w_o


def _moe(h, w_router, router_bias, w_gate, w_up, w_down):
    b, s, d = h.shape
    t = h.reshape(b * s, d)
    scores = jax.nn.sigmoid((t @ w_router).astype(jnp.float32))
    sel = scores + router_bias.astype(jnp.float32)
    grp_score = jnp.sum(lax.top_k(sel.reshape(-1, N_GROUPS, EXPERTS_PER_GROUP), TOP_K)[0], -1)
    best = jnp.argmax(grp_score, axis=-1)
    in_group = (jnp.arange(N_EXPERTS) // EXPERTS_PER_GROUP)[None, :] == best[:, None]
    _, idx = lax.top_k(jnp.where(in_group, sel, -jnp.inf), TOP_K)
    top_s = jnp.take_along_axis(scores, idx, axis=-1)
    gate = top_s / jnp.sum(top_s, -1, keepdims=True)
    combine = jnp.sum(jax.nn.one_hot(idx, N_EXPERTS, dtype=jnp.float32) * gate[..., None], 1)
    hg = jnp.einsum('td,edf->tef', t, w_gate)
    hu = jnp.einsum('td,edf->tef', t, w_up)
    act = jax.nn.silu(hg) * hu * combine[..., None].astype(t.dtype)
    y = jnp.einsum('tef,efd->td', act, w_down)
    return y.reshape(b, s, d)


def setup_inputs(seed: int = 0) -> dict:
    key = jax.random.key(seed)
    ks = jax.random.split(key, 24)
    f32 = jnp.float32
    n = lambda k, shape, sc: jax.random.normal(k, shape, f32) * sc
    d = D_MODEL
    return {
        "x": n(ks[0], (BATCH, SEQ, d), 1.0),
        "c": n(ks[1], (BATCH, d), 1.0),
        "w_ada": n(ks[2], (DEPTH, d, 6 * d), 0.5 * d ** -0.5),
        "b_ada": n(ks[3], (DEPTH, 6 * d), 0.02),
        "w_in": n(ks[4], (DEPTH, d, N_IN), d ** -0.5),
        "q_norm_g": 1.0 + n(ks[5], (DEPTH, HEAD_DIM), 0.02),
        "k_norm_g": 1.0 + n(ks[6], (DEPTH, HEAD_DIM), 0.02),
        "w_branch_a": n(ks[7], (DEPTH, A_Q, d), A_Q ** -0.5),
        "w_branch_b": n(ks[8], (DEPTH, B_OUT, d), B_OUT ** -0.5),
        "w_out": n(ks[9], (DEPTH, d, d), DN_BETA * d ** -0.5),
        "ln1_g": 1.0 + n(ks[10], (DEPTH, d), 0.02),
        "ln1_b": n(ks[11], (DEPTH, d), 0.02),
        "w_router": n(ks[12], (d, N_EXPERTS), d ** -0.5),
        "router_bias": n(ks[13], (N_EXPERTS,), 0.01),
        "w_exp_gate": n(ks[14], (DEPTH, N_EXPERTS, d, D_EXPERT), d ** -0.5),
        "w_exp_up": n(ks[15], (DEPTH, N_EXPERTS, d, D_EXPERT), d ** -0.5),
        "w_exp_down": n(ks[16], (DEPTH, N_EXPERTS, D_EXPERT, d), DN_BETA * D_EXPERT ** -0.5),
        "ln2_g": 1.0 + n(ks[17], (DEPTH, d), 0.02),
        "ln2_b": n(ks[18], (DEPTH, d), 0.02),
    }


def reference(x, c, w_ada, b_ada, w_in, q_norm_g, k_norm_g, w_branch_a, w_branch_b, w_out,
              ln1_g, ln1_b, w_router, router_bias, w_exp_gate, w_exp_up, w_exp_down, ln2_g, ln2_b):
    s = x.shape[1]
    cos, sin = _axial_rope_tables(s)
    slopes = _alibi_slopes(B_HEADS)
    cond = jax.nn.silu(c)
    for l in range(DEPTH):
        mod = cond @ w_ada[l] + b_ada[l]
        sh1, sc1, g1, sh2, sc2, g2 = [m[:, None, :] for m in jnp.split(mod, 6, axis=-1)]
        h = _layer_norm(x) * (1.0 + sc1) + sh1
        mix = _mixer(h, w_in[l], q_norm_g[l], k_norm_g[l], w_branch_a[l], w_branch_b[l],
                     w_out[l], cos, sin, slopes)
        x = _layer_norm(DN_ALPHA * x + g1 * mix, ln1_g[l], ln1_b[l])
        h = _layer_norm(x) * (1.0 + sc2) + sh2
        ffn = _moe(h, w_router, router_bias, w_exp_gate[l], w_exp_up[l], w_exp_down[l])
        x = _layer_norm(DN_ALPHA * x + g2 * ffn, ln2_g[l], ln2_b[l])
    return x
```

```cpp
#include <hip/hip_runtime.h>
#include <hip/hip_bf16.h>
#include <cstdio>
#include <cstdint>
#include <cmath>
__device__ __forceinline__ int hw_lane() { int l; asm volatile("v_mbcnt_lo_u32_b32 %0, -1, 0\n\tv_mbcnt_hi_u32_b32 %0, -1, %0" : "=v"(l)); return l; }
namespace pg8 {
#define PG8_LAS __attribute__((address_space(3)))
typedef unsigned short bf16_t;
typedef short bf16x8 __attribute__((ext_vector_type(8)));
typedef float f32x4 __attribute__((ext_vector_type(4)));
typedef unsigned u32x4 __attribute__((ext_vector_type(4)));
typedef unsigned u32x2 __attribute__((ext_vector_type(2)));
constexpr int BM = 256, BK = 64, HALF = 128, HTB = HALF * BK * 2  , STAGE_BYTES = 8 * HTB, NXCD = 8, WGM = 8;

__host__ __device__ __forceinline__ int lds_byte(int r, int c) { const int st = (r >> 4) * 2 + (c >> 5), rr = r & 15, cc = c & 31, ob = rr * 64 + cc * 2; return st * 1024 + (ob ^ (((ob >> 9) & 1) << 5)); }
__host__ __device__ __forceinline__ void stage_rc(int b, int& R, int& C) { const int st = b / 1024, sb = b % 1024, swz = sb ^ (((sb >> 9) & 1) << 5); R = (st >> 1) * 16 + swz / 64; C = (st & 1) * 32 + (swz % 64) / 2; }

struct Unit { int pm, pn, e, lt; };
struct Gemm { const bf16_t* A; const bf16_t* Bt; int M, N, K; };

struct StaticOrder {
    int nM, nN, nwg, G, c;
    __host__ __device__ void init(int M, int N, int G_, int c_) { nM = M / BM; nN = N / BM; nwg = nM * nN; G = G_; c = c_; }
    __host__ __device__ bool next(int i, Unit& u) const {
        const long L = (long)i * G + c; if (L >= nwg) return false;
        int wgid = (int)L; { const int q = nwg / NXCD, r = nwg % NXCD, xcd = wgid % NXCD, off = wgid / NXCD; wgid = (xcd < r ? xcd * (q + 1) : r * (q + 1) + (xcd - r) * q) + off; }
        const int nig = WGM * nN, gid = wgid / nig, fm = gid * WGM, gsz = (nM - fm) < WGM ? (nM - fm) : WGM;
        u.pm = fm + ((wgid % nig) % gsz); u.pn = (wgid % nig) / gsz; u.e = 0; u.lt = 0; return true;
    }
    __device__ __forceinline__ int arow(const Unit& u, int R) const { return u.pm * BM + R; }
};

__device__ __forceinline__ unsigned cvt_pk_bf16(float lo, float hi) { unsigned r; asm volatile("v_cvt_pk_bf16_f32 %0, %1, %2" : "=v"(r) : "v"(lo), "v"(hi)); return r; }

template <class Epi, class Sched, bool ALIGN_EPI, bool GATHER = false>
__device__ __forceinline__ void gemm_phase(PG8_LAS unsigned char* lds, const Gemm g, const Sched& S, const Epi& E, const int wave) {
    const int lane = hw_lane(), wid = wave, tid = wid * 64 + lane,
              wr = wid >> 2, wc = wid & 3, fr = lane & 15, fq = lane >> 4;
    const int K = g.K, nt = K / BK;
    unsigned voffB[2];
#pragma unroll
    for (int i = 0; i < 2; ++i) { int R_, C_; stage_rc(tid * 16 + i * 8192, R_, C_); voffB[i] = (unsigned)(R_ * K + C_) * 2u; }
    const size_t kstep = (size_t)(BK * 2);
    const size_t hstep = (size_t)HALF * K * 2;
    const size_t tstep = 2 * hstep;
    const unsigned ldsw = (unsigned)wid * 1024u;
    const int aoff = lds_byte(wr * 64 + fr, fq * 8), boff = lds_byte(wc * 32 + fr, fq * 8);
#define PG8_SA(b, h) (((b) * 2 + (h)) * HTB)
#define PG8_SB(b, h) ((4 + (b) * 2 + (h)) * HTB)
#define PG8_STAGE(bufoff, gbase, voff) do { _Pragma("unroll") for (int _i = 0; _i < 2; ++_i) \
        __builtin_amdgcn_global_load_lds((const unsigned*)((const char*)(gbase) + (voff)[_i]), (PG8_LAS unsigned*)(lds + (bufoff) + ldsw + _i * 8192), 16, 0, 0); } while (0)
#define PG8_LDA(dst, b, h) do { _Pragma("unroll") for (int m = 0; m < 4; ++m) _Pragma("unroll") for (int k = 0; k < 2; ++k) dst[m][k] = *(const PG8_LAS bf16x8*)(lds + PG8_SA(b, h) + aoff + m * 2048 + k * 1024); } while (0)
#define PG8_LDB(dst, b, h) do { _Pragma("unroll") for (int n = 0; n < 2; ++n) _Pragma("unroll") for (int k = 0; k < 2; ++k) dst[n][k] = *(const PG8_LAS bf16x8*)(lds + PG8_SB(b, h) + boff + n * 2048 + k * 1024); } while (0)
#define PG8_MMA(ai, bj, At, Bt) do { __builtin_amdgcn_s_setprio(1); _Pragma("unroll") for (int m = 0; m < 4; ++m) _Pragma("unroll") for (int n = 0; n < 2; ++n) _Pragma("unroll") for (int k = 0; k < 2; ++k) \
        acc[ai][bj][m][n] = __builtin_amdgcn_mfma_f32_16x16x32_bf16(Bt[n][k], At[m][k], acc[ai][bj][m][n], 0, 0, 0); __builtin_amdgcn_s_setprio(0); } while (0)
#define PG8_WAIT_V(n) asm volatile("s_waitcnt vmcnt(" #n ")" ::: "memory")
#define PG8_WAIT_L(n) asm volatile("s_waitcnt lgkmcnt(" #n ")" ::: "memory")
#define PG8_BAR __builtin_amdgcn_s_barrier()
#define PG8_SCHED __builtin_amdgcn_sched_barrier(0)
#define PG8_AOFF(dst, u) do { if constexpr (GATHER) { _Pragma("unroll") for (int _h = 0; _h < 2; ++_h) _Pragma("unroll") for (int _i = 0; _i < 2; ++_i) { int R_, C_; stage_rc(tid * 16 + _i * 8192, R_, C_); \
        dst[_h][_i] = (unsigned)S.arow(u, _h * HALF + R_) * (unsigned)(K * 2) + (unsigned)(C_ * 2); } } } while (0)
#define PG8_STAGE_A(bufoff, base, h, NXT) do { if constexpr (GATHER) { if (NXT) PG8_STAGE(bufoff, base, o2[h]); else PG8_STAGE(bufoff, base, voA[h]); } else { PG8_STAGE(bufoff, (base) + (h) * hstep, voffB); } } while (0)
    Unit cur, nxt; int ui = 0;
    if (!S.next(0, cur)) return;
    f32x4 acc[2][2][4][2];
#pragma unroll
    for (int a = 0; a < 2; ++a)
#pragma unroll
        for (int b = 0; b < 2; ++b)
#pragma unroll
            for (int m = 0; m < 4; ++m)
#pragma unroll
                for (int n = 0; n < 2; ++n) acc[a][b][m][n] = (f32x4){0.f, 0.f, 0.f, 0.f};
    bf16x8 At[4][2], B0[2][2], B1[2][2];
    unsigned voA[2][2], voN[2][2], o2[2][2];
    PG8_AOFF(voA, cur);
    const char* cA = GATHER ? (const char*)g.A : (const char*)g.A + (size_t)cur.pm * tstep;
    const char* cB = (const char*)g.Bt + (size_t)cur.pn * tstep;
    PG8_STAGE(PG8_SB(0, 0), cB, voffB); PG8_STAGE(PG8_SB(0, 1), cB + hstep, voffB); PG8_STAGE_A(PG8_SA(0, 0), cA, 0, 0); PG8_STAGE_A(PG8_SA(0, 1), cA, 1, 0);
    if (wr == 1) PG8_BAR;
    PG8_WAIT_V(2); PG8_BAR;
    PG8_STAGE(PG8_SB(1, 0), cB + kstep, voffB); PG8_STAGE_A(PG8_SA(1, 0), cA + kstep, 0, 0); PG8_STAGE(PG8_SB(1, 1), cB + hstep + kstep, voffB);
    PG8_WAIT_V(6); PG8_BAR;
    for (;;) {
        const bool has_next = S.next(ui + 1, nxt);
        if constexpr (GATHER) {
            if (has_next) { PG8_AOFF(voN, nxt); }
            else {
#pragma unroll
                for (int _h = 0; _h < 2; ++_h) { voN[_h][0] = voA[_h][0]; voN[_h][1] = voA[_h][1]; } } }
        const char* nA = (GATHER || !has_next) ? cA : (const char*)g.A + (size_t)nxt.pm * tstep;
        const char* nB = has_next ? (const char*)g.Bt + (size_t)nxt.pn * tstep : cB;
#pragma nounroll
        for (int t = 0; t < nt; t += 2) {
            const bool last = (t == nt - 2);
            const char* a1 = cA + (size_t)(t + 1) * kstep;
            const char* a2 = last ? nA : cA + (size_t)(t + 2) * kstep; const char* b2 = last ? nB : cB + (size_t)(t + 2) * kstep;
            const char* a3 = a2 + kstep; const char* b3 = b2 + kstep;
            if constexpr (GATHER) {
#pragma unroll
                for (int _h = 0; _h < 2; ++_h) { o2[_h][0] = last ? voN[_h][0] : voA[_h][0]; o2[_h][1] = last ? voN[_h][1] : voA[_h][1]; } }
            PG8_LDB(B0, 0, 0); PG8_LDB(B1, 0, 1); PG8_SCHED; PG8_LDA(At, 0, 0); PG8_STAGE_A(PG8_SA(1, 1), a1, 1, 0);
            PG8_WAIT_V(8); PG8_WAIT_L(0); PG8_BAR; PG8_MMA(0, 0, At, B0); PG8_MMA(0, 1, At, B1); PG8_BAR; PG8_SCHED;
            PG8_LDA(At, 0, 1); PG8_STAGE(PG8_SB(0, 0), b2, voffB); PG8_STAGE(PG8_SB(0, 1), b2 + hstep, voffB); PG8_STAGE_A(PG8_SA(0, 0), a2, 0, 1);
            PG8_WAIT_V(8); PG8_WAIT_L(0); PG8_BAR; PG8_MMA(1, 0, At, B0); PG8_MMA(1, 1, At, B1); PG8_BAR; PG8_SCHED;
            PG8_LDB(B0, 1, 0); PG8_LDB(B1, 1, 1); PG8_SCHED; PG8_LDA(At, 1, 0); PG8_STAGE_A(PG8_SA(0, 1), a2, 1, 1);
            PG8_WAIT_V(8); PG8_WAIT_L(0); PG8_BAR; PG8_MMA(0, 0, At, B0); PG8_MMA(0, 1, At, B1); PG8_BAR; PG8_SCHED;
            PG8_LDA(At, 1, 1); PG8_STAGE(PG8_SB(1, 0), b3, voffB); PG8_STAGE(PG8_SB(1, 1), b3 + hstep, voffB); PG8_STAGE_A(PG8_SA(1, 0), a3, 0, 1);
            PG8_WAIT_V(8); PG8_WAIT_L(0); PG8_BAR; PG8_MMA(1, 0, At, B0); PG8_MMA(1, 1, At, B1); PG8_BAR; PG8_SCHED;
        }
        if constexpr (ALIGN_EPI) { if (wr == 0) PG8_BAR; }
        E(acc, cur, wr, wc, fr, fq);
        if (!has_next) break;
#pragma unroll
        for (int a = 0; a < 2; ++a)
#pragma unroll
            for (int b = 0; b < 2; ++b)
#pragma unroll
                for (int m = 0; m < 4; ++m)
#pragma unroll
                    for (int n = 0; n < 2; ++n) acc[a][b][m][n] = (f32x4){0.f, 0.f, 0.f, 0.f};
        cur = nxt; cA = nA; cB = nB; ++ui;
        if constexpr (GATHER) {
#pragma unroll
            for (int _h = 0; _h < 2; ++_h) { voA[_h][0] = voN[_h][0]; voA[_h][1] = voN[_h][1]; } }
        if constexpr (ALIGN_EPI) { if (wr == 1) PG8_BAR; }
    }
    PG8_WAIT_V(0);
    if constexpr (!ALIGN_EPI) { if (wr == 0) PG8_BAR; }
    PG8_BAR;
#undef PG8_SA
#undef PG8_SB
#undef PG8_STAGE
#undef PG8_LDA
#undef PG8_LDB
#undef PG8_MMA
#undef PG8_WAIT_V
#undef PG8_WAIT_L
#undef PG8_BAR
#undef PG8_SCHED
#undef PG8_AOFF
#undef PG8_STAGE_A
}
}
constexpr int T_TOK = 32768, SEQ = 2048, DM = 1024, NB = 16, DEPTH = 4;
constexpr int N_IN = 5120, CAP = 32768;
constexpr float C2F = 0.125f * 1.4426950408889634f;
constexpr float DN_ALPHA = 1.681792830507429f;
constexpr float LN_EPS = 1e-5f, RMS_EPS = 1e-6f;

namespace pg8 {
__device__ __forceinline__ float bf2f(unsigned short b) { return __uint_as_float((unsigned)b << 16); }
__device__ __forceinline__ float bflo(unsigned w) { return __uint_as_float(w << 16); }
__device__ __forceinline__ float bfhi(unsigned w) { return __uint_as_float(w & 0xffff0000u); }
__device__ __forceinline__ float sigmoidf_(float x) { return __builtin_amdgcn_rcpf(1.f + __expf(-x)); }
__device__ __forceinline__ void store16(bf16_t* dst, const float (&v)[16]) {
    u32x4 w0, w1;
    w0.x = cvt_pk_bf16(v[0], v[1]); w0.y = cvt_pk_bf16(v[2], v[3]); w0.z = cvt_pk_bf16(v[4], v[5]); w0.w = cvt_pk_bf16(v[6], v[7]);
    w1.x = cvt_pk_bf16(v[8], v[9]); w1.y = cvt_pk_bf16(v[10], v[11]); w1.z = cvt_pk_bf16(v[12], v[13]); w1.w = cvt_pk_bf16(v[14], v[15]);
    *(u32x4*)dst = w0; *(u32x4*)(dst + 8) = w1;
}
__device__ __forceinline__ void load16bf(const bf16_t* src, float (&v)[16]) {
    const u32x4 w0 = *(const u32x4*)src, w1 = *(const u32x4*)(src + 8);
    v[0] = bflo(w0.x); v[1] = bfhi(w0.x); v[2] = bflo(w0.y); v[3] = bfhi(w0.y); v[4] = bflo(w0.z); v[5] = bfhi(w0.z); v[6] = bflo(w0.w); v[7] = bfhi(w0.w);
    v[8] = bflo(w1.x); v[9] = bfhi(w1.x); v[10] = bflo(w1.y); v[11] = bfhi(w1.y); v[12] = bflo(w1.z); v[13] = bfhi(w1.z); v[14] = bflo(w1.w); v[15] = bfhi(w1.w);
}
#define PG8_GATHER16(v, acc, ai, m) do { _Pragma("unroll") for (int _bj = 0; _bj < 2; ++_bj) _Pragma("unroll") for (int _n = 0; _n < 2; ++_n) _Pragma("unroll") for (int _j = 0; _j < 4; ++_j) \
        v[8 * _bj + 4 * _n + _j] = acc[ai][_bj][m][_n][_j]; } while (0)

__device__ __forceinline__ int pg_perm(int g, int s) { return g == 0 ? s : (g == 1 ? ((s & 3) * 512 + (s >> 2)) : ((s & 15) * 128 + (s >> 4))); }

struct EpiIn {
    bf16_t *QA, *KA, *VA, *QD, *KD, *VDT, *G;
    const float* qg; const float* kg;
    const float* rope;
    __device__ __forceinline__ void rms_rope(float (&v)[16], const float* gain, int s, int fq, float scale) const {
        float ss = 0.f;
#pragma unroll
        for (int e = 0; e < 16; ++e) ss += v[e] * v[e];
        ss += __shfl_xor(ss, 16); ss += __shfl_xor(ss, 32);
        const float rinv = 1.0f / sqrtf(ss * (1.0f / 64.0f) + RMS_EPS);
        const int a = (fq < 2) ? (s >> 6) : (s & 63);
        const f32x4* rp = (const f32x4*)(rope + (size_t)(a * 16 + 8 * (fq & 1)) * 2);
        const f32x4* gp = (const f32x4*)(gain + 16 * fq);
#pragma unroll
        for (int q = 0; q < 4; ++q) {
            const f32x4 cs = rp[q], gg = gp[q];
            const float x0 = v[4 * q] * rinv * gg[0], x1 = v[4 * q + 1] * rinv * gg[1], x2 = v[4 * q + 2] * rinv * gg[2], x3 = v[4 * q + 3] * rinv * gg[3];
            v[4 * q] = (x0 * cs[0] - x1 * cs[1]) * scale; v[4 * q + 1] = (x0 * cs[1] + x1 * cs[0]) * scale;
            v[4 * q + 2] = (x2 * cs[2] - x3 * cs[3]) * scale; v[4 * q + 3] = (x2 * cs[3] + x3 * cs[2]) * scale;
        }
    }
    __device__ __forceinline__ void operator()(const f32x4 (&acc)[2][2][4][2], const Unit& u, int wr, int wc, int fr, int fq) const {
        const int pn = u.pn;
        const int b = (u.pm * BM) >> 11;
#pragma unroll
        for (int ai = 0; ai < 2; ++ai)
#pragma unroll
            for (int m = 0; m < 4; ++m) {
                const int row = u.pm * BM + ai * HALF + wr * 64 + m * 16 + fr, s = row & (SEQ - 1);
                float v[16]; PG8_GATHER16(v, acc, ai, m);
                if (pn < 2) {
                    rms_rope(v, qg, s, fq, C2F);
                    store16(QA + (size_t)row * 512 + (pn * 4 + wc) * 64 + 16 * fq, v);
                } else if (pn == 2) {
                    if (wc < 2) { rms_rope(v, kg, s, fq, 1.0f); store16(KA + (size_t)row * 128 + wc * 64 + 16 * fq, v); }
                    else store16(VA + (size_t)row * 128 + (wc - 2) * 64 + 16 * fq, v);
                } else if (pn < 9) {
                    const bool isq = pn < 6; const int g = isq ? pn - 3 : pn - 6, gh = g * 4 + wc;
                    if (isq) {
#pragma unroll
                        for (int e = 0; e < 16; ++e) v[e] *= C2F; }
                    store16((isq ? QD : KD) + ((size_t)(b * 12 + gh) * SEQ + pg_perm(g, s)) * 64 + 16 * fq, v);
                } else if (pn < 12) {
                    const int g = pn - 9, gh = g * 4 + wc;
                    bf16_t* dst = VDT + ((size_t)(b * 12 + gh) * 64 + 16 * fq) * SEQ + pg_perm(g, s);
#pragma unroll
                    for (int e = 0; e < 16; e += 2) { const unsigned w = cvt_pk_bf16(v[e], v[e + 1]); dst[(size_t)e * SEQ] = (bf16_t)(w & 0xffffu); dst[(size_t)(e + 1) * SEQ] = (bf16_t)(w >> 16); }
                } else {
#pragma unroll
                    for (int e = 0; e < 16; ++e) v[e] = sigmoidf_(v[e]);
                    store16(G + (size_t)row * 2048 + (pn - 12) * 256 + wc * 64 + 16 * fq, v);
                }
                if (m & 1) asm volatile("" ::: "memory");
            }
    }
};
template <bool SECOND> struct EpiMerge {
    const bf16_t* G; bf16_t* tmp; bf16_t* merged;
    __device__ __forceinline__ void operator()(const f32x4 (&acc)[2][2][4][2], const Unit& u, int wr, int wc, int fr, int fq) const {
        const int col0 = u.pn * BM + wc * 64 + 16 * fq;
#pragma unroll
        for (int ai = 0; ai < 2; ++ai)
#pragma unroll
            for (int m = 0; m < 4; ++m) {
                const int row = u.pm * BM + ai * HALF + wr * 64 + m * 16 + fr;
                float v[16], gt[16]; PG8_GATHER16(v, acc, ai, m);
                load16bf(G + (size_t)row * 2048 + (SECOND ? 1024 : 0) + col0, gt);
                if (SECOND) { float t[16]; load16bf(tmp + (size_t)row * DM + col0, t);
#pragma unroll
                    for (int e = 0; e < 16; ++e) v[e] = t[e] + gt[e] * v[e];
                    store16(merged + (size_t)row * DM + col0, v);
                } else {
#pragma unroll
                    for (int e = 0; e < 16; ++e) v[e] *= gt[e];
                    store16(tmp + (size_t)row * DM + col0, v);
                }
                if (m & 1) asm volatile("" ::: "memory");
            }
    }
};
struct EpiRes {
    const float* xin; float* y; const float* gmod;
    __device__ __forceinline__ void operator()(const f32x4 (&acc)[2][2][4][2], const Unit& u, int wr, int wc, int fr, int fq) const {
        const int col0 = u.pn * BM + wc * 64 + 16 * fq;
        const int b = (u.pm * BM) >> 11;
        f32x4 gv[4];
#pragma unroll
        for (int q = 0; q < 4; ++q) gv[q] = *(const f32x4*)(gmod + (size_t)b * 6144 + col0 + 4 * q);
#pragma unroll
        for (int ai = 0; ai < 2; ++ai)
#pragma unroll
            for (int m = 0; m < 4; ++m) {
                const size_t off = (size_t)(u.pm * BM + ai * HALF + wr * 64 + m * 16 + fr) * DM + col0;
#pragma unroll
                for (int bj = 0; bj < 2; ++bj)
#pragma unroll
                    for (int n = 0; n < 2; ++n) { const int q = 2 * bj + n; const f32x4 xv = *(const f32x4*)(xin + off + 4 * q);
                        *(f32x4*)(y + off + 4 * q) = xv * DN_ALPHA + gv[q] * acc[ai][bj][m][n]; }
                if (m & 1) asm volatile("" ::: "memory");
            }
    }
};
struct EpiGU {
    bf16_t* act; const float* gatew; const PG8_LAS int* tab;
    __device__ __forceinline__ void operator()(const f32x4 (&acc)[2][2][4][2], const Unit& u, int wr, int wc, int fr, int fq) const {
        const int e = u.e, cnt = tab[e], f0 = (u.pn & 1) * 128 + wc * 32 + fq * 8;
#pragma unroll
        for (int ai = 0; ai < 2; ++ai)
#pragma unroll
            for (int m = 0; m < 4; ++m) {
                const int rit = ai * HALF + wr * 64 + m * 16 + fr, li = u.lt * BM + rit;
                const float gwl = gatew[(size_t)e * CAP + (li < CAP ? li : CAP - 1)]; const float gw = li < cnt ? gwl : 0.f;
                float a[8];
#pragma unroll
                for (int bj = 0; bj < 2; ++bj)
#pragma unroll
                    for (int j = 0; j < 4; ++j) { const float gt = acc[ai][bj][m][0][j], up = acc[ai][bj][m][1][j]; a[4 * bj + j] = gt * sigmoidf_(gt) * up * gw; }
                u32x4 w; w.x = cvt_pk_bf16(a[0], a[1]); w.y = cvt_pk_bf16(a[2], a[3]); w.z = cvt_pk_bf16(a[4], a[5]); w.w = cvt_pk_bf16(a[6], a[7]);
                *(u32x4*)(act + (size_t)(u.pm * BM + rit) * 256 + f0) = w;
                if (m & 1) asm volatile("" ::: "memory");
            }
    }
};
struct EpiDown {
    bf16_t* y2; const int* rowlist; const PG8_LAS int* tab;
    __device__ __forceinline__ void operator()(const f32x4 (&acc)[2][2][4][2], const Unit& u, int wr, int wc, int fr, int fq) const {
        const int e = u.e, cnt = tab[e], col0 = (u.pn & 3) * BM + wc * 64 + 16 * fq;
#pragma unroll
        for (int ai = 0; ai < 2; ++ai)
#pragma unroll
            for (int m = 0; m < 4; ++m) {
                const int li = u.lt * BM + ai * HALF + wr * 64 + m * 16 + fr;
                const int ent = rowlist[(size_t)e * CAP + (li < CAP ? li : CAP - 1)];
                float v[16]; PG8_GATHER16(v, acc, ai, m);
                store16(li < cnt ? y2 + ((size_t)(ent & 1) * T_TOK + (ent >> 1)) * DM + col0 : y2 + (size_t)2 * T_TOK * DM + col0, v);
                if (m & 1) asm volatile("" ::: "memory");
            }
    }
};
template <bool GATHER> struct MoeOrder {
    const PG8_LAS int* tab; const int* rowlist; int nct, G, c;
    __device__ __forceinline__ bool next(int i, Unit& u) const {
        const int nwg = tab[32] * nct; const long L = (long)i * G + c; if (L >= nwg) return false;
        int w = (int)L; { const int q = nwg / NXCD, r = nwg % NXCD, xcd = w % NXCD, off = w / NXCD; w = (xcd < r ? xcd * (q + 1) : r * (q + 1) + (xcd - r) * q) + off; }
        const int rt = w / nct, ct = w - rt * nct; int e = 0;
        for (int k = 1; k < 16; ++k) e += (rt >= tab[16 + k]) ? 1 : 0;
        u.pm = rt; u.e = e; u.lt = rt - tab[16 + e]; u.pn = e * nct + ct; return true;
    }
    __device__ __forceinline__ int arow(const Unit& u, int R) const {
        if (GATHER) { const int li = u.lt * BM + R; const int ent = rowlist[(size_t)u.e * CAP + (li < CAP ? li : CAP - 1)]; return li < tab[u.e] ? (ent >> 1) : 0; }
        return u.pm * BM + R;
    }
};
}
namespace attn_body {
using bf16=__hip_bfloat16;
using bf16x8=__attribute__((ext_vector_type(8)))short;
using s16x4=__attribute__((ext_vector_type(4)))short;
using f32x16=__attribute__((ext_vector_type(16)))float;
using u32x4=__attribute__((ext_vector_type(4)))unsigned;
constexpr int BATCH=16,NHEAD=8,SEQ=2048,D=64,QP=512,KP=128,VP=128,OP=512;
constexpr int NW=8,QBLK=32,QB=QBLK*NW,KVBLK=64,NQB=SEQ/QB;
constexpr int ATTN_UNIT_ROWS=QB;
__device__ __forceinline__ int crow(int r,int hi){return (r&3)+8*(r>>2)+4*hi;}
#define SBAR() __builtin_amdgcn_sched_barrier(0)
__device__ __forceinline__ void cmask(f32x16&p0,f32x16&p1,int jb,int qrel,int hi){
  const float NEG=-INFINITY; int kb=64*jb+4*hi;
  #pragma unroll
  for(int r=0;r<16;++r){int kv=kb+(r&3)+8*(r>>2); if(kv>qrel)p0[r]=NEG; if(kv+32>qrel)p1[r]=NEG;}
}

constexpr int NSLOT=3, SLOTB=8192;
constexpr int LDS_K=0, LDS_V=NSLOT*SLOTB, LDS_WS=2*NSLOT*SLOTB, LDS_OST=LDS_WS+NW*64*4, LDS_BYTES=LDS_OST+NW*4096;
constexpr float C2=0.125f*1.4426950408889634f;
__device__ __forceinline__ void glds16(const void*gsrc,unsigned lds_dst){unsigned keep;
  asm volatile("s_mov_b32 %0, m0\n\ts_mov_b32 m0, %2\n\ts_nop 0\n\tglobal_load_lds_dwordx4 %1, off\n\ts_mov_b32 m0, %0":"=&s"(keep):"v"(gsrc),"s"(lds_dst):"memory");}
__device__ __forceinline__ float max3f(float a,float b,float c){float r;asm("v_max3_f32 %0, %1, %2, %3":"=v"(r):"v"(a),"v"(b),"v"(c));return r;}
__device__ __forceinline__ float max2f(float a,float b){float r;asm("v_max_f32_e32 %0, %1, %2":"=v"(r):"v"(a),"v"(b));return r;}
__device__ __forceinline__ float fadd_s(float a,float b){float r;asm("v_add_f32_e32 %0, %1, %2":"=v"(r):"v"(a),"v"(b));return r;}
__device__ __forceinline__ float fsub_s(float a,float b){float r;asm("v_sub_f32_e32 %0, %1, %2":"=v"(r):"v"(a),"v"(b));return r;}
typedef float f32x2_t __attribute__((ext_vector_type(2))); typedef __bf16 bf16x2_t __attribute__((ext_vector_type(2)));
__device__ __forceinline__ unsigned cvtpk_s(float lo,float hi){f32x2_t v={lo,hi};bf16x2_t b=__builtin_convertvector(v,bf16x2_t);return __builtin_bit_cast(unsigned,b);}
#define WAIT_BAR(N) asm volatile("s_waitcnt vmcnt(" #N ") lgkmcnt(0)\n\ts_barrier":::"memory")

__device__ __forceinline__ void qkt(f32x16&p0,f32x16&p1,const char*Kslot,const bf16x8*qr,const f32x16&negm,int r32,int hi){
  const char*kb=Kslot+hi*1024+r32*16;
  #pragma unroll
  for(int d0=0;d0<4;++d0){
    const bf16x8 b0=*reinterpret_cast<const bf16x8*>(kb+d0*2048);
    const bf16x8 b1=*reinterpret_cast<const bf16x8*>(kb+d0*2048+512);
    if(d0==0){p0=__builtin_amdgcn_mfma_f32_32x32x16_bf16(b0,qr[0],negm,0,0,0);p1=__builtin_amdgcn_mfma_f32_32x32x16_bf16(b1,qr[0],negm,0,0,0);}
    else{p0=__builtin_amdgcn_mfma_f32_32x32x16_bf16(b0,qr[d0],p0,0,0,0);p1=__builtin_amdgcn_mfma_f32_32x32x16_bf16(b1,qr[d0],p1,0,0,0);}}
}
typedef __attribute__((address_space(3))) const char* lds_cptr;
typedef short v4i16_t __attribute__((ext_vector_type(4)));
__device__ __forceinline__ void kload8(bf16x8*kf,lds_cptr kp){
  kf[0]=*(const __attribute__((address_space(3))) bf16x8*)(kp);      kf[1]=*(const __attribute__((address_space(3))) bf16x8*)(kp+512);
  kf[2]=*(const __attribute__((address_space(3))) bf16x8*)(kp+2048); kf[3]=*(const __attribute__((address_space(3))) bf16x8*)(kp+2560);
  kf[4]=*(const __attribute__((address_space(3))) bf16x8*)(kp+4096); kf[5]=*(const __attribute__((address_space(3))) bf16x8*)(kp+4608);
  kf[6]=*(const __attribute__((address_space(3))) bf16x8*)(kp+6144); kf[7]=*(const __attribute__((address_space(3))) bf16x8*)(kp+6656);
}
__device__ __forceinline__ void kload2(bf16x8*kf,lds_cptr kp,int j){ kf[2*j]=*(const __attribute__((address_space(3))) bf16x8*)(kp+j*2048); kf[2*j+1]=*(const __attribute__((address_space(3))) bf16x8*)(kp+j*2048+512); }
__device__ __forceinline__ s16x4 vtr(lds_cptr p){ return __builtin_bit_cast(s16x4,__builtin_amdgcn_ds_read_tr16_b64_v4i16((__attribute__((address_space(3))) v4i16_t*)p)); }
__device__ __forceinline__ float rowmax(const f32x16&p0,const f32x16&p1){
  float a=max3f(p0[0],p0[1],p1[0]),b=max3f(p0[2],p0[3],p1[1]);a=max3f(a,p1[2],p1[3]);
  #pragma unroll
  for(int r=4;r<16;r+=4){a=max3f(a,p0[r],p0[r+1]);b=max3f(b,p0[r+2],p0[r+3]);a=max3f(a,p1[r],p1[r+1]);b=max3f(b,p1[r+2],p1[r+3]);}
  const float m=max2f(a,b);
  auto rr=__builtin_amdgcn_permlane32_swap(__float_as_uint(m),__float_as_uint(m),false,false);
  return max2f(__uint_as_float(rr[0]),__uint_as_float(rr[1]));
}
__device__ __forceinline__ void pv(f32x16*o,int vb,bf16x8 pa0,bf16x8 pa1,bf16x8 pa2,bf16x8 pa3){
  #pragma unroll
  for(int d0=0;d0<2;++d0){s16x4 lo[4],hi[4];
    #pragma unroll
    for(int ks=0;ks<4;++ks){
      asm volatile("ds_read_b64_tr_b16 %0,%1 offset:%c2":"=&v"(lo[ks]):"v"(vb),"i"(d0*4096+ks*1024):"memory");
      asm volatile("ds_read_b64_tr_b16 %0,%1 offset:%c2":"=&v"(hi[ks]):"v"(vb),"i"(d0*4096+ks*1024+512):"memory");}
    asm volatile("s_waitcnt lgkmcnt(0)":::"memory");SBAR();
    #define PK(k) (bf16x8){lo[k][0],lo[k][1],lo[k][2],lo[k][3],hi[k][0],hi[k][1],hi[k][2],hi[k][3]}
    o[d0]=__builtin_amdgcn_mfma_f32_32x32x16_bf16(pa0,PK(0),o[d0],0,0,0);
    o[d0]=__builtin_amdgcn_mfma_f32_32x32x16_bf16(pa1,PK(1),o[d0],0,0,0);
    o[d0]=__builtin_amdgcn_mfma_f32_32x32x16_bf16(pa2,PK(2),o[d0],0,0,0);
    o[d0]=__builtin_amdgcn_mfma_f32_32x32x16_bf16(pa3,PK(3),o[d0],0,0,0);
    #undef PK
  }
}

#ifndef ATTN_STORE16
#define ATTN_STORE16(p,v) (*(u32x4*)(p)=(v))
#endif
template<int THRL> __device__ __forceinline__ void attn_unit(const int wave,int b,int h,int qb,const bf16*Q,const bf16*__restrict__ K,const bf16*__restrict__ V,bf16*O,char*shm){
  const int lane=hw_lane(),r32=lane&31,hi=lane>>5; const int wid=wave;
  const long rowbase=(long)b*SEQ; const int q0=qb*QB;
  const bf16*Qw=Q+(rowbase+q0+wid*QBLK)*QP+h*D;
  const bf16*Kh=K+rowbase*KP+(h>>2)*D,*Vh=V+rowbase*VP+(h>>2)*D;
  const unsigned lds0=(unsigned)(uintptr_t)shm;
  float*wsf=(float*)(shm+LDS_WS)+wid*64;
  const bf16*ksrc=Kh+(long)lane*KP+wid*8;
  const bf16*vsrc=Vh+(long)(16*(wid&3)+(lane>>2))*VP+(wid>>2)*32+(lane&3)*8;
  const unsigned kdst=lds0+LDS_K+wid*1024, vdst=lds0+LDS_V+wid*1024;
  #define DMA_K(t,slot) glds16(ksrc+(long)(t)*KVBLK*KP,(unsigned)__builtin_amdgcn_readfirstlane(kdst+(slot)))
  #define DMA_V(t,slot) glds16(vsrc+(long)(t)*KVBLK*VP,(unsigned)__builtin_amdgcn_readfirstlane(vdst+(slot)))
  const int vb0=(int)(lds0+LDS_V)+((lane>>4)&1)*32+(lane&3)*8+(4*hi+((lane&15)>>2))*64;
  const char*Kbase=shm+LDS_K; bf16x8 kf[8];
  const lds_cptr shm3=(lds_cptr)shm; const lds_cptr kp0=shm3+LDS_K+hi*1024+r32*16; const lds_cptr vp0=shm3+LDS_V+((lane>>4)&1)*32+(lane&3)*8+(4*hi+((lane&15)>>2))*64;
  const int NT=SEQ/KVBLK;
  DMA_K(0,0);DMA_V(0,0);DMA_K(1,SLOTB);
  bf16x8 qr[4];
  #pragma unroll
  for(int d0=0;d0<4;++d0)qr[d0]=*reinterpret_cast<const bf16x8*>(&Qw[(long)r32*QP+d0*16+hi*8]);
  float mhat=0.f,l_reg=0.f;f32x16 o[2];o[0]=f32x16{};o[1]=f32x16{};f32x16 negm=f32x16{};asm volatile("":"+v"(negm));

  #define CMASK(P0,P1,t) do{}while(0)
  bool resc=false;
  #define START(P0,P1) do{ const float rm=rowmax(P0,P1); resc=false; \
    { const float dl=rm; mhat=fadd_s(mhat,dl); \
      _Pragma("unroll") for(int r=0;r<16;++r){P0[r]=fsub_s(P0[r],dl);P1[r]=fsub_s(P1[r],dl);} \
      _Pragma("unroll") for(int r=0;r<16;++r)negm[r]=-mhat; asm volatile("":"+v"(negm)); } \
    _Pragma("unroll") for(int r=0;r<16;++r)P0[r]=__builtin_amdgcn_exp2f(P0[r]); }while(0)
  #define RESC() do{ if(resc){ asm volatile("s_waitcnt lgkmcnt(0)":::"memory"); \
      _Pragma("unroll") for(int d_=0;d_<2;++d_) _Pragma("unroll") for(int r=0;r<16;++r)o[d_][r]*=wsf[crow(r,hi)]; } }while(0)
  f32x16 pA0,pA1,pB0,pB1;
  int sl_prev=0,sl_cur=0,sl_next=SLOTB;
  #define ROT() do{sl_prev=sl_cur;sl_cur=sl_next;sl_next=(sl_next==(NSLOT-1)*SLOTB)?0:sl_next+SLOTB;}while(0)
  DMA_K(2,2*SLOTB);
  WAIT_BAR(3);
  qkt(pA0,pA1,Kbase,qr,negm,r32,hi);asm volatile("s_nop 15\n\ts_nop 7":"+v"(pA0),"+v"(pA1));CMASK(pA0,pA1,0);
  START(pA0,pA1);
  _Pragma("unroll") for(int r=0;r<16;++r)pA1[r]=__builtin_amdgcn_exp2f(pA1[r]);
  WAIT_BAR(0);
  DMA_K(3,0);DMA_V(1,SLOTB);
  ROT();
  kload8(kf,kp0+sl_cur);
  WAIT_BAR(2);
  s16x4 vlo[8],vhi[8]; u32x4 pw0,pw1,pw2,pw3;
  #define PKW(P,B) cvtpk_s(P[B],P[B+1])
  #define PAF(k) __builtin_bit_cast(bf16x8,pw##k)
  #define VFR(i) (bf16x8){vlo[i][0],vlo[i][1],vlo[i][2],vlo[i][3],vhi[i][0],vhi[i][1],vhi[i][2],vhi[i][3]}
  #define PIN(x) asm volatile("":"+v"(x))
  #define MX3(a,b,c) __builtin_fmaxf(__builtin_fmaxf((a),(b)),(c))
  #define GAPA(MF,A0,A1,A2,A3,W0,W1,PW) do{ MF; sacc+=A0; sacc+=A1; sacc+=A2; sacc+=A3; PIN(sacc); W0; W1; PIN(PW); SBAR(); }while(0)
  #define EX(v) __builtin_amdgcn_exp2f(v)
  #define GAPB(MF,X,B) do{ MF; X[B]=EX(X[B]); X[B+1]=EX(X[B+1]); X[B+2]=EX(X[B+2]); X[B+3]=EX(X[B+3]); PIN(X); SBAR(); }while(0)
  #define VRD(i) do{ vlo[i]=vtr(vp_+(((i)>>2)*4096+((i)&3)*1024)); vhi[i]=vtr(vp_+(((i)>>2)*4096+((i)&3)*1024+512)); }while(0)
  #define KRD(G,j) do{ if(G){ kload2(kf,kp0+sl_next,j); SBAR(); } }while(0)
  #define STEP(C0,C1,P0,P1,t,GK,GV,GL) do{ SBAR(); \
    const lds_cptr vp_=vp0+sl_prev; \
    VRD(0); SBAR(); float sacc=(P0[0]+P0[1]); \
    GAPA(C0=__builtin_amdgcn_mfma_f32_32x32x16_bf16(kf[0],qr[0],negm,0,0,0), P0[2],P0[3],P0[4],P0[5],     pw0[0]=PKW(P0,0), pw0[1]=PKW(P0,2), pw0); \
    VRD(4); SBAR(); GAPA(C1=__builtin_amdgcn_mfma_f32_32x32x16_bf16(kf[1],qr[0],negm,0,0,0), P0[6],P0[7],P0[8],P0[9],     pw0[2]=PKW(P0,4), pw0[3]=PKW(P0,6), pw0); \
    VRD(1); SBAR(); GAPA(C0=__builtin_amdgcn_mfma_f32_32x32x16_bf16(kf[2],qr[1],C0,0,0,0),   P0[10],P0[11],P0[12],P0[13], pw1[0]=PKW(P0,8), pw1[1]=PKW(P0,10), pw1); \
    VRD(5); SBAR(); GAPA(C1=__builtin_amdgcn_mfma_f32_32x32x16_bf16(kf[3],qr[1],C1,0,0,0),   P0[14],P0[15],P1[0],P1[1],   pw1[2]=PKW(P0,12),pw1[3]=PKW(P0,14), pw1); \
    VRD(2); SBAR(); GAPA(C0=__builtin_amdgcn_mfma_f32_32x32x16_bf16(kf[4],qr[2],C0,0,0,0),   P1[2],P1[3],P1[4],P1[5],     pw2[0]=PKW(P1,0), pw2[1]=PKW(P1,2), pw2); \
    VRD(6); SBAR(); GAPA(C1=__builtin_amdgcn_mfma_f32_32x32x16_bf16(kf[5],qr[2],C1,0,0,0),   P1[6],P1[7],P1[8],P1[9],     pw2[2]=PKW(P1,4), pw2[3]=PKW(P1,6), pw2); \
    VRD(3); SBAR(); GAPA(C0=__builtin_amdgcn_mfma_f32_32x32x16_bf16(kf[6],qr[3],C0,0,0,0),   P1[10],P1[11],P1[12],P1[13], pw3[0]=PKW(P1,8), pw3[1]=PKW(P1,10), pw3); \
    VRD(7); SBAR(); GAPA(C1=__builtin_amdgcn_mfma_f32_32x32x16_bf16(kf[7],qr[3],C1,0,0,0),   P1[14],P1[15],0.f,0.f,       pw3[2]=PKW(P1,12),pw3[3]=PKW(P1,14), pw3); \
    l_reg+=sacc; \
    if(GK){DMA_K((t)+3,sl_cur);} if(GV){DMA_V((t)+1,sl_next);} \
    CMASK(C0,C1,t); \
    { float a=MX3(C0[0],C0[1],C1[0]),b=MX3(C0[2],C0[3],C1[1]); a=MX3(a,C1[2],C1[3]); \
      _Pragma("unroll") for(int r=4;r<16;r+=4){a=MX3(a,C0[r],C0[r+1]);b=MX3(b,C0[r+2],C0[r+3]);a=MX3(a,C1[r],C1[r+1]);b=MX3(b,C1[r+2],C1[r+3]);} \
      float rm=__builtin_fmaxf(a,b); { auto rr=__builtin_amdgcn_permlane32_swap(__float_as_uint(rm),__float_as_uint(rm),false,false); rm=__builtin_fmaxf(__uint_as_float(rr[0]),__uint_as_float(rr[1])); } \
      resc=false; \
      if(__builtin_expect(__any(rm>(float)THRL),0)){ const float dl=__builtin_fmaxf(rm,0.f); mhat+=dl; \
        _Pragma("unroll") for(int r=0;r<16;++r){C0[r]-=dl;C1[r]-=dl;} \
        _Pragma("unroll") for(int r=0;r<16;++r)negm[r]=-mhat; asm volatile("":"+v"(negm)); \
        const float f=__builtin_amdgcn_exp2f(-dl); l_reg*=f; if(hi==0)wsf[r32]=f; resc=true; } } \
    SBAR(); \
    GAPB(o[0]=__builtin_amdgcn_mfma_f32_32x32x16_bf16(PAF(0),VFR(0),o[0],0,0,0), C0,0); \
    GAPB(o[1]=__builtin_amdgcn_mfma_f32_32x32x16_bf16(PAF(0),VFR(4),o[1],0,0,0), C0,4); \
    KRD(GL,0); GAPB(o[0]=__builtin_amdgcn_mfma_f32_32x32x16_bf16(PAF(1),VFR(1),o[0],0,0,0), C0,8); \
    KRD(GL,1); GAPB(o[1]=__builtin_amdgcn_mfma_f32_32x32x16_bf16(PAF(1),VFR(5),o[1],0,0,0), C0,12); \
    KRD(GL,2); GAPB(o[0]=__builtin_amdgcn_mfma_f32_32x32x16_bf16(PAF(2),VFR(2),o[0],0,0,0), C1,0); \
    KRD(GL,3); GAPB(o[1]=__builtin_amdgcn_mfma_f32_32x32x16_bf16(PAF(2),VFR(6),o[1],0,0,0), C1,4); \
    GAPB(o[0]=__builtin_amdgcn_mfma_f32_32x32x16_bf16(PAF(3),VFR(3),o[0],0,0,0), C1,8); \
    GAPB(o[1]=__builtin_amdgcn_mfma_f32_32x32x16_bf16(PAF(3),VFR(7),o[1],0,0,0), C1,12); \
    }while(0)
  int t=1;
  #undef CMASK
  #define CMASK(P0,P1,t) do{}while(0)
  for(;t+5<NT;t+=2){
    STEP(pB0,pB1,pA0,pA1,t,true,true,true);     WAIT_BAR(2); RESC(); ROT();
    STEP(pA0,pA1,pB0,pB1,t+1,true,true,true);   WAIT_BAR(2); RESC(); ROT();
  }
  #undef CMASK
  #define CMASK(P0,P1,t) do{}while(0)
  #define ENDW(tt) do{ if((tt)+3<NT){WAIT_BAR(2);} else if((tt)+2<NT){WAIT_BAR(1);} else {WAIT_BAR(0);} }while(0)
  for(;t+1<NT;t+=2){
    STEP(pB0,pB1,pA0,pA1,t,(t+3<NT),(t+1<NT),(t+1<NT));       ENDW(t);   RESC(); ROT();
    STEP(pA0,pA1,pB0,pB1,t+1,(t+4<NT),(t+2<NT),(t+2<NT));     ENDW(t+1); RESC(); ROT();
  }
  STEP(pB0,pB1,pA0,pA1,NT-1,false,false,false); RESC();
  { float sacc=pB0[0]+pB0[1]; _Pragma("unroll") for(int r=2;r<16;++r)sacc+=pB0[r]; _Pragma("unroll") for(int r=0;r<16;++r)sacc+=pB1[r]; l_reg+=sacc;
    pw0=(u32x4){PKW(pB0,0),PKW(pB0,2),PKW(pB0,4),PKW(pB0,6)};pw1=(u32x4){PKW(pB0,8),PKW(pB0,10),PKW(pB0,12),PKW(pB0,14)};pw2=(u32x4){PKW(pB1,0),PKW(pB1,2),PKW(pB1,4),PKW(pB1,6)};pw3=(u32x4){PKW(pB1,8),PKW(pB1,10),PKW(pB1,12),PKW(pB1,14)};
    SBAR(); pv(o,vb0+sl_cur,PAF(0),PAF(1),PAF(2),PAF(3)); }
  #undef PKW
  #undef PAF
  #undef VFR
  #undef PIN
  #undef MX3
  #undef GAPA
  #undef GAPB
  #undef EX
  #undef VRD
  #undef KRD
  #undef STEP
  #undef ENDW
  {auto rr=__builtin_amdgcn_permlane32_swap(__float_as_uint(l_reg),__float_as_uint(l_reg),false,false);l_reg=__uint_as_float(rr[0])+__uint_as_float(rr[1]);}
  if(hi==0)wsf[32+r32]=l_reg;asm volatile("s_waitcnt lgkmcnt(0)":::"memory");
  float rli[16];
  #pragma unroll
  for(int r=0;r<16;++r)rli[r]=__builtin_amdgcn_rcpf(wsf[32+crow(r,hi)]);
  bf16*Ow=O+(rowbase+q0+wid*QBLK)*OP+h*D;
  { bf16*stg=(bf16*)(shm+LDS_OST)+wid*2048;
    #pragma unroll
    for(int r=0;r<16;++r){const int orow=crow(r,hi);
      #pragma unroll
      for(int d0=0;d0<2;++d0)stg[orow*64+d0*32+r32]=__float2bfloat16(o[d0][r]*rli[r]);}
    asm volatile("s_waitcnt lgkmcnt(0)":::"memory");
    #pragma unroll
    for(int i=0;i<4;++i){const int row=i*8+(lane>>3),ch=lane&7; const u32x4 v=*(const u32x4*)(stg+row*64+ch*8); ATTN_STORE16(Ow+(long)row*OP+ch*8,v);} }
  asm volatile("s_waitcnt lgkmcnt(0)\n\ts_barrier":::"memory");
  #undef DMA_K
  #undef DMA_V
  #undef CMASK
  #undef START
  #undef RESC
  #undef ROT
}
constexpr int ATTN_LDS_BYTES=LDS_BYTES;
struct AttnTensors { const bf16* Q; const bf16* K; const bf16* V; bf16* O; };
struct AttnUnit { int bh; int qb; };
struct StaticOrder {
  int vcu, G;
  __device__ __forceinline__ explicit StaticOrder(int grid,int block):vcu((grid%8==0)?(block%8)*(grid/8)+block/8:block),G(grid){}
  __device__ __forceinline__ bool next(int i,AttnUnit&u)const{ const int L=(G==256)?(vcu*4+i):(vcu+i*G); if((G==256&&i>=4)||L>=BATCH*NHEAD*NQB)return false; u.bh=L>>3; u.qb=L&7; return true; }
  __device__ __forceinline__ void a_ready(const AttnUnit&)const{}
  __device__ __forceinline__ void done(const AttnUnit&)const{}
};
template<class Sched,int THRL=8> __device__ __forceinline__ void attn_phase(char*lds,const AttnTensors&T,const Sched&S,const int wave){
  AttnUnit u;
  for(int i=0;S.next(i,u);++i){ S.a_ready(u); attn_unit<THRL>(wave,u.bh/NHEAD,u.bh%NHEAD,u.qb,T.Q,T.K,T.V,T.O,lds); S.done(u); }
}
#undef SBAR
#undef WAIT_BAR
}
namespace attnb {
using pg8::bf16_t;
typedef short bf16x8 __attribute__((ext_vector_type(8)));
typedef float f32x16 __attribute__((ext_vector_type(16)));
typedef unsigned u32x2 __attribute__((ext_vector_type(2)));
typedef unsigned u32x4 __attribute__((ext_vector_type(4)));
typedef float f32x2_t __attribute__((ext_vector_type(2))); typedef __bf16 bf16x2_t __attribute__((ext_vector_type(2)));
__device__ __forceinline__ unsigned cvtpk(float lo, float hi) { f32x2_t v = {lo, hi}; bf16x2_t b = __builtin_convertvector(v, bf16x2_t); return __builtin_bit_cast(unsigned, b); }
constexpr float NEGB = -1.0e30f;
constexpr int NTASK = 16 * 4 * 16 * 4;

__device__ __forceinline__ void task(int tk, const bf16_t* __restrict__ QD, const bf16_t* __restrict__ KD, const bf16_t* __restrict__ VDT, bf16_t* OUTB, int lane) {
    const int ib = tk & 3, R = (tk >> 2) & 15, hh = (tk >> 6) & 3, b = tk >> 8;
    const int r = lane & 31, h = lane >> 5;
    const int kr = (r & 0x13) | ((r & 4) << 1) | ((r & 8) >> 1);
    f32x16 o0, o1;
#pragma unroll
    for (int i = 0; i < 16; ++i) { o0[i] = 0.f; o1[i] = 0.f; }
    float mrun = NEGB, lrun = 0.f;
    const int t = R + 16 * (32 * ib + r);
    for (int g = 2; g >= 0; --g) {
        const int sh = 2 * g, dg = 1 << sh, ng = SEQ >> sh, gh = g * 4 + hh;
        const int cls = R & (dg - 1), u = t >> sh;
        const int u_min = (R + 512 * ib) >> sh, u_max = (R + 512 * ib + 496) >> sh;
        int tlo = (u_min - 64) >> 5; if (tlo < 0) tlo = 0;
        int thi = (u_max + 64) >> 5; const int tmax = (ng >> 5) - 1; if (thi > tmax) thi = tmax;
        const size_t hb = (size_t)(b * 12 + gh);
        const bf16_t* Qp = QD + (hb * SEQ + cls * ng + u) * 64 + 8 * h;
        bf16x8 qf[4];
#pragma unroll
        for (int ds = 0; ds < 4; ++ds) qf[ds] = *(const bf16x8*)(Qp + 16 * ds);
        const bf16_t* Kc = KD + (hb * SEQ + cls * ng + kr) * 64 + 8 * h;
        const bf16_t* Vc = VDT + (hb * 64 + r) * SEQ + cls * ng + 8 * h;
        const float sl2 = __builtin_amdgcn_exp2f(-8.0f * (float)(gh + 1) / 12.0f) * 1.4426950408889634f * (float)dg;
        const int du = u - 8 * h;
        bf16x8 kf[4], vf[2][2];
#define ATTNB_LOAD(KF, VF, tb) do { const int kb_ = (tb) * 32; \
            _Pragma("unroll") for (int ds = 0; ds < 4; ++ds) KF[ds] = *(const bf16x8*)(Kc + (size_t)kb_ * 64 + 16 * ds); \
            _Pragma("unroll") for (int db = 0; db < 2; ++db) _Pragma("unroll") for (int s = 0; s < 2; ++s) VF[db][s] = *(const bf16x8*)(Vc + (size_t)(32 * db) * SEQ + kb_ + 16 * s); } while (0)
        ATTNB_LOAD(kf, vf, tlo);
        for (int tb = tlo; tb <= thi; ++tb) {
            bf16x8 kn[4], vn[2][2];
            const int tbn = tb < thi ? tb + 1 : tb;
            ATTNB_LOAD(kn, vn, tbn);
            f32x16 x;
#pragma unroll
            for (int i = 0; i < 16; ++i) x[i] = 0.f;
#pragma unroll
            for (int ds = 0; ds < 4; ++ds) x = __builtin_amdgcn_mfma_f32_32x32x16_bf16(kf[ds], qf[ds], x, 0, 0, 0);
            const int dk = du - tb * 32;
            float mx = NEGB;
#pragma unroll
            for (int i = 0; i < 16; ++i) { const int d = dk - ((i & 7) + 16 * (i >> 3)); const int ad = d < 0 ? -d : d;
                const float s2 = x[i] - sl2 * (float)ad; x[i] = ad > 64 ? NEGB : s2; mx = fmaxf(mx, x[i]); }
            mx = fmaxf(mx, __shfl_xor(mx, 32));
            const float mnew = fmaxf(mrun, mx), f = __builtin_amdgcn_exp2f(mrun - mnew);
            mrun = mnew;
            float ps = 0.f;
#pragma unroll
            for (int i = 0; i < 16; ++i) { x[i] = __builtin_amdgcn_exp2f(x[i] - mnew); ps += x[i]; }
            lrun = lrun * f + ps;
#pragma unroll
            for (int i = 0; i < 16; ++i) { o0[i] *= f; o1[i] *= f; }
            u32x4 p0, p1;
            p0.x = cvtpk(x[0], x[1]); p0.y = cvtpk(x[2], x[3]); p0.z = cvtpk(x[4], x[5]); p0.w = cvtpk(x[6], x[7]);
            p1.x = cvtpk(x[8], x[9]); p1.y = cvtpk(x[10], x[11]); p1.z = cvtpk(x[12], x[13]); p1.w = cvtpk(x[14], x[15]);
            const bf16x8 pb0 = __builtin_bit_cast(bf16x8, p0), pb1 = __builtin_bit_cast(bf16x8, p1);
            o0 = __builtin_amdgcn_mfma_f32_32x32x16_bf16(vf[0][0], pb0, o0, 0, 0, 0);
            o0 = __builtin_amdgcn_mfma_f32_32x32x16_bf16(vf[0][1], pb1, o0, 0, 0, 0);
            o1 = __builtin_amdgcn_mfma_f32_32x32x16_bf16(vf[1][0], pb0, o1, 0, 0, 0);
            o1 = __builtin_amdgcn_mfma_f32_32x32x16_bf16(vf[1][1], pb1, o1, 0, 0, 0);
#pragma unroll
            for (int ds = 0; ds < 4; ++ds) kf[ds] = kn[ds];
#pragma unroll
            for (int db = 0; db < 2; ++db) { vf[db][0] = vn[db][0]; vf[db][1] = vn[db][1]; }
        }
#undef ATTNB_LOAD
    }
    const float ltot = lrun + __shfl_xor(lrun, 32), inv = 1.0f / ltot;
    bf16_t* op = OUTB + ((size_t)b * SEQ + t) * 256 + hh * 64 + 4 * h;
#pragma unroll
    for (int q = 0; q < 4; ++q) {
        u32x2 w0, w1;
        w0.x = cvtpk(o0[4 * q] * inv, o0[4 * q + 1] * inv); w0.y = cvtpk(o0[4 * q + 2] * inv, o0[4 * q + 3] * inv);
        w1.x = cvtpk(o1[4 * q] * inv, o1[4 * q + 1] * inv); w1.y = cvtpk(o1[4 * q + 2] * inv, o1[4 * q + 3] * inv);
        *(u32x2*)(op + 8 * q) = w0; *(u32x2*)(op + 32 + 8 * q) = w1;
    }
}
}
typedef unsigned u32x2g __attribute__((ext_vector_type(2)));
#define GAS __attribute__((address_space(1)))
#define LAS __attribute__((address_space(3)))
typedef unsigned short bf16;
typedef unsigned v4u __attribute__((ext_vector_type(4)));
typedef float f32x4 __attribute__((ext_vector_type(4)));
typedef short bf16x8 __attribute__((ext_vector_type(8)));
typedef GAS unsigned gu32;
typedef GAS unsigned long long gu64;
#define RLX_AGENT __ATOMIC_RELAXED, __HIP_MEMORY_SCOPE_AGENT
#define LDS_WAIT() asm volatile("s_waitcnt lgkmcnt(0)" ::: "memory")
#define VM_WAIT() asm volatile("s_waitcnt vmcnt(0)" ::: "memory")
__device__ __forceinline__ unsigned long long rt() { return __builtin_amdgcn_s_memrealtime(); }
__device__ __forceinline__ unsigned f2bf(float f) { unsigned u = __builtin_bit_cast(unsigned, f); return (u + 0x7fffu + ((u >> 16) & 1u)) >> 16; }
__device__ __forceinline__ unsigned pk2(float lo, float hi) { return f2bf(lo) | (f2bf(hi) << 16); }

#define XB_TMO      128
#define XB_XCNT(j)  (256  + 64 * (j))
#define XB_XSUB(j)  (1280 + 64 * (j))
#define XB_XGEN(j)  (2304 + 64 * (j))
#define XB_TOP      3328
#define XB_TOPGEN   3392
#define XCD_BAR_WORDS 3456
#define XB_SPIN_CAP (1u << 18)

__device__ __forceinline__ unsigned xb_ld(unsigned* p)              { return __hip_atomic_load(p, __ATOMIC_RELAXED, __HIP_MEMORY_SCOPE_AGENT); }
__device__ __forceinline__ unsigned xb_add(unsigned* p, unsigned v) { return __hip_atomic_fetch_add(p, v, __ATOMIC_RELAXED, __HIP_MEMORY_SCOPE_AGENT); }
__device__ __forceinline__ unsigned xb_xcc_id() { return (unsigned)__builtin_amdgcn_s_getreg((3 << 11) | 20) & 0xFu; }
#define XB_SPIN(cond, bar) do { unsigned _sp = 0; while (cond) { __builtin_amdgcn_s_sleep(1); \
    if ((++_sp & 255u) == 0u) { if (xb_ld(&(bar)[XB_TMO])) break; if (_sp > XB_SPIN_CAP) { atomicAdd(&(bar)[XB_TMO], 1u); break; } } } } while (0)

struct XcdBarrier {
    unsigned* bar; unsigned x;
    volatile LAS unsigned* st;
};

__device__ __forceinline__ XcdBarrier xcd_barrier_post(unsigned* bar, volatile LAS unsigned* st) {
    XcdBarrier b; b.bar = bar; b.x = xb_xcc_id(); b.st = st;
    if (threadIdx.x == 0) (void)xb_add(&bar[XB_XCNT(b.x)], 1u);
    return b;
}
__device__ __forceinline__ void xcd_barrier_complete(unsigned* bar, unsigned x, unsigned& nloc, unsigned& nx) {
    const unsigned G = gridDim.x * gridDim.y * gridDim.z;
    unsigned sum, cnt, mine, sp = 0u;
    for (;;) {
        sum = 0u; cnt = 0u; mine = 0u;
#pragma unroll
        for (unsigned j = 0; j < 16; ++j) { const unsigned c = xb_ld(&bar[XB_XCNT(j)]); sum += c; cnt += (c > 0u) ? 1u : 0u; mine = (j == x) ? c : mine; }
        if (sum == G) break;
        __builtin_amdgcn_s_sleep(1);
        if ((++sp & 255u) == 0u) { if (xb_ld(&bar[XB_TMO])) break; if (sp > XB_SPIN_CAP) { atomicAdd(&bar[XB_TMO], 1u); break; } }
    }
    nloc = mine > 0u ? mine : 1u; nx = cnt > 0u ? cnt : 1u;
}

__device__ __forceinline__ void xcd_barrier(const XcdBarrier& b, const bool is_t0  ) {
    asm volatile("s_waitcnt vmcnt(0)" ::: "memory");
    __syncthreads();
    if (is_t0) {
        unsigned* bar = b.bar;
        __builtin_amdgcn_s_waitcnt(0);
        unsigned nloc = b.st[0], nx = b.st[1];
        if (nloc == 0u) { xcd_barrier_complete(bar, b.x, nloc, nx); b.st[0] = nloc; b.st[1] = nx; }
        const unsigned old = xb_add(&bar[XB_XSUB(b.x)], 1u);
        const unsigned gen = old / nloc;
        if (old + 1u == (gen + 1u) * nloc) {
            __builtin_amdgcn_fence(__ATOMIC_RELEASE, "agent");
            asm volatile("s_waitcnt vmcnt(0)" ::: "memory");
            const unsigned og = xb_add(&bar[XB_TOP], 1u);
            const unsigned tg = og / nx;
            if (og + 1u == (tg + 1u) * nx) xb_add(&bar[XB_TOPGEN], 1u);
            else XB_SPIN(xb_ld(&bar[XB_TOPGEN]) == tg, bar);
            __builtin_amdgcn_fence(__ATOMIC_ACQUIRE, "agent");
            xb_add(&bar[XB_XGEN(b.x)], 1u);
            asm volatile("s_waitcnt vmcnt(0)" ::: "memory");
        } else {
            XB_SPIN(xb_ld(&bar[XB_XGEN(b.x)]) == gen, bar);
            __builtin_amdgcn_fence(__ATOMIC_ACQUIRE, "agent");
            asm volatile("s_waitcnt vmcnt(0)" ::: "memory");
        }
    }
    __syncthreads();
}
#ifndef MK_N_LAUNCHES
#define MK_N_LAUNCHES 34
#endif
constexpr int NWAVES = 8;
constexpr int N_PHASES = 2 + 8 * DEPTH;
constexpr size_t MiB = 1u << 20;
constexpr size_t WS_CTL = 0, CTL_ZERO_BYTES = 1 * MiB;
constexpr size_t WS_ROPE = 1 * MiB;
constexpr size_t WS_MOD = 2 * MiB;
constexpr size_t WS_ROWLIST = 4 * MiB, WS_GATEW = 6 * MiB;
constexpr size_t WS_WIN = 8 * MiB, WS_WPA = 18 * MiB, WS_WPB = 19 * MiB, WS_WO = 20 * MiB, WS_WGU = 22 * MiB, WS_WDN = 38 * MiB;
constexpr size_t WS_H = 48 * MiB;
constexpr size_t WS_OUTB = 112 * MiB;
constexpr size_t WS_QA = 128 * MiB, WS_KA = 160 * MiB, WS_VA = 168 * MiB, WS_QD = 176 * MiB, WS_KD = 224 * MiB, WS_VDT = 272 * MiB, WS_G = 320 * MiB;
constexpr size_t WS_MERGED = 160 * MiB;
constexpr size_t WS_TMP = 224 * MiB;
constexpr size_t WS_ACT = 224 * MiB;
constexpr size_t WS_Y2 = 320 * MiB;
constexpr size_t WS_TRASH = 448 * MiB;
constexpr size_t WS_END = 449 * MiB;
constexpr int CW_GCNT = 1024;
constexpr int CW_BAR = 4096;
constexpr int RING_OFF = 0, RING_BYTES = 131072;
constexpr int LDSCTL_OFF = RING_BYTES, MISC_OFF = LDSCTL_OFF + 320;
constexpr int MOETAB_OFF = LDSCTL_OFF + 512;
constexpr int LDS_BYTES = 147456;

struct Frame {
    LAS unsigned char* lds;
    volatile LAS unsigned* MISC;
    gu32* ctl;
    int tid, lane, wave, vcu, G;
};
__device__ __forceinline__ float wave_sum(float v) {
#pragma unroll
    for (int o = 1; o < 64; o <<= 1) v += __shfl_xor(v, o);
    return v;
}
__device__ __forceinline__ float bf2f_(unsigned short b) { return __uint_as_float((unsigned)b << 16); }

__device__ __forceinline__ int hpw_row(int n) { const int c = n & 255; return (n & ~255) + 128 * ((c >> 3) & 1) + 32 * (c >> 6) + 16 * ((c >> 2) & 1) + 4 * ((c >> 4) & 3) + (c & 3); }
__device__ __forceinline__ int gu_row(int f, int which) { return (f >> 7) * 256 + 128 * ((f >> 2) & 1) + 32 * ((f >> 5) & 3) + 16 * which + 4 * ((f >> 3) & 3) + (f & 3); }

template <int MODE>
__device__ __forceinline__ void transpose_item(const float* W, int K, int N, pg8::bf16_t* WT, int row_off, LAS float* scr, int item, int lane) {
    const int nblk = N / 32, kb = item / nblk, nb = item % nblk, k0 = 64 * kb, n0 = 32 * nb;
#pragma unroll 8
    for (int i = 0; i < 32; ++i) { const int kk = 2 * i + (lane >> 5); scr[kk * 33 + (lane & 31)] = W[(size_t)(k0 + kk) * N + n0 + (lane & 31)]; }
    LDS_WAIT(); asm volatile("" ::: "memory");
    const int c = lane & 7;
#pragma unroll
    for (int j = 0; j < 4; ++j) { const int n = (lane >> 3) + 8 * j; const LAS float* s = scr + (8 * c) * 33 + n;
        v4u o; o.x = pk2(s[0 * 33], s[1 * 33]); o.y = pk2(s[2 * 33], s[3 * 33]); o.z = pk2(s[4 * 33], s[5 * 33]); o.w = pk2(s[6 * 33], s[7 * 33]);
        const int drow = row_off + (MODE == 0 ? hpw_row(n0 + n) : gu_row(n0 + n, MODE - 1));
        *(GAS v4u*)(WT + (size_t)drow * K + k0 + 8 * c) = o; }
    LDS_WAIT(); asm volatile("" ::: "memory");
}
struct Weights { const float *w_in, *w_pa, *w_pb, *w_o, *w_g, *w_u, *w_d; };
__device__ __forceinline__ void convert_layer(Frame& F0, const Weights& W, unsigned char* ws) {
    Frame F = F0;
    LAS float* scr = (LAS float*)(F.lds + RING_OFF + F.wave * 16384);
    const int gw = F.vcu * NWAVES + F.wave, NGW = F.G * NWAVES;
    constexpr int I_IN = 16 * 160, I_PA = 8 * 32, I_PB = 4 * 32, I_O = 16 * 32, I_G = 16 * 128, I_D = 16 * 128;
    constexpr int NITEMS = I_IN + I_PA + I_PB + I_O + 2 * I_G + I_D;
    for (int it = gw; it < NITEMS; it += NGW) {
        int r = it;
        if (r < I_IN) { transpose_item<0>(W.w_in, 1024, N_IN, (pg8::bf16_t*)(ws + WS_WIN), 0, scr, r, F.lane); continue; } r -= I_IN;
        if (r < I_PA) { transpose_item<0>(W.w_pa, 512, 1024, (pg8::bf16_t*)(ws + WS_WPA), 0, scr, r, F.lane); continue; } r -= I_PA;
        if (r < I_PB) { transpose_item<0>(W.w_pb, 256, 1024, (pg8::bf16_t*)(ws + WS_WPB), 0, scr, r, F.lane); continue; } r -= I_PB;
        if (r < I_O) { transpose_item<0>(W.w_o, 1024, 1024, (pg8::bf16_t*)(ws + WS_WO), 0, scr, r, F.lane); continue; } r -= I_O;
        if (r < I_G) { const int e = r >> 7; transpose_item<1>(W.w_g + (size_t)e * 1024 * 256, 1024, 256, (pg8::bf16_t*)(ws + WS_WGU), e * 512, scr, r & 127, F.lane); continue; } r -= I_G;
        if (r < I_G) { const int e = r >> 7; transpose_item<2>(W.w_u + (size_t)e * 1024 * 256, 1024, 256, (pg8::bf16_t*)(ws + WS_WGU), e * 512, scr, r & 127, F.lane); continue; } r -= I_G;
        { const int e = r >> 7; transpose_item<0>(W.w_d + (size_t)e * 256 * 1024, 256, 1024, (pg8::bf16_t*)(ws + WS_WDN), e * 1024, scr, r & 127, F.lane); }
    }
}

__device__ __forceinline__ void row_stats(const f32x4 (&v)[4], float& mean, float& rstd) {
    float s = 0.f;
#pragma unroll
    for (int j = 0; j < 4; ++j) s += (v[j].x + v[j].y) + (v[j].z + v[j].w);
    mean = wave_sum(s) * (1.f / DM); float s2 = 0.f;
#pragma unroll
    for (int j = 0; j < 4; ++j) { const f32x4 d = v[j] - mean; s2 += (d.x * d.x + d.y * d.y) + (d.z * d.z + d.w * d.w); }
    rstd = 1.f / sqrtf(wave_sum(s2) * (1.f / DM) + LN_EPS);
}
__device__ __forceinline__ void store_row_bf16(pg8::bf16_t* orow, int lane, const f32x4 (&v)[4]) {
    GAS unsigned long long* o8 = (GAS unsigned long long*)orow + lane;
#pragma unroll
    for (int j = 0; j < 4; ++j) o8[64 * j] = (unsigned long long)pk2(v[j].x, v[j].y) | ((unsigned long long)pk2(v[j].z, v[j].w) << 32);
}

__device__ __forceinline__ void phase_pr0(Frame& F, const float* c, const float* w_ada, const float* b_ada, float* mod, float* rope, const Weights& W0, unsigned char* ws) {
    LAS float* condT = (LAS float*)(F.lds);
    LAS float* red = (LAS float*)(F.lds + 65536);
    for (int idx = F.tid; idx < 16 * 1024; idx += NWAVES * 64) { const int b = idx >> 10, k = idx & 1023; const float x = c[idx]; condT[k * 16 + b] = x / (1.f + __expf(-x)); }
    __syncthreads();
    for (int it = F.vcu; it < 4 * 96; it += F.G) {
        const int l = it / 96, cb = it % 96, n = cb * 64 + F.lane;
        const float* wp = w_ada + ((size_t)l * 1024 + F.wave * 128) * 6144 + n;
        float a[16];
#pragma unroll
        for (int b = 0; b < 16; ++b) a[b] = 0.f;
#pragma unroll 4
        for (int k = 0; k < 128; ++k) {
            const float wv = wp[(size_t)k * 6144];
            const LAS f32x4* cp = (const LAS f32x4*)(condT + (F.wave * 128 + k) * 16);
#pragma unroll
            for (int q = 0; q < 4; ++q) { const f32x4 cv = cp[q]; a[4 * q] += wv * cv.x; a[4 * q + 1] += wv * cv.y; a[4 * q + 2] += wv * cv.z; a[4 * q + 3] += wv * cv.w; }
        }
#pragma unroll
        for (int b = 0; b < 16; ++b) red[(F.wave * 16 + b) * 64 + F.lane] = a[b];
        __syncthreads();
        for (int o = F.tid; o < 1024; o += NWAVES * 64) { const int b = o >> 6, nn = o & 63; float s = b_ada[(size_t)l * 6144 + cb * 64 + nn];
#pragma unroll
            for (int w = 0; w < 8; ++w) s += red[(w * 16 + b) * 64 + nn];
            mod[((size_t)l * 16 + b) * 6144 + cb * 64 + nn] = s; }
        __syncthreads();
    }
    if (F.vcu == 0 && F.tid < 16) {
        const int k = F.tid; double th = 1.0; for (int i = 0; i < k; ++i) th *= 0.5623413251903491;
        double c1 = 1.0, s1 = th; { double tc = 1.0, tsn = th; const double t2 = th * th;
            for (int i = 1; i < 14; ++i) { tc *= -t2 / ((2.0 * i - 1.0) * (2.0 * i)); tsn *= -t2 / ((2.0 * i) * (2.0 * i + 1.0)); c1 += tc; s1 += tsn; } }
        double cc = 1.0, sn = 0.0;
        for (int a = 0; a < 64; ++a) { rope[(a * 16 + k) * 2] = (float)cc; rope[(a * 16 + k) * 2 + 1] = (float)sn; const double nc = cc * c1 - sn * s1, ns = sn * c1 + cc * s1; cc = nc; sn = ns; }
    }
    __syncthreads();
    convert_layer(F, W0, ws);
}
__device__ __forceinline__ void phase_pr1(Frame& F, const float* x, const float* mod0, pg8::bf16_t* H) {
    for (int blk = F.vcu; blk < T_TOK / 128; blk += F.G) {
        const int b = blk >> 4; const float* mb = mod0 + (size_t)b * 6144;
        f32x4 sh[4], sc[4];
#pragma unroll
        for (int j = 0; j < 4; ++j) { sh[j] = *(const f32x4*)(mb + 4 * F.lane + 256 * j); sc[j] = *(const f32x4*)(mb + 1024 + 4 * F.lane + 256 * j) + 1.0f; }
        for (int k = 0; k < 16; ++k) {
            const int row = blk * 128 + F.wave * 16 + k; const GAS f32x4* xr = (const GAS f32x4*)(x + (size_t)row * DM) + F.lane;
            f32x4 v[4];
#pragma unroll
            for (int j = 0; j < 4; ++j) v[j] = xr[64 * j];
            float mean, rstd; row_stats(v, mean, rstd);
#pragma unroll
            for (int j = 0; j < 4; ++j) v[j] = (v[j] - mean) * rstd * sc[j] + sh[j];
            store_row_bf16(H + (size_t)row * DM, F.lane, v);
        }
    }
}
__device__ __forceinline__ void phase_ln1(Frame& F0, float* xb, const float* ln_g, const float* ln_b, const float* modl, const float* w_router, const float* rbias,
                                          pg8::bf16_t* H, int* rowlist, float* gatew, gu32* gcnt) {
    Frame F = F0;
    LAS float* wr = (LAS float*)(F.lds);
    LAS float* cst = (LAS float*)(F.lds + 65536);
    LAS int* lcnt = (LAS int*)(F.lds + 81920);
    LAS int* gbase = lcnt + 16;
    LAS int* st_e = lcnt + 32;
    LAS float* st_g = (LAS float*)(lcnt + 32 + 256);
    for (int idx = F.tid; idx < 16 * 1024; idx += NWAVES * 64) wr[(idx & 15) * 1024 + (idx >> 4)] = w_router[idx];
    float rb[16];
#pragma unroll
    for (int e = 0; e < 16; ++e) rb[e] = rbias[e];
    for (int blk = F.vcu; blk < T_TOK / 128; blk += F.G) {
        const int b = blk >> 4; const float* mb = modl + (size_t)b * 6144;
        __syncthreads();
        for (int idx = F.tid; idx < 1024; idx += NWAVES * 64) { cst[idx] = ln_g[idx]; cst[1024 + idx] = ln_b[idx]; cst[2048 + idx] = 1.0f + mb[4 * 1024 + idx]; cst[3072 + idx] = mb[3 * 1024 + idx]; }
        if (F.tid < 16) lcnt[F.tid] = 0;
        __syncthreads();
        for (int it = 0; it < 4; ++it) {
            float hq[4][16];
#pragma unroll
            for (int q = 0; q < 4; ++q) {
                const int row = blk * 128 + F.wave * 16 + it * 4 + q; GAS f32x4* xr = (GAS f32x4*)(xb + (size_t)row * DM) + F.lane;
                f32x4 v[4];
#pragma unroll
                for (int j = 0; j < 4; ++j) v[j] = xr[64 * j];
                float mean, rstd; row_stats(v, mean, rstd);
#pragma unroll
                for (int j = 0; j < 4; ++j) { const f32x4 g4 = *(const LAS f32x4*)(cst + 4 * F.lane + 256 * j), b4 = *(const LAS f32x4*)(cst + 1024 + 4 * F.lane + 256 * j);
                    v[j] = (v[j] - mean) * rstd * g4 + b4; xr[64 * j] = v[j]; }
                row_stats(v, mean, rstd);
#pragma unroll
                for (int j = 0; j < 4; ++j) { const f32x4 s4 = *(const LAS f32x4*)(cst + 2048 + 4 * F.lane + 256 * j), h4 = *(const LAS f32x4*)(cst + 3072 + 4 * F.lane + 256 * j);
                    v[j] = (v[j] - mean) * rstd * s4 + h4; hq[q][4 * j] = v[j].x; hq[q][4 * j + 1] = v[j].y; hq[q][4 * j + 2] = v[j].z; hq[q][4 * j + 3] = v[j].w; }
                store_row_bf16(H + (size_t)row * DM, F.lane, v);
            }
            float ac[4][16];
#pragma unroll
            for (int e = 0; e < 16; ++e) {
                float a0 = 0.f, a1 = 0.f, a2 = 0.f, a3 = 0.f;
#pragma unroll
                for (int j = 0; j < 4; ++j) { const f32x4 w4 = *(const LAS f32x4*)(wr + e * 1024 + 256 * j + 4 * F.lane);
                    a0 += hq[0][4 * j] * w4.x + hq[0][4 * j + 1] * w4.y + hq[0][4 * j + 2] * w4.z + hq[0][4 * j + 3] * w4.w;
                    a1 += hq[1][4 * j] * w4.x + hq[1][4 * j + 1] * w4.y + hq[1][4 * j + 2] * w4.z + hq[1][4 * j + 3] * w4.w;
                    a2 += hq[2][4 * j] * w4.x + hq[2][4 * j + 1] * w4.y + hq[2][4 * j + 2] * w4.z + hq[2][4 * j + 3] * w4.w;
                    a3 += hq[3][4 * j] * w4.x + hq[3][4 * j + 1] * w4.y + hq[3][4 * j + 2] * w4.z + hq[3][4 * j + 3] * w4.w; }
                ac[0][e] = wave_sum(a0); ac[1][e] = wave_sum(a1); ac[2][e] = wave_sum(a2); ac[3][e] = wave_sum(a3);
            }
#pragma unroll
            for (int q = 0; q < 4; ++q) {
                float scv[16], sel[16];
#pragma unroll
                for (int e = 0; e < 16; ++e) { scv[e] = 1.0f / (1.0f + __expf(-ac[q][e])); sel[e] = scv[e] + rb[e]; }
                float gs[4];
#pragma unroll
                for (int g = 0; g < 4; ++g) { const float a = sel[4 * g], bb = sel[4 * g + 1], cc = sel[4 * g + 2], d = sel[4 * g + 3];
                    const float hi1 = fmaxf(a, bb), lo1 = fminf(a, bb), hi2 = fmaxf(cc, d), lo2 = fminf(cc, d);
                    gs[g] = fmaxf(hi1, hi2) + fmaxf(fminf(hi1, hi2), fmaxf(lo1, lo2)); }
                int best = 0; float bv = gs[0];
#pragma unroll
                for (int g = 1; g < 4; ++g) if (gs[g] > bv) { bv = gs[g]; best = g; }
                float s4[4], c4[4];
#pragma unroll
                for (int k = 0; k < 4; ++k) { s4[k] = best == 0 ? sel[k] : best == 1 ? sel[4 + k] : best == 2 ? sel[8 + k] : sel[12 + k];
                                              c4[k] = best == 0 ? scv[k] : best == 1 ? scv[4 + k] : best == 2 ? scv[8 + k] : scv[12 + k]; }
                int i1 = 0; float v1 = s4[0];
#pragma unroll
                for (int k = 1; k < 4; ++k) if (s4[k] > v1) { v1 = s4[k]; i1 = k; }
                int i2 = -1; float v2 = -INFINITY;
#pragma unroll
                for (int k = 0; k < 4; ++k) if (k != i1 && s4[k] > v2) { v2 = s4[k]; i2 = k; }
                if (i2 < 0) i2 = (i1 + 1) & 3;
                const float t1 = i1 == 0 ? c4[0] : i1 == 1 ? c4[1] : i1 == 2 ? c4[2] : c4[3];
                const float t2 = i2 == 0 ? c4[0] : i2 == 1 ? c4[1] : i2 == 2 ? c4[2] : c4[3];
                const float inv = 1.0f / (t1 + t2);
                if (F.lane == 0) {
                    const int rl = F.wave * 16 + it * 4 + q, e1 = 4 * best + i1, e2 = 4 * best + i2;
                    const int p1 = atomicAdd((int*)(lcnt + e1), 1), p2 = atomicAdd((int*)(lcnt + e2), 1);
                    st_e[2 * rl] = e1 | (p1 << 8); st_g[2 * rl] = t1 * inv; st_e[2 * rl + 1] = e2 | (p2 << 8); st_g[2 * rl + 1] = t2 * inv;
                }
            }
        }
        __syncthreads();
        if (F.tid < 16) gbase[F.tid] = (int)__hip_atomic_fetch_add(gcnt + F.tid, (unsigned)lcnt[F.tid], __ATOMIC_RELAXED, __HIP_MEMORY_SCOPE_AGENT);
        __syncthreads();
        if (F.tid < 256) { const int ee = st_e[F.tid], e = ee & 255, lp = ee >> 8, pos = gbase[e] + lp;
            rowlist[(size_t)e * CAP + pos] = ((blk * 128 + (F.tid >> 1)) << 1) | (F.tid & 1); gatew[(size_t)e * CAP + pos] = st_g[F.tid]; }
    }
    __syncthreads();
}
__device__ __forceinline__ void phase_ln2(Frame& F0, float* xb, const pg8::bf16_t* y2, const float* ln_g, const float* ln_b, const float* modl, const float* modn, pg8::bf16_t* H) {
    Frame F = F0;
    for (int blk = F.vcu; blk < T_TOK / 128; blk += F.G) {
        const int b = blk >> 4; const float* mb = modl + (size_t)b * 6144 + 5 * 1024;
        for (int k = 0; k < 16; ++k) {
            const int row = blk * 128 + F.wave * 16 + k; GAS f32x4* xr = (GAS f32x4*)(xb + (size_t)row * DM) + F.lane;
            const GAS u32x2g* ya = (const GAS u32x2g*)(y2 + (size_t)row * DM) + F.lane; const GAS u32x2g* yb = (const GAS u32x2g*)(y2 + ((size_t)T_TOK + row) * DM) + F.lane;
            f32x4 v[4];
#pragma unroll
            for (int j = 0; j < 4; ++j) { const f32x4 xv = xr[64 * j]; const u32x2g a = ya[64 * j], c = yb[64 * j]; const f32x4 g2 = *(const f32x4*)(mb + 4 * F.lane + 256 * j);
                f32x4 f; f.x = __uint_as_float(a.x << 16) + __uint_as_float(c.x << 16); f.y = __uint_as_float(a.x & 0xffff0000u) + __uint_as_float(c.x & 0xffff0000u);
                f.z = __uint_as_float(a.y << 16) + __uint_as_float(c.y << 16); f.w = __uint_as_float(a.y & 0xffff0000u) + __uint_as_float(c.y & 0xffff0000u);
                v[j] = xv * DN_ALPHA + g2 * f; }
            float mean, rstd; row_stats(v, mean, rstd);
#pragma unroll
            for (int j = 0; j < 4; ++j) { const f32x4 g4 = *(const f32x4*)(ln_g + 4 * F.lane + 256 * j), b4 = *(const f32x4*)(ln_b + 4 * F.lane + 256 * j);
                v[j] = (v[j] - mean) * rstd * g4 + b4; xr[64 * j] = v[j]; }
            if (modn) {
                const float* mn = modn + (size_t)b * 6144;
                row_stats(v, mean, rstd);
#pragma unroll
                for (int j = 0; j < 4; ++j) { const f32x4 s4 = *(const f32x4*)(mn + 1024 + 4 * F.lane + 256 * j) + 1.0f, h4 = *(const f32x4*)(mn + 4 * F.lane + 256 * j);
                    v[j] = (v[j] - mean) * rstd * s4 + h4; }
                store_row_bf16(H + (size_t)row * DM, F.lane, v);
            }
        }
    }
}
__device__ __forceinline__ void moe_table(Frame& F, gu32* gcnt) {
    LAS int* tab = (LAS int*)(F.lds + MOETAB_OFF);
    __syncthreads();
    if (F.tid == 0) { int acc = 0;
        for (int e = 0; e < 16; ++e) { int c = (int)__hip_atomic_load(gcnt + e, __ATOMIC_RELAXED, __HIP_MEMORY_SCOPE_AGENT); if (c > CAP) c = CAP; if (c < 0) c = 0; tab[e] = c; tab[16 + e] = acc; acc += (c + 255) >> 8; }
        tab[32] = acc; }
    __syncthreads();
}
struct Args { const float* in[19]; float* out; unsigned char* ws; int ph_lo, ph_hi; };
typedef const __attribute__((address_space(4))) Args* KArgs;
__device__ __forceinline__ Weights layer_weights(KArgs ap_, int l) {
    struct { const float* in[19]; } a; a.in[4] = ap_->in[4]; a.in[7] = ap_->in[7]; a.in[8] = ap_->in[8]; a.in[9] = ap_->in[9]; a.in[14] = ap_->in[14]; a.in[15] = ap_->in[15]; a.in[16] = ap_->in[16];
    Weights W; W.w_in = a.in[4] + (size_t)l * 1024 * N_IN; W.w_pa = a.in[7] + (size_t)l * 512 * 1024; W.w_pb = a.in[8] + (size_t)l * 256 * 1024; W.w_o = a.in[9] + (size_t)l * 1024 * 1024;
    W.w_g = a.in[14] + (size_t)l * 16 * 1024 * 256; W.w_u = a.in[15] + (size_t)l * 16 * 1024 * 256; W.w_d = a.in[16] + (size_t)l * 16 * 256 * 1024; return W;
}
#ifndef SKIPMASK
#define SKIPMASK 0
#endif
#define IN(k) (lo <= (k) && (k) < hi && !(((k) >= 2) && ((SKIPMASK >> (((k) - 2) & 7)) & 1)) && !(((k) < 2) && ((SKIPMASK >> (8 + (k))) & 1)))
#define SEAM(k) do { if (IN(k) && IN((k) + 1)) { XcdBarrier b2_ = bar; asm volatile("" : "+s"(b2_.x), "+s"(b2_.bar)); int w0_ = F.wave; asm volatile("" : "+s"(w0_)); xcd_barrier(b2_, w0_ == 0 && hw_lane() == 0); } } while (0)
#define PHASE_ARGS KArgs ap = kargs; int bx_ = (int)blockIdx.x; Frame FF = F; asm volatile("" : "+s"(ap), "+s"(bx_), "+s"(FF.G), "+s"(FF.vcu), "+s"(FF.wave)); FF.lane = hw_lane(); FF.tid = FF.wave * 64 + FF.lane; unsigned char* const ws = ap->ws; (void)ws; (void)bx_
template <int l>
__device__ __forceinline__ void layer_phases(Frame& F, const KArgs kargs, const int lo, const int hi, const XcdBarrier& bar, unsigned char* lds) {
    using pg8::bf16_t;
    const LAS int* tab = (const LAS int*)(F.lds + MOETAB_OFF);
    {
        const int P = 2 + 8 * l;
        if (IN(P + 0)) {
            PHASE_ARGS;
            pg8::Gemm g{(const bf16_t*)(ws + WS_H), (const bf16_t*)(ws + WS_WIN), T_TOK, N_IN, 1024}; pg8::StaticOrder S; S.init(T_TOK, N_IN, FF.G, bx_);
            pg8::EpiIn E{(bf16_t*)(ws + WS_QA), (bf16_t*)(ws + WS_KA), (bf16_t*)(ws + WS_VA), (bf16_t*)(ws + WS_QD), (bf16_t*)(ws + WS_KD), (bf16_t*)(ws + WS_VDT), (bf16_t*)(ws + WS_G),
                         ap->in[5] + l * 64, ap->in[6] + l * 64, (const float*)(ws + WS_ROPE)};
            pg8::gemm_phase<pg8::EpiIn, pg8::StaticOrder, true>(F.lds + RING_OFF, g, S, E, FF.wave);
            SEAM(P + 0);
        }
        if (IN(P + 1)) {
            PHASE_ARGS;
            const attn_body::AttnTensors AT{(const attn_body::bf16*)(ws + WS_QA), (const attn_body::bf16*)(ws + WS_KA), (const attn_body::bf16*)(ws + WS_VA), (attn_body::bf16*)(ws + WS_QA)};
            const attn_body::StaticOrder S(FF.G, bx_);
            attn_body::attn_phase<attn_body::StaticOrder>((char*)lds + RING_OFF, AT, S, FF.wave);
            { const int ln_ = FF.lane;
              for (int tk = FF.vcu * NWAVES + FF.wave; tk < attnb::NTASK; tk += FF.G * NWAVES)
                  attnb::task(tk, (const bf16_t*)(ws + WS_QD), (const bf16_t*)(ws + WS_KD), (const bf16_t*)(ws + WS_VDT), (bf16_t*)(ws + WS_OUTB), ln_); }
            SEAM(P + 1);
        }
        if (IN(P + 2)) {
            PHASE_ARGS;
            { pg8::Gemm g{(const bf16_t*)(ws + WS_QA), (const bf16_t*)(ws + WS_WPA), T_TOK, 1024, 512}; pg8::StaticOrder S; S.init(T_TOK, 1024, FF.G, bx_);
              pg8::EpiMerge<false> E{(const bf16_t*)(ws + WS_G), (bf16_t*)(ws + WS_TMP), (bf16_t*)(ws + WS_MERGED)};
              pg8::gemm_phase<pg8::EpiMerge<false>, pg8::StaticOrder, true>(F.lds + RING_OFF, g, S, E, FF.wave); }
            VM_WAIT(); __builtin_amdgcn_fence(__ATOMIC_ACQUIRE, "agent"); VM_WAIT(); __syncthreads();
            { pg8::Gemm g{(const bf16_t*)(ws + WS_OUTB), (const bf16_t*)(ws + WS_WPB), T_TOK, 1024, 256}; pg8::StaticOrder S; S.init(T_TOK, 1024, FF.G, bx_);
              pg8::EpiMerge<true> E{(const bf16_t*)(ws + WS_G), (bf16_t*)(ws + WS_TMP), (bf16_t*)(ws + WS_MERGED)};
              pg8::gemm_phase<pg8::EpiMerge<true>, pg8::StaticOrder, true>(F.lds + RING_OFF, g, S, E, FF.wave); }
            SEAM(P + 2);
        }
        if (IN(P + 3)) {
            PHASE_ARGS;
            pg8::Gemm g{(const bf16_t*)(ws + WS_MERGED), (const bf16_t*)(ws + WS_WO), T_TOK, 1024, 1024}; pg8::StaticOrder S; S.init(T_TOK, 1024, FF.G, bx_);
            pg8::EpiRes E{l == 0 ? ap->in[0] : (const float*)ap->out, ap->out, (const float*)(ws + WS_MOD) + (size_t)l * 16 * 6144 + 2 * 1024};
            pg8::gemm_phase<pg8::EpiRes, pg8::StaticOrder, true>(F.lds + RING_OFF, g, S, E, FF.wave);
            SEAM(P + 3);
        }
        if (IN(P + 4)) {
            PHASE_ARGS;
            phase_ln1(FF, ap->out, ap->in[10] + l * 1024, ap->in[11] + l * 1024, (const float*)(ws + WS_MOD) + (size_t)l * 16 * 6144, ap->in[12], ap->in[13], (bf16_t*)(ws + WS_H),
                      (int*)(ws + WS_ROWLIST), (float*)(ws + WS_GATEW), F.ctl + CW_GCNT + 64 * l);
            SEAM(P + 4);
        }
        if (IN(P + 5)) {
            PHASE_ARGS;
            moe_table(FF, F.ctl + CW_GCNT + 64 * l);
            pg8::Gemm g{(const bf16_t*)(ws + WS_H), (const bf16_t*)(ws + WS_WGU), T_TOK, 512, 1024};
            pg8::MoeOrder<true> S{tab, (const int*)(ws + WS_ROWLIST), 2, FF.G, bx_};
            pg8::EpiGU E{(bf16_t*)(ws + WS_ACT), (const float*)(ws + WS_GATEW), tab};
            pg8::gemm_phase<pg8::EpiGU, pg8::MoeOrder<true>, true, true>(F.lds + RING_OFF, g, S, E, FF.wave);
            SEAM(P + 5);
        }
        if (IN(P + 6)) {
            PHASE_ARGS;
            moe_table(FF, F.ctl + CW_GCNT + 64 * l);
            pg8::Gemm g{(const bf16_t*)(ws + WS_ACT), (const bf16_t*)(ws + WS_WDN), T_TOK, 1024, 256};
            pg8::MoeOrder<false> S{tab, (const int*)(ws + WS_ROWLIST), 4, FF.G, bx_};
            pg8::EpiDown E{(bf16_t*)(ws + WS_Y2), (const int*)(ws + WS_ROWLIST), tab};
            pg8::gemm_phase<pg8::EpiDown, pg8::MoeOrder<false>, true>(F.lds + RING_OFF, g, S, E, FF.wave);
            SEAM(P + 6);
        }
        if (IN(P + 7)) {
            PHASE_ARGS;
            const float* modl = (const float*)(ws + WS_MOD) + (size_t)l * 16 * 6144;
            phase_ln2(FF, ap->out, (const bf16_t*)(ws + WS_Y2), ap->in[17] + l * 1024, ap->in[18] + l * 1024, modl, l + 1 < DEPTH ? modl + 16 * 6144 : nullptr, (bf16_t*)(ws + WS_H));
            if (l + 1 < DEPTH) { __syncthreads(); const Weights Wn = layer_weights(ap, l + 1); convert_layer(FF, Wn, ws); }
            SEAM(P + 7);
        }
    }
}
__global__ void __launch_bounds__(NWAVES * 64, 2) fwd_kernel(Args args_unused) {
    extern __shared__ __attribute__((aligned(16))) unsigned char lds[];
    Frame F;
    F.lds = (LAS unsigned char*)lds;
    F.MISC = (volatile LAS unsigned*)(F.lds + MISC_OFF);
    F.wave = __builtin_amdgcn_readfirstlane((int)threadIdx.x >> 6); F.lane = hw_lane(); F.tid = F.wave * 64 + F.lane;
    F.G = gridDim.x; { const int bx = blockIdx.x; F.vcu = (F.G % 8 == 0) ? (bx % 8) * (F.G / 8) + bx / 8 : bx; }
    const KArgs kargs = (KArgs)__builtin_amdgcn_kernarg_segment_ptr();
    F.ctl = (gu32*)(kargs->ws + WS_CTL);
    for (int u = F.tid; u < (LDS_BYTES - LDSCTL_OFF) / 4; u += NWAVES * 64) ((LAS unsigned*)(F.lds + LDSCTL_OFF))[u] = 0u;
    __syncthreads();
    const int lo = kargs->ph_lo, hi = kargs->ph_hi;
    XcdBarrier bar; bar.bar = (unsigned*)(F.ctl + CW_BAR); bar.x = 0; bar.st = nullptr;
    if (hi - lo > 1) bar = xcd_barrier_post((unsigned*)(F.ctl + CW_BAR), F.MISC + 8);
    using pg8::bf16_t;
    const LAS int* tab = (const LAS int*)(F.lds + MOETAB_OFF);

    if (IN(0)) { PHASE_ARGS; const Weights W0 = layer_weights(ap, 0); phase_pr0(FF, ap->in[1], ap->in[2], ap->in[3], (float*)(ws + WS_MOD), (float*)(ws + WS_ROPE), W0, ws); SEAM(0); }
    if (IN(1)) { PHASE_ARGS; phase_pr1(FF, ap->in[0], (const float*)(ws + WS_MOD), (bf16_t*)(ws + WS_H)); SEAM(1); }

    layer_phases<0>(F, kargs, lo, hi, bar, lds); layer_phases<1>(F, kargs, lo, hi, bar, lds); layer_phases<2>(F, kargs, lo, hi, bar, lds); layer_phases<3>(F, kargs, lo, hi, bar, lds);
#undef IN
#undef SEAM
#undef PHASE_ARGS
}

extern "C" void kernel_launch(void* const* d_in, const int* in_sizes, int n_in, void* d_out, int out_size, void* d_ws, size_t ws_size, hipStream_t stream) {
    static int grid = 0;
    if (grid == 0) {
        if (n_in != 19 || in_sizes[0] != T_TOK * DM || out_size != T_TOK * DM || ws_size < WS_END) { fprintf(stderr, "kernel_launch: unexpected shapes/workspace (n_in %d, ws %zu); nothing launched\n", n_in, ws_size); grid = -1; return; }
        int dev = 0, cus = 0, per_cu = 0;
        if (hipGetDevice(&dev) != hipSuccess || hipDeviceGetAttribute(&cus, hipDeviceAttributeMultiprocessorCount, dev) != hipSuccess) { grid = -1; return; }
        if (hipFuncSetAttribute((const void*)fwd_kernel, hipFuncAttributeMaxDynamicSharedMemorySize, LDS_BYTES) != hipSuccess) { fprintf(stderr, "kernel_launch: hipFuncSetAttribute failed\n"); grid = -1; return; }
        if (hipOccupancyMaxActiveBlocksPerMultiprocessor(&per_cu, (const void*)fwd_kernel, NWAVES * 64, LDS_BYTES) != hipSuccess || per_cu < 1) { fprintf(stderr, "kernel_launch: occupancy query reports %d\n", per_cu); }
        (void)hipGetLastError();
        grid = cus;
    }
    if (grid < 0) return;
    if (hipMemsetAsync((char*)d_ws + WS_CTL, 0, CTL_ZERO_BYTES, stream) != hipSuccess) return;
    Args a{};
    for (int i = 0; i < 19; ++i) a.in[i] = (const float*)d_in[i];
    a.out = (float*)d_out; a.ws = (unsigned char*)d_ws;
#if MK_N_LAUNCHES == 1
    a.ph_lo = 0; a.ph_hi = N_PHASES;
    hipLaunchKernelGGL(fwd_kernel, dim3(grid), dim3(NWAVES * 64), LDS_BYTES, stream, a);
#else
    for (int p = 0; p < N_PHASES; ++p) { a.ph_lo = p; a.ph_hi = p + 1; hipLaunchKernelGGL(fwd_kernel, dim3(grid), dim3(NWAVES * 64), LDS_BYTES, stream, a); }
#endif
}
```

```cpp
#include <hip/hip_runtime.h>
#include <hip/hip_bf16.h>
#include <cstdio>
#include <cstdint>
#include <cmath>
__device__ __forceinline__ int hw_lane() { int l; asm volatile("v_mbcnt_lo_u32_b32 %0, -1, 0\n\tv_mbcnt_hi_u32_b32 %0, -1, %0" : "=v"(l)); return l; }
namespace pg8 {
#define PG8_LAS __attribute__((address_space(3)))
typedef unsigned short bf16_t;
typedef short bf16x8 __attribute__((ext_vector_type(8)));
typedef float f32x4 __attribute__((ext_vector_type(4)));
typedef unsigned u32x4 __attribute__((ext_vector_type(4)));
typedef unsigned u32x2 __attribute__((ext_vector_type(2)));
typedef int i32x4 __attribute__((ext_vector_type(4)));
typedef int i32x8 __attribute__((ext_vector_type(8)));
constexpr int BM = 256, BK = 64, HALF = 128, HTB = HALF * BK * 2  , STAGE_BYTES = 8 * HTB, NXCD = 8, WGM = 8;

__host__ __device__ __forceinline__ int lds_byte(int r, int c) { const int st = (r >> 4) * 2 + (c >> 5), rr = r & 15, cc = c & 31, ob = rr * 64 + cc * 2; return st * 1024 + (ob ^ (((ob >> 9) & 1) << 5)); }
__host__ __device__ __forceinline__ void stage_rc(int b, int& R, int& C) { const int st = b / 1024, sb = b % 1024, swz = sb ^ (((sb >> 9) & 1) << 5); R = (st >> 1) * 16 + swz / 64; C = (st & 1) * 32 + (swz % 64) / 2; }

struct Unit { int pm, pn, e, lt; };
struct Gemm { const bf16_t* A; const bf16_t* Bt; int M, N, K; };

struct StaticOrder {
    int nM, nN, nwg, G, c;
    __host__ __device__ void init(int M, int N, int G_, int c_) { nM = M / BM; nN = N / BM; nwg = nM * nN; G = G_; c = c_; }
    __host__ __device__ bool next(int i, Unit& u) const {
        const long L = (long)i * G + c; if (L >= nwg) return false;
        int wgid = (int)L; { const int q = nwg / NXCD, r = nwg % NXCD, xcd = wgid % NXCD, off = wgid / NXCD; wgid = (xcd < r ? xcd * (q + 1) : r * (q + 1) + (xcd - r) * q) + off; }
        const int nig = WGM * nN, gid = wgid / nig, fm = gid * WGM, gsz = (nM - fm) < WGM ? (nM - fm) : WGM;
        u.pm = fm + ((wgid % nig) % gsz); u.pn = (wgid % nig) / gsz; u.e = 0; u.lt = 0; return true;
    }
    __device__ __forceinline__ int arow(const Unit& u, int R) const { return u.pm * BM + R; }
};

__device__ __forceinline__ unsigned cvt_pk_bf16(float lo, float hi) { unsigned r; asm volatile("v_cvt_pk_bf16_f32 %0, %1, %2" : "=v"(r) : "v"(lo), "v"(hi)); return r; }

template <class Epi, class Sched, bool ALIGN_EPI, bool GATHER = false, bool FP8 = false, bool MID = false>
__device__ __forceinline__ void gemm_phase(PG8_LAS unsigned char* lds, const Gemm g, const Sched& S, const Epi& E, const int wave) {
    const int lane = hw_lane(), wid = wave, tid = wid * 64 + lane,
              wr = wid >> 2, wc = wid & 3, fr = lane & 15, fq = lane >> 4;
    const int K = g.K, RB = FP8 ? K : 2 * K  , nt = RB / (BK * 2);
    unsigned voffB[2];
#pragma unroll
    for (int i = 0; i < 2; ++i) { int R_, C_; stage_rc(tid * 16 + i * 8192, R_, C_); voffB[i] = (unsigned)(R_ * RB + C_ * 2); }
    const size_t kstep = (size_t)(BK * 2);
    const size_t hstep = (size_t)HALF * RB;
    const size_t tstep = 2 * hstep;
    const unsigned ldsw = (unsigned)wid * 1024u;
    const int aoff = lds_byte(wr * 64 + fr, fq * 8), boff = lds_byte(wc * 32 + fr, fq * 8);
#define PG8_SA(b, h) (((b) * 2 + (h)) * HTB)
#define PG8_SB(b, h) ((4 + (b) * 2 + (h)) * HTB)
#define PG8_STAGE(bufoff, gbase, voff) do { _Pragma("unroll") for (int _i = 0; _i < 2; ++_i) \
        __builtin_amdgcn_global_load_lds((const unsigned*)((const char*)(gbase) + (voff)[_i]), (PG8_LAS unsigned*)(lds + (bufoff) + ldsw + _i * 8192), 16, 0, 0); } while (0)
#define PG8_LDA(dst, b, h) do { _Pragma("unroll") for (int m = 0; m < 4; ++m) { if constexpr (FP8) { \
            const i32x4 l0_ = *(const PG8_LAS i32x4*)(lds + PG8_SA(b, h) + aoff + m * 2048), l1_ = *(const PG8_LAS i32x4*)(lds + PG8_SA(b, h) + aoff + m * 2048 + 1024); \
            dst##8[m] = __builtin_shufflevector(l0_, l1_, 0, 1, 2, 3, 4, 5, 6, 7); } \
        else { _Pragma("unroll") for (int k = 0; k < 2; ++k) dst[m][k] = *(const PG8_LAS bf16x8*)(lds + PG8_SA(b, h) + aoff + m * 2048 + k * 1024); } } } while (0)
#define PG8_LDB(dst, b, h) do { _Pragma("unroll") for (int n = 0; n < 2; ++n) { if constexpr (FP8) { \
            const i32x4 l0_ = *(const PG8_LAS i32x4*)(lds + PG8_SB(b, h) + boff + n * 2048), l1_ = *(const PG8_LAS i32x4*)(lds + PG8_SB(b, h) + boff + n * 2048 + 1024); \
            dst##8[n] = __builtin_shufflevector(l0_, l1_, 0, 1, 2, 3, 4, 5, 6, 7); } \
        else { _Pragma("unroll") for (int k = 0; k < 2; ++k) dst[n][k] = *(const PG8_LAS bf16x8*)(lds + PG8_SB(b, h) + boff + n * 2048 + k * 1024); } } } while (0)
#define PG8_MMA(ai, bj, At, Bt) do { __builtin_amdgcn_s_setprio(1); _Pragma("unroll") for (int m = 0; m < 4; ++m) _Pragma("unroll") for (int n = 0; n < 2; ++n) { \
        if constexpr (FP8) { asm volatile("v_mfma_f32_16x16x128_f8f6f4 %0, %1, %2, %0" : "+v"(acc[ai][bj][m][n]) : "v"(Bt##8[n]), "v"(At##8[m])); }   \
        else { _Pragma("unroll") for (int k = 0; k < 2; ++k) acc[ai][bj][m][n] = __builtin_amdgcn_mfma_f32_16x16x32_bf16(Bt[n][k], At[m][k], acc[ai][bj][m][n], 0, 0, 0); } } \
        __builtin_amdgcn_s_setprio(0); } while (0)
#define PG8_WAIT_V(n) asm volatile("s_waitcnt vmcnt(" #n ")" ::: "memory")
#define PG8_WAIT_V8R(rx) do { if (rx) PG8_WAIT_V(24); else PG8_WAIT_V(8); } while (0)
#define PG8_WAIT_L(n) asm volatile("s_waitcnt lgkmcnt(" #n ")" ::: "memory")
#define PG8_BAR __builtin_amdgcn_s_barrier()
#define PG8_SCHED __builtin_amdgcn_sched_barrier(0)
#define PG8_AOFF(dst, u) do { if constexpr (GATHER) { _Pragma("unroll") for (int _h = 0; _h < 2; ++_h) _Pragma("unroll") for (int _i = 0; _i < 2; ++_i) { int R_, C_; stage_rc(tid * 16 + _i * 8192, R_, C_); \
        dst[_h][_i] = (unsigned)S.arow(u, _h * HALF + R_) * (unsigned)RB + (unsigned)(C_ * 2); } } } while (0)
#define PG8_STAGE_A(bufoff, base, h, NXT) do { if constexpr (GATHER) { if (NXT) PG8_STAGE(bufoff, base, o2[h]); else PG8_STAGE(bufoff, base, voA[h]); } else { PG8_STAGE(bufoff, (base) + (h) * hstep, voffB); } } while (0)
    Unit cur, nxt; int ui = 0; bool relax = false;
    if (!S.next(0, cur)) return;
    f32x4 acc[2][2][4][2];
#pragma unroll
    for (int a = 0; a < 2; ++a)
#pragma unroll
        for (int b = 0; b < 2; ++b)
#pragma unroll
            for (int m = 0; m < 4; ++m)
#pragma unroll
                for (int n = 0; n < 2; ++n) acc[a][b][m][n] = (f32x4){0.f, 0.f, 0.f, 0.f};
    bf16x8 At[4][2], B0[2][2], B1[2][2];
    i32x8 At8[4], B08[2], B18[2];
    unsigned voA[2][2], voN[2][2], o2[2][2];
    PG8_AOFF(voA, cur);
    const char* cA = GATHER ? (const char*)g.A : (const char*)g.A + (size_t)cur.pm * tstep;
    const char* cB = (const char*)g.Bt + (size_t)cur.pn * tstep;
    PG8_STAGE(PG8_SB(0, 0), cB, voffB); PG8_STAGE(PG8_SB(0, 1), cB + hstep, voffB); PG8_STAGE_A(PG8_SA(0, 0), cA, 0, 0); PG8_STAGE_A(PG8_SA(0, 1), cA, 1, 0);
    if (wr == 1) PG8_BAR;
    PG8_WAIT_V(2); PG8_BAR;
    PG8_STAGE(PG8_SB(1, 0), cB + kstep, voffB); PG8_STAGE_A(PG8_SA(1, 0), cA + kstep, 0, 0); PG8_STAGE(PG8_SB(1, 1), cB + hstep + kstep, voffB);
    PG8_WAIT_V(6); PG8_BAR;
    for (;;) {
        const bool has_next = S.next(ui + 1, nxt);
        if constexpr (GATHER) {
            if (has_next) { PG8_AOFF(voN, nxt); }
            else {
#pragma unroll
                for (int _h = 0; _h < 2; ++_h) { voN[_h][0] = voA[_h][0]; voN[_h][1] = voA[_h][1]; } } }
        const char* nA = (GATHER || !has_next) ? cA : (const char*)g.A + (size_t)nxt.pm * tstep;
        const char* nB = has_next ? (const char*)g.Bt + (size_t)nxt.pn * tstep : cB;
#pragma nounroll
        for (int t = 0; t < nt; t += 2) {
            const bool last = (t == nt - 2);
            const char* a1 = cA + (size_t)(t + 1) * kstep;
            const char* a2 = last ? nA : cA + (size_t)(t + 2) * kstep; const char* b2 = last ? nB : cB + (size_t)(t + 2) * kstep;
            const char* a3 = a2 + kstep; const char* b3 = b2 + kstep;
            if constexpr (GATHER) {
#pragma unroll
                for (int _h = 0; _h < 2; ++_h) { o2[_h][0] = last ? voN[_h][0] : voA[_h][0]; o2[_h][1] = last ? voN[_h][1] : voA[_h][1]; } }
            if constexpr (MID) { if (t == Epi::MID_T) { E.mid(acc, cur, wr, wc, fr, fq); PG8_SCHED; } }
            const bool rx = relax && t == 0;
            PG8_LDB(B0, 0, 0); PG8_LDB(B1, 0, 1); PG8_SCHED; PG8_LDA(At, 0, 0); PG8_STAGE_A(PG8_SA(1, 1), a1, 1, 0);
            PG8_WAIT_V8R(rx); PG8_WAIT_L(0); PG8_BAR; PG8_MMA(0, 0, At, B0); PG8_MMA(0, 1, At, B1); PG8_BAR; PG8_SCHED;
            PG8_LDA(At, 0, 1); PG8_STAGE(PG8_SB(0, 0), b2, voffB); PG8_STAGE(PG8_SB(0, 1), b2 + hstep, voffB); PG8_STAGE_A(PG8_SA(0, 0), a2, 0, 1);
            PG8_WAIT_V8R(rx); PG8_WAIT_L(0); PG8_BAR; PG8_MMA(1, 0, At, B0); PG8_MMA(1, 1, At, B1); PG8_BAR; PG8_SCHED;
            PG8_LDB(B0, 1, 0); PG8_LDB(B1, 1, 1); PG8_SCHED; PG8_LDA(At, 1, 0); PG8_STAGE_A(PG8_SA(0, 1), a2, 1, 1);
            PG8_WAIT_V(8); PG8_WAIT_L(0); PG8_BAR; PG8_MMA(0, 0, At, B0); PG8_MMA(0, 1, At, B1); PG8_BAR; PG8_SCHED;
            PG8_LDA(At, 1, 1); PG8_STAGE(PG8_SB(1, 0), b3, voffB); PG8_STAGE(PG8_SB(1, 1), b3 + hstep, voffB); PG8_STAGE_A(PG8_SA(1, 0), a3, 0, 1);
            PG8_WAIT_V(8); PG8_WAIT_L(0); PG8_BAR; PG8_MMA(1, 0, At, B0); PG8_MMA(1, 1, At, B1); PG8_BAR; PG8_SCHED;
        }
        if constexpr (ALIGN_EPI) { if (wr == 0) PG8_BAR; }
        E(acc, cur, wr, wc, fr, fq); relax = Epi::leaves16(cur);
#ifdef PROBE_EPI2
        if constexpr (Epi::PROBE_TWICE) E(acc, cur, wr, wc, fr, fq);
#endif
        if (!has_next) break;
#pragma unroll
        for (int a = 0; a < 2; ++a)
#pragma unroll
            for (int b = 0; b < 2; ++b)
#pragma unroll
                for (int m = 0; m < 4; ++m)
#pragma unroll
                    for (int n = 0; n < 2; ++n) acc[a][b][m][n] = (f32x4){0.f, 0.f, 0.f, 0.f};
        cur = nxt; cA = nA; cB = nB; ++ui;
        if constexpr (GATHER) {
#pragma unroll
            for (int _h = 0; _h < 2; ++_h) { voA[_h][0] = voN[_h][0]; voA[_h][1] = voN[_h][1]; } }
        if constexpr (ALIGN_EPI) { if (wr == 1) PG8_BAR; }
    }
    PG8_WAIT_V(0);
    if constexpr (!ALIGN_EPI) { if (wr == 0) PG8_BAR; }
    PG8_BAR;
#undef PG8_SA
#undef PG8_SB
#undef PG8_STAGE
#undef PG8_LDA
#undef PG8_LDB
#undef PG8_MMA
#undef PG8_WAIT_V
#undef PG8_WAIT_V8R
#undef PG8_WAIT_L
#undef PG8_BAR
#undef PG8_SCHED
#undef PG8_AOFF
#undef PG8_STAGE_A
}
}
constexpr int T_TOK = 32768, SEQ = 2048, DM = 1024, NB = 16, DEPTH = 4;
constexpr int N_IN = 5120, CAP = 32768;
constexpr float C2F = 0.125f * 1.4426950408889634f;
constexpr float DN_ALPHA = 1.681792830507429f;
constexpr float LN_EPS = 1e-5f, RMS_EPS = 1e-6f;
constexpr float IN_DESCALE = 1.0f / (16.0f * 256.0f);
constexpr float GU_WSCALE = 256.0f, GU_DESCALE = 1.0f / (16.0f * 256.0f), ACT_SCALE = 16.0f, DN_WSCALE = 1024.0f, DN_DESCALE = 1.0f / (16.0f * 1024.0f);
constexpr float PAB_ASCALE = 32.0f, PAB_WSCALE = 256.0f, PAB_DESCALE = 1.0f / (32.0f * 256.0f);
constexpr float GMIX_SCALE = 512.0f, GMIX_DESCALE = 1.0f / 512.0f;
constexpr float Y2_SCALE = 128.0f, Y2_DESCALE = 1.0f / 128.0f;
constexpr float GATE_SCALE = 128.0f, GATE_DESCALE = 1.0f / 128.0f;
constexpr float MERGED_SCALE = 64.0f, WO_SCALE = 2048.0f, WO_DESCALE = 1.0f / (64.0f * 2048.0f);

#ifndef PROBE_SCALE_A
#define PROBE_SCALE_A 1.0f
#endif
#ifndef PROBE_SCALE_B
#define PROBE_SCALE_B 1.0f
#endif
namespace pg8 {
__device__ __forceinline__ float bf2f(unsigned short b) { return __uint_as_float((unsigned)b << 16); }
__device__ __forceinline__ float bflo(unsigned w) { return __uint_as_float(w << 16); }
__device__ __forceinline__ float bfhi(unsigned w) { return __uint_as_float(w & 0xffff0000u); }
__device__ __forceinline__ float sat8e(float x) { return __builtin_amdgcn_fmed3f(x, -448.0f, 448.0f); }
__device__ __forceinline__ unsigned pk4_fp8e(float a, float b, float c, float d) { unsigned w = 0; w = __builtin_amdgcn_cvt_pk_fp8_f32(sat8e(a), sat8e(b), w, false); w = __builtin_amdgcn_cvt_pk_fp8_f32(sat8e(c), sat8e(d), w, true); return w; }
__device__ __forceinline__ float sigmoidf_(float x) { return __builtin_amdgcn_rcpf(1.f + __expf(-x)); }
__device__ __forceinline__ void sigmoid16(float (&v)[16]) {
#pragma unroll
    for (int q = 0; q < 4; ++q) {
        const float a = 1.f + __expf(-v[4 * q]), b = 1.f + __expf(-v[4 * q + 1]), c = 1.f + __expf(-v[4 * q + 2]), d = 1.f + __expf(-v[4 * q + 3]);
        const float ab = a * b, cd = c * d;
        if (ab * cd < 1e30f) { const float r = __builtin_amdgcn_rcpf(ab * cd) * GATE_SCALE, rcd = r * cd, rab = r * ab;
            v[4 * q] = rcd * b; v[4 * q + 1] = rcd * a; v[4 * q + 2] = rab * d; v[4 * q + 3] = rab * c; }
        else { v[4 * q] = GATE_SCALE * __builtin_amdgcn_rcpf(a); v[4 * q + 1] = GATE_SCALE * __builtin_amdgcn_rcpf(b); v[4 * q + 2] = GATE_SCALE * __builtin_amdgcn_rcpf(c); v[4 * q + 3] = GATE_SCALE * __builtin_amdgcn_rcpf(d); }
    }
}
__device__ __forceinline__ void store16(bf16_t* dst, const float (&v)[16]) {
    u32x4 w0, w1;
    w0.x = cvt_pk_bf16(v[0], v[1]); w0.y = cvt_pk_bf16(v[2], v[3]); w0.z = cvt_pk_bf16(v[4], v[5]); w0.w = cvt_pk_bf16(v[6], v[7]);
    w1.x = cvt_pk_bf16(v[8], v[9]); w1.y = cvt_pk_bf16(v[10], v[11]); w1.z = cvt_pk_bf16(v[12], v[13]); w1.w = cvt_pk_bf16(v[14], v[15]);
#ifdef NT_STORES
    __builtin_nontemporal_store(w0, (u32x4*)dst); __builtin_nontemporal_store(w1, (u32x4*)(dst + 32));
#else
    *(u32x4*)dst = w0; *(u32x4*)(dst + 32) = w1;
#endif
}
__device__ __forceinline__ void load16bf(const bf16_t* src, float (&v)[16]) {
    const u32x4 w0 = *(const u32x4*)src, w1 = *(const u32x4*)(src + 32);
    v[0] = bflo(w0.x); v[1] = bfhi(w0.x); v[2] = bflo(w0.y); v[3] = bfhi(w0.y); v[4] = bflo(w0.z); v[5] = bfhi(w0.z); v[6] = bflo(w0.w); v[7] = bfhi(w0.w);
    v[8] = bflo(w1.x); v[9] = bfhi(w1.x); v[10] = bflo(w1.y); v[11] = bfhi(w1.y); v[12] = bflo(w1.z); v[13] = bfhi(w1.z); v[14] = bflo(w1.w); v[15] = bfhi(w1.w);
}
__device__ __forceinline__ void load16f8(const unsigned char* src, float (&v)[16]) {
    const u32x2 w0 = *(const u32x2*)src, w1 = *(const u32x2*)(src + 32);
    typedef float f32x2v __attribute__((ext_vector_type(2)));
#pragma unroll
    for (int h = 0; h < 2; ++h) { const u32x2 w = h ? w1 : w0;
        const f32x2v a = __builtin_amdgcn_cvt_pk_f32_fp8(w.x, false), b = __builtin_amdgcn_cvt_pk_f32_fp8(w.x, true), c = __builtin_amdgcn_cvt_pk_f32_fp8(w.y, false), d = __builtin_amdgcn_cvt_pk_f32_fp8(w.y, true);
        v[8 * h] = a[0] * GATE_DESCALE; v[8 * h + 1] = a[1] * GATE_DESCALE; v[8 * h + 2] = b[0] * GATE_DESCALE; v[8 * h + 3] = b[1] * GATE_DESCALE;
        v[8 * h + 4] = c[0] * GATE_DESCALE; v[8 * h + 5] = c[1] * GATE_DESCALE; v[8 * h + 6] = d[0] * GATE_DESCALE; v[8 * h + 7] = d[1] * GATE_DESCALE; }
}
__device__ __forceinline__ void store16f8c(unsigned char* dst, const float (&v)[16]) {
    u32x4 w; w.x = pk4_fp8e(v[0], v[1], v[2], v[3]); w.y = pk4_fp8e(v[4], v[5], v[6], v[7]); w.z = pk4_fp8e(v[8], v[9], v[10], v[11]); w.w = pk4_fp8e(v[12], v[13], v[14], v[15]);
    *(u32x4*)dst = w;
}
__device__ __forceinline__ void load16f8c(const unsigned char* src, float (&v)[16]) {
    const u32x4 w = *(const u32x4*)src;
    typedef float f32x2v __attribute__((ext_vector_type(2)));
#pragma unroll
    for (int h = 0; h < 4; ++h) { const unsigned x = w[h];
        const f32x2v a = __builtin_amdgcn_cvt_pk_f32_fp8(x, false), b = __builtin_amdgcn_cvt_pk_f32_fp8(x, true);
        v[4 * h] = a[0] * GATE_DESCALE; v[4 * h + 1] = a[1] * GATE_DESCALE; v[4 * h + 2] = b[0] * GATE_DESCALE; v[4 * h + 3] = b[1] * GATE_DESCALE; }
}
__device__ __forceinline__ void dec16f8c(const u32x4 w, float (&v)[16]) {
    typedef float f32x2v __attribute__((ext_vector_type(2)));
#pragma unroll
    for (int h = 0; h < 4; ++h) { const unsigned x = w[h];
        const f32x2v a = __builtin_amdgcn_cvt_pk_f32_fp8(x, false), b = __builtin_amdgcn_cvt_pk_f32_fp8(x, true);
        v[4 * h] = a[0] * GATE_DESCALE; v[4 * h + 1] = a[1] * GATE_DESCALE; v[4 * h + 2] = b[0] * GATE_DESCALE; v[4 * h + 3] = b[1] * GATE_DESCALE; }
}
#define PG8_PIN8(a) asm volatile("" :: "v"(a[0]), "v"(a[1]), "v"(a[2]), "v"(a[3]), "v"(a[4]), "v"(a[5]), "v"(a[6]), "v"(a[7]))
#define PG8_GATHER16(v, acc, ai, m) do { _Pragma("unroll") for (int _bj = 0; _bj < 2; ++_bj) _Pragma("unroll") for (int _n = 0; _n < 2; ++_n) _Pragma("unroll") for (int _j = 0; _j < 4; ++_j) \
        v[8 * _bj + 4 * _n + _j] = acc[ai][_bj][m][_n][_j]; } while (0)

__device__ __forceinline__ int pg_perm(int g, int s) { return g == 0 ? s : (g == 1 ? ((s & 3) * 512 + (s >> 2)) : ((s & 15) * 128 + (s >> 4))); }

struct EpiIn {
    static constexpr bool PROBE_TWICE = true;
    static __device__ __forceinline__ bool leaves16(const Unit& u) { return u.pn < 12; }
    bf16_t *QA, *KA, *VA, *QD, *KD, *VDT, *G;
    const float* qg; const float* kg;
    const float* rope;
    __device__ __forceinline__ void rms_rope(float (&v)[16], const float* gain, int s, int fq, float scale) const {
        float ss = 0.f;
#pragma unroll
        for (int e = 0; e < 16; ++e) ss += v[e] * v[e];
        ss += __shfl_xor(ss, 16); ss += __shfl_xor(ss, 32);
        const float rinv = 1.0f / sqrtf(ss * (1.0f / 64.0f) + RMS_EPS);
#pragma unroll
        for (int hb = 0; hb < 2; ++hb) {
            const int a = hb == 0 ? (s >> 6) : (s & 63);
            const f32x4* rp = (const f32x4*)(rope + (size_t)(a * 16 + 4 * fq) * 2);
            const f32x4* gp = (const f32x4*)(gain + 32 * hb + 8 * fq);
#pragma unroll
            for (int q = 0; q < 2; ++q) {
                const f32x4 cs = rp[q], gg = gp[q];
                const int e0 = 8 * hb + 4 * q;
                const float x0 = v[e0] * rinv * gg[0], x1 = v[e0 + 1] * rinv * gg[1], x2 = v[e0 + 2] * rinv * gg[2], x3 = v[e0 + 3] * rinv * gg[3];
                v[e0] = (x0 * cs[0] - x1 * cs[1]) * scale; v[e0 + 1] = (x0 * cs[1] + x1 * cs[0]) * scale;
                v[e0 + 2] = (x2 * cs[2] - x3 * cs[3]) * scale; v[e0 + 3] = (x2 * cs[3] + x3 * cs[2]) * scale;
            }
        }
    }
    __device__ __forceinline__ void operator()(const f32x4 (&acc)[2][2][4][2], const Unit& u, int wr, int wc, int fr, int fq) const {
        const int pn = u.pn;
        const int b = (u.pm * BM) >> 11;
#pragma unroll
        for (int ai = 0; ai < 2; ++ai)
#pragma unroll
            for (int m = 0; m < 4; ++m) {
                const int row = u.pm * BM + ai * HALF + wr * 64 + m * 16 + fr, s = row & (SEQ - 1);
                float v[16]; PG8_GATHER16(v, acc, ai, m);
#pragma unroll
                for (int e = 0; e < 16; ++e) v[e] *= IN_DESCALE;
                if (pn < 2) {
                    rms_rope(v, qg, s, fq, C2F);
                    store16(QA + (size_t)row * 512 + (pn * 4 + wc) * 64 + 8 * fq, v);
                } else if (pn == 2) {
                    if (wc < 2) { rms_rope(v, kg, s, fq, 1.0f); store16(KA + (size_t)row * 128 + wc * 64 + 8 * fq, v); }
                    else store16(VA + (size_t)row * 128 + (wc - 2) * 64 + 8 * fq, v);
                } else if (pn < 12) {
                    const int kind = (pn - 3) / 3, g = (pn - 3) - 3 * kind, gh = g * 4 + wc;
                    if (kind == 0) {
#pragma unroll
                        for (int e = 0; e < 16; ++e) v[e] *= C2F; }
                    store16((kind == 0 ? QD : kind == 1 ? KD : VDT) + ((size_t)(b * 12 + gh) * SEQ + pg_perm(g, s)) * 64 + 8 * fq, v);
                } else {
#pragma unroll
                    for (int e = 0; e < 16; ++e) v[e] = sigmoidf_(v[e]) * GATE_SCALE;
                    store16f8c((unsigned char*)G + (size_t)row * 2048 + (pn - 12) * 256 + wc * 64 + 16 * fq, v);
                }
                if (m & 1) asm volatile("" ::: "memory");
            }
    }
};
struct EpiMergeF {
    static constexpr bool PROBE_TWICE = false;
    static constexpr int MID_T = 4;
    static constexpr float GB_MIN = 7.62939453125e-06f;
    static __device__ __forceinline__ bool leaves16(const Unit&) { return false; }
    const bf16_t* G; bf16_t* merged;
    __device__ __forceinline__ void mid(f32x4 (&acc)[2][2][4][2], const Unit& u, int wr, int wc, int fr, int fq) const {
        const int col0 = u.pn * BM + wc * 64 + 16 * fq;
#pragma unroll
        for (int ai = 0; ai < 2; ++ai) {
            u32x4 raw[8];
#pragma unroll
            for (int m = 0; m < 4; ++m) { const unsigned char* gp = (const unsigned char*)G + (size_t)(u.pm * BM + ai * HALF + wr * 64 + m * 16 + fr) * 2048 + col0;
                raw[2 * m] = *(const u32x4*)gp; raw[2 * m + 1] = *(const u32x4*)(gp + 1024); }
            PG8_PIN8(raw);
#pragma unroll
            for (int m = 0; m < 4; ++m) {
                float ga[16], gb[16]; dec16f8c(raw[2 * m], ga); dec16f8c(raw[2 * m + 1], gb);
#pragma unroll
                for (int e = 0; e < 16; ++e) ga[e] *= __builtin_amdgcn_rcpf(fmaxf(gb[e], GB_MIN));
#pragma unroll
                for (int bj = 0; bj < 2; ++bj)
#pragma unroll
                    for (int n = 0; n < 2; ++n)
#pragma unroll
                        for (int j = 0; j < 4; ++j) acc[ai][bj][m][n][j] *= ga[8 * bj + 4 * n + j];
            }
        }
    }
    __device__ __forceinline__ void operator()(const f32x4 (&acc)[2][2][4][2], const Unit& u, int wr, int wc, int fr, int fq) const {
        const int col0 = u.pn * BM + wc * 64 + 16 * fq;
        u32x4 raw[8];
#pragma unroll
        for (int ai = 0; ai < 2; ++ai)
#pragma unroll
            for (int m = 0; m < 4; ++m) raw[ai * 4 + m] = *(const u32x4*)((const unsigned char*)G + (size_t)(u.pm * BM + ai * HALF + wr * 64 + m * 16 + fr) * 2048 + 1024 + col0);
        PG8_PIN8(raw);
#pragma unroll
        for (int ai = 0; ai < 2; ++ai)
#pragma unroll
            for (int m = 0; m < 4; ++m) {
                const int row = u.pm * BM + ai * HALF + wr * 64 + m * 16 + fr;
                float v[16], gb[16]; PG8_GATHER16(v, acc, ai, m);
                dec16f8c(raw[ai * 4 + m], gb);
#pragma unroll
                for (int e = 0; e < 16; ++e) v[e] *= fmaxf(gb[e], GB_MIN) * (PAB_DESCALE * MERGED_SCALE);
                store16f8c((unsigned char*)merged + (size_t)row * DM + col0, v);
                if (m & 1) asm volatile("" ::: "memory");
            }
    }
};
struct EpiRes {
    static constexpr bool PROBE_TWICE = false;
    static __device__ __forceinline__ bool leaves16(const Unit&) { return false; }
    bf16_t* gmix; const float* gmod;
    __device__ __forceinline__ void operator()(const f32x4 (&acc)[2][2][4][2], const Unit& u, int wr, int wc, int fr, int fq) const {
        const int col0 = u.pn * BM + wc * 64 + 16 * fq;
        const int b = (u.pm * BM) >> 11;
        float gv[16];
#pragma unroll
        for (int q = 0; q < 4; ++q) { const f32x4 t = *(const f32x4*)(gmod + (size_t)b * 6144 + col0 + 4 * q); gv[4 * q] = t[0] * WO_DESCALE; gv[4 * q + 1] = t[1] * WO_DESCALE; gv[4 * q + 2] = t[2] * WO_DESCALE; gv[4 * q + 3] = t[3] * WO_DESCALE; }
#pragma unroll
        for (int ai = 0; ai < 2; ++ai)
#pragma unroll
            for (int m = 0; m < 4; ++m) {
                const size_t off = (size_t)(u.pm * BM + ai * HALF + wr * 64 + m * 16 + fr) * DM + col0;
                float v[16]; PG8_GATHER16(v, acc, ai, m);
#pragma unroll
                for (int e = 0; e < 16; ++e) v[e] *= gv[e] * GMIX_SCALE;
                store16f8c((unsigned char*)gmix + off, v);
                if (m & 1) asm volatile("" ::: "memory");
            }
    }
};
struct EpiGU {
    static constexpr bool PROBE_TWICE = false;
    static __device__ __forceinline__ bool leaves16(const Unit&) { return false; }
    bf16_t* act; const float* gatew; const PG8_LAS int* tab;
    __device__ __forceinline__ void operator()(const f32x4 (&acc)[2][2][4][2], const Unit& u, int wr, int wc, int fr, int fq) const {
        const int e = u.e, cnt = tab[e], f0 = (u.pn & 1) * 128 + wc * 32 + fq * 8;
        float gwa[8];
#pragma unroll
        for (int ai = 0; ai < 2; ++ai)
#pragma unroll
            for (int m = 0; m < 4; ++m) { const int li = u.lt * BM + ai * HALF + wr * 64 + m * 16 + fr; gwa[ai * 4 + m] = gatew[(size_t)e * CAP + (li < CAP ? li : CAP - 1)]; }
        PG8_PIN8(gwa);
#pragma unroll
        for (int ai = 0; ai < 2; ++ai)
#pragma unroll
            for (int m = 0; m < 4; ++m) {
                const int rit = ai * HALF + wr * 64 + m * 16 + fr, li = u.lt * BM + rit;
                const float gw = li < cnt ? gwa[ai * 4 + m] : 0.f;
                float a[8];
#pragma unroll
                for (int bj = 0; bj < 2; ++bj)
#pragma unroll
                    for (int j = 0; j < 4; ++j) { const float gt = acc[ai][bj][m][0][j] * GU_DESCALE, up = acc[ai][bj][m][1][j] * GU_DESCALE; a[4 * bj + j] = gt * sigmoidf_(gt) * up * gw * ACT_SCALE; }
                u32x2 w; w.x = pk4_fp8e(a[0], a[1], a[2], a[3]); w.y = pk4_fp8e(a[4], a[5], a[6], a[7]);
                *(u32x2*)((unsigned char*)act + (size_t)(u.pm * BM + rit) * 256 + f0) = w;
                if (m & 1) asm volatile("" ::: "memory");
            }
    }
};
struct EpiDown {
    static constexpr bool PROBE_TWICE = false;
    static __device__ __forceinline__ bool leaves16(const Unit&) { return false; }
    bf16_t* y2; const int* rowlist; const PG8_LAS int* tab;
    __device__ __forceinline__ void operator()(const f32x4 (&acc)[2][2][4][2], const Unit& u, int wr, int wc, int fr, int fq) const {
        const int e = u.e, cnt = tab[e], col0 = (u.pn & 3) * BM + wc * 64 + 16 * fq;
        int ents[8];
#pragma unroll
        for (int ai = 0; ai < 2; ++ai)
#pragma unroll
            for (int m = 0; m < 4; ++m) { const int li = u.lt * BM + ai * HALF + wr * 64 + m * 16 + fr; ents[ai * 4 + m] = rowlist[(size_t)e * CAP + (li < CAP ? li : CAP - 1)]; }
        PG8_PIN8(ents);
#pragma unroll
        for (int ai = 0; ai < 2; ++ai)
#pragma unroll
            for (int m = 0; m < 4; ++m) {
                const int li = u.lt * BM + ai * HALF + wr * 64 + m * 16 + fr;
                const int ent = ents[ai * 4 + m];
                float v[16]; PG8_GATHER16(v, acc, ai, m);
#pragma unroll
                for (int e2 = 0; e2 < 16; ++e2) v[e2] *= DN_DESCALE * Y2_SCALE;
                store16f8c((unsigned char*)y2 + (li < cnt ? ((size_t)(ent & 1) * T_TOK + (ent >> 1)) * DM : (size_t)2 * T_TOK * DM) + col0, v);
                if (m & 1) asm volatile("" ::: "memory");
            }
    }
};
template <bool GATHER> struct MoeOrder {
    const PG8_LAS int* tab; const int* rowlist; int nct, G, c;
    __device__ __forceinline__ bool next(int i, Unit& u) const {
        const int nwg = tab[32] * nct; const long L = (long)i * G + c; if (L >= nwg) return false;
        int w = (int)L; { const int q = nwg / NXCD, r = nwg % NXCD, xcd = w % NXCD, off = w / NXCD; w = (xcd < r ? xcd * (q + 1) : r * (q + 1) + (xcd - r) * q) + off; }
        const int rt = w / nct, ct = w - rt * nct; int e = 0;
        for (int k = 1; k < 16; ++k) e += (rt >= tab[16 + k]) ? 1 : 0;
        u.pm = rt; u.e = e; u.lt = rt - tab[16 + e]; u.pn = e * nct + ct; return true;
    }
    __device__ __forceinline__ int arow(const Unit& u, int R) const {
        if (GATHER) { const int li = u.lt * BM + R; const int ent = rowlist[(size_t)u.e * CAP + (li < CAP ? li : CAP - 1)]; return li < tab[u.e] ? (ent >> 1) : 0; }
        return u.pm * BM + R;
    }
};
}
namespace attn_body {
using bf16=__hip_bfloat16;
using bf16x8=__attribute__((ext_vector_type(8)))short;
using s16x4=__attribute__((ext_vector_type(4)))short;
using f32x16=__attribute__((ext_vector_type(16)))float;
using u32x4=__attribute__((ext_vector_type(4)))unsigned;
constexpr int BATCH=16,NHEAD=8,SEQ=2048,D=64;
constexpr int NW=8,QBLK=32,QB=QBLK*NW,KVBLK=64,NQB=SEQ/QB;
constexpr int ATTN_UNIT_ROWS=QB;
__device__ __forceinline__ int crow(int r,int hi){return (r&3)+8*(r>>2)+4*hi;}
#define SBAR() __builtin_amdgcn_sched_barrier(0)
__device__ __forceinline__ void cmask(f32x16&p0,f32x16&p1,int jb,int qrel,int hi){
  const float NEG=-INFINITY; int kb=64*jb+4*hi;
  #pragma unroll
  for(int r=0;r<16;++r){int kv=kb+(r&3)+8*(r>>2); if(kv>qrel)p0[r]=NEG; if(kv+32>qrel)p1[r]=NEG;}
}

constexpr int NSLOT=3, SLOTB=8192;
constexpr int LDS_K=0, LDS_V=NSLOT*SLOTB, LDS_WS=2*NSLOT*SLOTB, LDS_OST=LDS_WS+NW*64*4, LDS_BYTES=LDS_OST+NW*4096;
constexpr float C2=0.125f*1.4426950408889634f;
__device__ __forceinline__ void glds16(const void*gsrc,unsigned lds_dst){unsigned keep;
  asm volatile("s_mov_b32 %0, m0\n\ts_mov_b32 m0, %2\n\ts_nop 0\n\tglobal_load_lds_dwordx4 %1, off\n\ts_mov_b32 m0, %0":"=&s"(keep):"v"(gsrc),"s"(lds_dst):"memory");}
__device__ __forceinline__ float max3f(float a,float b,float c){float r;asm("v_max3_f32 %0, %1, %2, %3":"=v"(r):"v"(a),"v"(b),"v"(c));return r;}
__device__ __forceinline__ float max2f(float a,float b){float r;asm("v_max_f32_e32 %0, %1, %2":"=v"(r):"v"(a),"v"(b));return r;}
__device__ __forceinline__ float fadd_s(float a,float b){float r;asm("v_add_f32_e32 %0, %1, %2":"=v"(r):"v"(a),"v"(b));return r;}
__device__ __forceinline__ float fsub_s(float a,float b){float r;asm("v_sub_f32_e32 %0, %1, %2":"=v"(r):"v"(a),"v"(b));return r;}
typedef float f32x2_t __attribute__((ext_vector_type(2))); typedef __bf16 bf16x2_t __attribute__((ext_vector_type(2)));
__device__ __forceinline__ unsigned cvtpk_s(float lo,float hi){f32x2_t v={lo,hi};bf16x2_t b=__builtin_convertvector(v,bf16x2_t);return __builtin_bit_cast(unsigned,b);}
#define WAIT_BAR(N) asm volatile("s_waitcnt vmcnt(" #N ") lgkmcnt(0)\n\ts_barrier":::"memory")

__device__ __forceinline__ void qkt(f32x16&p0,f32x16&p1,const char*Kslot,const bf16x8*qr,const f32x16&negm,int r32,int hi){
  const char*kb=Kslot+hi*1024+r32*16;
  #pragma unroll
  for(int d0=0;d0<4;++d0){
    const bf16x8 b0=*reinterpret_cast<const bf16x8*>(kb+d0*2048);
    const bf16x8 b1=*reinterpret_cast<const bf16x8*>(kb+d0*2048+512);
    if(d0==0){p0=__builtin_amdgcn_mfma_f32_32x32x16_bf16(b0,qr[0],negm,0,0,0);p1=__builtin_amdgcn_mfma_f32_32x32x16_bf16(b1,qr[0],negm,0,0,0);}
    else{p0=__builtin_amdgcn_mfma_f32_32x32x16_bf16(b0,qr[d0],p0,0,0,0);p1=__builtin_amdgcn_mfma_f32_32x32x16_bf16(b1,qr[d0],p1,0,0,0);}}
}
typedef __attribute__((address_space(3))) const char* lds_cptr;
typedef short v4i16_t __attribute__((ext_vector_type(4)));
__device__ __forceinline__ void kload8(bf16x8*kf,lds_cptr kp){
  kf[0]=*(const __attribute__((address_space(3))) bf16x8*)(kp);      kf[1]=*(const __attribute__((address_space(3))) bf16x8*)(kp+512);
  kf[2]=*(const __attribute__((address_space(3))) bf16x8*)(kp+2048); kf[3]=*(const __attribute__((address_space(3))) bf16x8*)(kp+2560);
  kf[4]=*(const __attribute__((address_space(3))) bf16x8*)(kp+4096); kf[5]=*(const __attribute__((address_space(3))) bf16x8*)(kp+4608);
  kf[6]=*(const __attribute__((address_space(3))) bf16x8*)(kp+6144); kf[7]=*(const __attribute__((address_space(3))) bf16x8*)(kp+6656);
}
__device__ __forceinline__ void kload2(bf16x8*kf,lds_cptr kp,int j){ kf[2*j]=*(const __attribute__((address_space(3))) bf16x8*)(kp+j*2048); kf[2*j+1]=*(const __attribute__((address_space(3))) bf16x8*)(kp+j*2048+512); }
__device__ __forceinline__ s16x4 vtr(lds_cptr p){ return __builtin_bit_cast(s16x4,__builtin_amdgcn_ds_read_tr16_b64_v4i16((__attribute__((address_space(3))) v4i16_t*)p)); }
__device__ __forceinline__ float rowmax(const f32x16&p0,const f32x16&p1){
  float a=max3f(p0[0],p0[1],p1[0]),b=max3f(p0[2],p0[3],p1[1]);a=max3f(a,p1[2],p1[3]);
  #pragma unroll
  for(int r=4;r<16;r+=4){a=max3f(a,p0[r],p0[r+1]);b=max3f(b,p0[r+2],p0[r+3]);a=max3f(a,p1[r],p1[r+1]);b=max3f(b,p1[r+2],p1[r+3]);}
  const float m=max2f(a,b);
  auto rr=__builtin_amdgcn_permlane32_swap(__float_as_uint(m),__float_as_uint(m),false,false);
  return max2f(__uint_as_float(rr[0]),__uint_as_float(rr[1]));
}
__device__ __forceinline__ void pv(f32x16*o,int vb,bf16x8 pa0,bf16x8 pa1,bf16x8 pa2,bf16x8 pa3){
  #pragma unroll
  for(int d0=0;d0<2;++d0){s16x4 lo[4],hi[4];
    #pragma unroll
    for(int ks=0;ks<4;++ks){
      asm volatile("ds_read_b64_tr_b16 %0,%1 offset:%c2":"=&v"(lo[ks]):"v"(vb),"i"(d0*4096+ks*1024):"memory");
      asm volatile("ds_read_b64_tr_b16 %0,%1 offset:%c2":"=&v"(hi[ks]):"v"(vb),"i"(d0*4096+ks*1024+512):"memory");}
    asm volatile("s_waitcnt lgkmcnt(0)":::"memory");SBAR();
    #define PK(k) (bf16x8){lo[k][0],lo[k][1],lo[k][2],lo[k][3],hi[k][0],hi[k][1],hi[k][2],hi[k][3]}
    o[d0]=__builtin_amdgcn_mfma_f32_32x32x16_bf16(pa0,PK(0),o[d0],0,0,0);
    o[d0]=__builtin_amdgcn_mfma_f32_32x32x16_bf16(pa1,PK(1),o[d0],0,0,0);
    o[d0]=__builtin_amdgcn_mfma_f32_32x32x16_bf16(pa2,PK(2),o[d0],0,0,0);
    o[d0]=__builtin_amdgcn_mfma_f32_32x32x16_bf16(pa3,PK(3),o[d0],0,0,0);
    #undef PK
  }
}

#ifndef ATTN_STORE16
#define ATTN_STORE16(p,v) (*(u32x4*)(p)=(v))
#endif
struct UnitP { const bf16* Q; const bf16* K; const bf16* V; bf16* O; unsigned char* O8; float* lse; int NT; int qa0; int kk0; int ngmask; float sl2; };
struct CfgA { static constexpr int QP=512,KP=128,VP=128,OP=768; static constexpr bool BAND=false,OFP8=true; };
struct CfgB { static constexpr int QP=64,KP=64,VP=64,OP=64; static constexpr bool BAND=true,OFP8=true; };
constexpr float OUT_SCALE=32.0f;
constexpr float NEGBAND=-30000.0f;
__device__ __forceinline__ void bandmask(f32x16&p0,f32x16&p1,int kt0,int qa,int hi,int ngmask,float sl2){
  const bool cls_ok=((kt0&ngmask)==(qa&ngmask));
  const float fb=(float)(kt0+4*hi-qa);
  #pragma unroll
  for(int r=0;r<16;++r){ const float f0=fb+(float)((r&3)+8*(r>>2)),f1=f0+32.0f; const float a0=__builtin_fabsf(f0),a1=__builtin_fabsf(f1);
    const float v0=__builtin_fmaf(-sl2,a0,p0[r]),v1=__builtin_fmaf(-sl2,a1,p1[r]);
    p0[r]=(cls_ok&&a0<=64.0f)?v0:NEGBAND; p1[r]=(cls_ok&&a1<=64.0f)?v1:NEGBAND; }
}
template<int THRL,class CFG> __device__ __forceinline__ void attn_unit(const int wave,const UnitP&U,char*shm,const bool pre,const bf16*nK,const bf16*nV){
  constexpr int QP=CFG::QP,KP=CFG::KP,VP=CFG::VP,OP=CFG::OP;
  const int lane=hw_lane(),r32=lane&31,hi=lane>>5; const int wid=wave;
  const bf16*Qw=U.Q+(long)(wid*QBLK)*QP;
  const bf16*Kh=U.K,*Vh=U.V;
  const int qa=U.qa0+wid*QBLK+r32;
  const unsigned lds0=(unsigned)(uintptr_t)shm;
  float*wsf=(float*)(shm+LDS_WS)+wid*64;
  const bf16*ksrc=Kh+(long)lane*KP+wid*8;
  const bf16*vsrc=Vh+(long)(16*(wid&3)+(lane>>2))*VP+(wid>>2)*32+(lane&3)*8;
  const unsigned kdst=lds0+LDS_K+wid*1024, vdst=lds0+LDS_V+wid*1024;
  #define DMA_K(t,slot) glds16(ksrc+(long)(t)*KVBLK*KP,(unsigned)__builtin_amdgcn_readfirstlane(kdst+(slot)))
  #define DMA_V(t,slot) glds16(vsrc+(long)(t)*KVBLK*VP,(unsigned)__builtin_amdgcn_readfirstlane(vdst+(slot)))
  const int vb0=(int)(lds0+LDS_V)+((lane>>4)&1)*32+(lane&3)*8+(4*hi+((lane&15)>>2))*64;
  const char*Kbase=shm+LDS_K; bf16x8 kf[8];
  const lds_cptr shm3=(lds_cptr)shm; const lds_cptr kp0=shm3+LDS_K+hi*1024+r32*16; const lds_cptr vp0=shm3+LDS_V+((lane>>4)&1)*32+(lane&3)*8+(4*hi+((lane&15)>>2))*64;
  const int NT=U.NT;
  if(!pre){DMA_K(0,0);DMA_V(0,0);DMA_K(1,SLOTB);}
  bf16x8 qr[4];
  #pragma unroll
  for(int d0=0;d0<4;++d0)qr[d0]=*reinterpret_cast<const bf16x8*>(&Qw[(long)r32*QP+d0*16+hi*8]);
  float mhat=0.f,l_reg=0.f;f32x16 o[2];o[0]=f32x16{};o[1]=f32x16{};f32x16 negm=f32x16{};asm volatile("":"+v"(negm));

  #define CMASK(P0,P1,t) do{ if constexpr(CFG::BAND) bandmask(P0,P1,U.kk0+64*(t),qa,hi,U.ngmask,U.sl2); }while(0)
  bool resc=false;
  #define START(P0,P1) do{ const float rm=rowmax(P0,P1); resc=false; \
    { const float dl=rm; mhat=fadd_s(mhat,dl); \
      _Pragma("unroll") for(int r=0;r<16;++r){P0[r]=fsub_s(P0[r],dl);P1[r]=fsub_s(P1[r],dl);} \
      _Pragma("unroll") for(int r=0;r<16;++r)negm[r]=-mhat; asm volatile("":"+v"(negm)); } \
    _Pragma("unroll") for(int r=0;r<16;++r)P0[r]=__builtin_amdgcn_exp2f(P0[r]); }while(0)
  #define RESC() do{ if(resc){ asm volatile("s_waitcnt lgkmcnt(0)":::"memory"); \
      _Pragma("unroll") for(int d_=0;d_<2;++d_) _Pragma("unroll") for(int r=0;r<16;++r)o[d_][r]*=wsf[crow(r,hi)]; } }while(0)
  f32x16 pA0,pA1,pB0,pB1;
  int sl_prev=0,sl_cur=0,sl_next=SLOTB;
  #define ROT() do{sl_prev=sl_cur;sl_cur=sl_next;sl_next=(sl_next==(NSLOT-1)*SLOTB)?0:sl_next+SLOTB;}while(0)
  DMA_K(2,2*SLOTB);
  WAIT_BAR(3);
  qkt(pA0,pA1,Kbase,qr,negm,r32,hi);asm volatile("s_nop 15\n\ts_nop 7":"+v"(pA0),"+v"(pA1));CMASK(pA0,pA1,0);
  START(pA0,pA1);
  _Pragma("unroll") for(int r=0;r<16;++r)pA1[r]=__builtin_amdgcn_exp2f(pA1[r]);
  WAIT_BAR(0);
  DMA_K(3,0);DMA_V(1,SLOTB);
  ROT();
  kload8(kf,kp0+sl_cur);
  WAIT_BAR(2);
  s16x4 vlo[8],vhi[8]; u32x4 pw0,pw1,pw2,pw3;
  #define PKW(P,B) cvtpk_s(P[B],P[B+1])
  #define PAF(k) __builtin_bit_cast(bf16x8,pw##k)
  #define VFR(i) (bf16x8){vlo[i][0],vlo[i][1],vlo[i][2],vlo[i][3],vhi[i][0],vhi[i][1],vhi[i][2],vhi[i][3]}
  #define PIN(x) asm volatile("":"+v"(x))
  #define MX3(a,b,c) __builtin_fmaxf(__builtin_fmaxf((a),(b)),(c))
  #define GAPA(MF,A0,A1,A2,A3,W0,W1,PW) do{ MF; sacc+=A0; sacc+=A1; sacc+=A2; sacc+=A3; PIN(sacc); W0; W1; PIN(PW); SBAR(); }while(0)
  #define EX(v) __builtin_amdgcn_exp2f(v)
  #define GAPB(MF,X,B) do{ MF; X[B]=EX(X[B]); X[B+1]=EX(X[B+1]); X[B+2]=EX(X[B+2]); X[B+3]=EX(X[B+3]); PIN(X); SBAR(); }while(0)
  #define VRD(i) do{ vlo[i]=vtr(vp_+(((i)>>2)*4096+((i)&3)*1024)); vhi[i]=vtr(vp_+(((i)>>2)*4096+((i)&3)*1024+512)); }while(0)
  #define KRD(G,j) do{ if(G){ kload2(kf,kp0+sl_next,j); SBAR(); } }while(0)
  #define STEP(C0,C1,P0,P1,t,GK,GV,GL) do{ SBAR(); \
    const lds_cptr vp_=vp0+sl_prev; \
    VRD(0); SBAR(); float sacc=(P0[0]+P0[1]); \
    GAPA(C0=__builtin_amdgcn_mfma_f32_32x32x16_bf16(kf[0],qr[0],negm,0,0,0), P0[2],P0[3],P0[4],P0[5],     pw0[0]=PKW(P0,0), pw0[1]=PKW(P0,2), pw0); \
    VRD(4); SBAR(); GAPA(C1=__builtin_amdgcn_mfma_f32_32x32x16_bf16(kf[1],qr[0],negm,0,0,0), P0[6],P0[7],P0[8],P0[9],     pw0[2]=PKW(P0,4), pw0[3]=PKW(P0,6), pw0); \
    VRD(1); SBAR(); GAPA(C0=__builtin_amdgcn_mfma_f32_32x32x16_bf16(kf[2],qr[1],C0,0,0,0),   P0[10],P0[11],P0[12],P0[13], pw1[0]=PKW(P0,8), pw1[1]=PKW(P0,10), pw1); \
    VRD(5); SBAR(); GAPA(C1=__builtin_amdgcn_mfma_f32_32x32x16_bf16(kf[3],qr[1],C1,0,0,0),   P0[14],P0[15],P1[0],P1[1],   pw1[2]=PKW(P0,12),pw1[3]=PKW(P0,14), pw1); \
    VRD(2); SBAR(); GAPA(C0=__builtin_amdgcn_mfma_f32_32x32x16_bf16(kf[4],qr[2],C0,0,0,0),   P1[2],P1[3],P1[4],P1[5],     pw2[0]=PKW(P1,0), pw2[1]=PKW(P1,2), pw2); \
    VRD(6); SBAR(); GAPA(C1=__builtin_amdgcn_mfma_f32_32x32x16_bf16(kf[5],qr[2],C1,0,0,0),   P1[6],P1[7],P1[8],P1[9],     pw2[2]=PKW(P1,4), pw2[3]=PKW(P1,6), pw2); \
    VRD(3); SBAR(); GAPA(C0=__builtin_amdgcn_mfma_f32_32x32x16_bf16(kf[6],qr[3],C0,0,0,0),   P1[10],P1[11],P1[12],P1[13], pw3[0]=PKW(P1,8), pw3[1]=PKW(P1,10), pw3); \
    VRD(7); SBAR(); GAPA(C1=__builtin_amdgcn_mfma_f32_32x32x16_bf16(kf[7],qr[3],C1,0,0,0),   P1[14],P1[15],0.f,0.f,       pw3[2]=PKW(P1,12),pw3[3]=PKW(P1,14), pw3); \
    l_reg+=sacc; \
    if(GK){DMA_K((t)+3,sl_cur);} if(GV){DMA_V((t)+1,sl_next);} \
    CMASK(C0,C1,t); \
    { float a=MX3(C0[0],C0[1],C1[0]),b=MX3(C0[2],C0[3],C1[1]); a=MX3(a,C1[2],C1[3]); \
      _Pragma("unroll") for(int r=4;r<16;r+=4){a=MX3(a,C0[r],C0[r+1]);b=MX3(b,C0[r+2],C0[r+3]);a=MX3(a,C1[r],C1[r+1]);b=MX3(b,C1[r+2],C1[r+3]);} \
      float rm=__builtin_fmaxf(a,b); { auto rr=__builtin_amdgcn_permlane32_swap(__float_as_uint(rm),__float_as_uint(rm),false,false); rm=__builtin_fmaxf(__uint_as_float(rr[0]),__uint_as_float(rr[1])); } \
      resc=false; \
      if(__builtin_expect(__any(rm>(float)THRL),0)){ const float dl=__builtin_fmaxf(rm,0.f); mhat+=dl; \
        _Pragma("unroll") for(int r=0;r<16;++r){C0[r]-=dl;C1[r]-=dl;} \
        _Pragma("unroll") for(int r=0;r<16;++r)negm[r]=-mhat; asm volatile("":"+v"(negm)); \
        const float f=__builtin_amdgcn_exp2f(-dl); l_reg*=f; if(hi==0)wsf[r32]=f; resc=true; } } \
    SBAR(); \
    GAPB(o[0]=__builtin_amdgcn_mfma_f32_32x32x16_bf16(PAF(0),VFR(0),o[0],0,0,0), C0,0); \
    GAPB(o[1]=__builtin_amdgcn_mfma_f32_32x32x16_bf16(PAF(0),VFR(4),o[1],0,0,0), C0,4); \
    KRD(GL,0); GAPB(o[0]=__builtin_amdgcn_mfma_f32_32x32x16_bf16(PAF(1),VFR(1),o[0],0,0,0), C0,8); \
    KRD(GL,1); GAPB(o[1]=__builtin_amdgcn_mfma_f32_32x32x16_bf16(PAF(1),VFR(5),o[1],0,0,0), C0,12); \
    KRD(GL,2); GAPB(o[0]=__builtin_amdgcn_mfma_f32_32x32x16_bf16(PAF(2),VFR(2),o[0],0,0,0), C1,0); \
    KRD(GL,3); GAPB(o[1]=__builtin_amdgcn_mfma_f32_32x32x16_bf16(PAF(2),VFR(6),o[1],0,0,0), C1,4); \
    GAPB(o[0]=__builtin_amdgcn_mfma_f32_32x32x16_bf16(PAF(3),VFR(3),o[0],0,0,0), C1,8); \
    GAPB(o[1]=__builtin_amdgcn_mfma_f32_32x32x16_bf16(PAF(3),VFR(7),o[1],0,0,0), C1,12); \
    }while(0)
  int t=1;
  #undef CMASK
  #define CMASK(P0,P1,t) do{ if constexpr(CFG::BAND) bandmask(P0,P1,U.kk0+64*(t),qa,hi,U.ngmask,U.sl2); }while(0)
  for(;t+5<NT;t+=2){
    STEP(pB0,pB1,pA0,pA1,t,true,true,true);     WAIT_BAR(2); RESC(); ROT();
    STEP(pA0,pA1,pB0,pB1,t+1,true,true,true);   WAIT_BAR(2); RESC(); ROT();
  }
  #undef CMASK
  #define CMASK(P0,P1,t) do{ if constexpr(CFG::BAND) bandmask(P0,P1,U.kk0+64*(t),qa,hi,U.ngmask,U.sl2); }while(0)
  #define ENDW(tt) do{ if((tt)+3<NT){WAIT_BAR(2);} else if((tt)+2<NT){WAIT_BAR(1);} else {WAIT_BAR(0);} }while(0)
  for(;t+1<NT;t+=2){
    STEP(pB0,pB1,pA0,pA1,t,(t+3<NT),(t+1<NT),(t+1<NT));       ENDW(t);   RESC(); ROT();
    STEP(pA0,pA1,pB0,pB1,t+1,(t+4<NT),(t+2<NT),(t+2<NT));     ENDW(t+1); RESC(); ROT();
  }
  STEP(pB0,pB1,pA0,pA1,NT-1,false,false,false); RESC();
  { float sacc=pB0[0]+pB0[1]; _Pragma("unroll") for(int r=2;r<16;++r)sacc+=pB0[r]; _Pragma("unroll") for(int r=0;r<16;++r)sacc+=pB1[r]; l_reg+=sacc;
    pw0=(u32x4){PKW(pB0,0),PKW(pB0,2),PKW(pB0,4),PKW(pB0,6)};pw1=(u32x4){PKW(pB0,8),PKW(pB0,10),PKW(pB0,12),PKW(pB0,14)};pw2=(u32x4){PKW(pB1,0),PKW(pB1,2),PKW(pB1,4),PKW(pB1,6)};pw3=(u32x4){PKW(pB1,8),PKW(pB1,10),PKW(pB1,12),PKW(pB1,14)};
    SBAR(); pv(o,vb0+sl_cur,PAF(0),PAF(1),PAF(2),PAF(3)); }
  #undef PKW
  #undef PAF
  #undef VFR
  #undef PIN
  #undef MX3
  #undef GAPA
  #undef GAPB
  #undef EX
  #undef VRD
  #undef KRD
  #undef STEP
  #undef ENDW
  asm volatile("s_waitcnt lgkmcnt(0)\n\ts_barrier":::"memory");
  if(nK){ const bf16*ks2=nK+(long)lane*KP+wid*8; const bf16*vs2=nV+(long)(16*(wid&3)+(lane>>2))*VP+(wid>>2)*32+(lane&3)*8;
    glds16(ks2,(unsigned)__builtin_amdgcn_readfirstlane(kdst)); glds16(vs2,(unsigned)__builtin_amdgcn_readfirstlane(vdst)); glds16(ks2+(long)KVBLK*KP,(unsigned)__builtin_amdgcn_readfirstlane(kdst+SLOTB)); }
  {auto rr=__builtin_amdgcn_permlane32_swap(__float_as_uint(l_reg),__float_as_uint(l_reg),false,false);l_reg=__uint_as_float(rr[0])+__uint_as_float(rr[1]);}
  if constexpr(CFG::BAND){ if(hi==0)U.lse[wid*QBLK+r32]=mhat+__builtin_amdgcn_logf(l_reg); }
  if(hi==0)wsf[32+r32]=l_reg;asm volatile("s_waitcnt lgkmcnt(0)":::"memory");
  float rli[16];
  #pragma unroll
  for(int r=0;r<16;++r)rli[r]=__builtin_amdgcn_rcpf(wsf[32+crow(r,hi)]);
  if constexpr(CFG::OFP8){
    unsigned char*Ow8=U.O8+(long)(wid*QBLK)*OP;
    unsigned char*stg8=(unsigned char*)(shm+LDS_OST)+wid*4096;
    #pragma unroll
    for(int r=0;r<16;++r){const int orow=crow(r,hi);
      #pragma unroll
      for(int d0=0;d0<2;++d0){ const float x=__builtin_amdgcn_fmed3f(o[d0][r]*rli[r]*OUT_SCALE,-448.0f,448.0f); stg8[orow*64+d0*32+r32]=(unsigned char)(__builtin_amdgcn_cvt_pk_fp8_f32(x,x,0u,false)&0xffu); } }
    asm volatile("s_waitcnt lgkmcnt(0)":::"memory");
    #pragma unroll
    for(int i=0;i<2;++i){const int row=i*16+(lane>>2),ch=lane&3; const u32x4 v=*(const u32x4*)(stg8+row*64+ch*16); ATTN_STORE16(Ow8+(long)row*OP+ch*16,v);} }
  else {
  bf16*Ow=U.O+(long)(wid*QBLK)*OP;
  { bf16*stg=(bf16*)(shm+LDS_OST)+wid*2048;
    #pragma unroll
    for(int r=0;r<16;++r){const int orow=crow(r,hi);
      #pragma unroll
      for(int d0=0;d0<2;++d0)stg[orow*64+d0*32+r32]=__float2bfloat16(o[d0][r]*rli[r]);}
    asm volatile("s_waitcnt lgkmcnt(0)":::"memory");
    #pragma unroll
    for(int i=0;i<4;++i){const int row=i*8+(lane>>3),ch=lane&7; const u32x4 v=*(const u32x4*)(stg+row*64+ch*8); ATTN_STORE16(Ow+(long)row*OP+ch*8,v);} }
  }
  if(!nK) asm volatile("s_waitcnt lgkmcnt(0)\n\ts_barrier":::"memory");
  #undef DMA_K
  #undef DMA_V
  #undef CMASK
  #undef START
  #undef RESC
  #undef ROT
}
constexpr int ATTN_LDS_BYTES=LDS_BYTES;
struct AttnTensors { const bf16* Q; const bf16* K; const bf16* V; bf16* O; unsigned char* O8; };
struct OrderA {
  int vcu, G; AttnTensors T;
  __device__ __forceinline__ bool next(int i,UnitP&u)const{ const int L=(G==256)?(vcu*4+i):(vcu+i*G); if((G==256&&i>=4)||L>=BATCH*NHEAD*NQB)return false;
    const int bh=L>>3,qb=L&7,b=bh/NHEAD,h=bh%NHEAD; const long rowbase=(long)b*SEQ;
    u.Q=T.Q+(rowbase+qb*QB)*CfgA::QP+h*D; u.K=T.K+rowbase*CfgA::KP+(h>>2)*D; u.V=T.V+rowbase*CfgA::VP+(h>>2)*D; u.O=T.O+(rowbase+qb*QB)*CfgA::OP+h*D; u.O8=T.O8+(rowbase+qb*QB)*CfgA::OP+h*D;
    u.lse=nullptr; u.NT=SEQ/KVBLK; u.qa0=0; u.kk0=0; u.ngmask=0; u.sl2=0.f; return true; }
};
struct OrderB {
  int vcu, G; AttnTensors T; float* lse;
  __device__ __forceinline__ bool next(int i,UnitP&u)const{ const int L=(G==256)?(vcu*6+i):(vcu+i*G); if((G==256&&i>=6)||L>=BATCH*12*NQB)return false;
    const int blk=L&7,bgh=L>>3,gh=bgh%12,g=gh>>2; const long hb=(long)bgh*SEQ;
    const int ng=SEQ>>(2*g),q0=blk*QB; int t_lo,nt;
    if(g==2){ t_lo=q0>>6; nt=4; } else { const int c_lo=(q0&~(ng-1))>>6,c_hi=c_lo+(ng>>6); t_lo=(q0>>6)-1; if(t_lo<c_lo)t_lo=c_lo; if(t_lo>c_hi-6)t_lo=c_hi-6; nt=6; }
    u.Q=T.Q+(hb+q0)*D; u.K=T.K+(hb+t_lo*64)*D; u.V=T.V+(hb+t_lo*64)*D; u.O=T.O+(hb+q0)*D; u.O8=T.O8+(hb+q0)*D; u.lse=lse+hb+q0;
    u.NT=nt; u.qa0=q0; u.kk0=t_lo*64; u.ngmask=~(ng-1); u.sl2=__builtin_amdgcn_exp2f(-8.0f*(float)(gh+1)/12.0f)*1.4426950408889634f*(float)(1<<(2*g)); return true; }
};
template<class CFG,class Sched,int THRL=8> __device__ __forceinline__ void attn_phase(char*lds,const Sched&S,const int wave){
  UnitP u;
  for(int i=0;S.next(i,u);++i){ UnitP n; const bool hn=S.next(i+1,n); const bf16*nK=hn?n.K:nullptr,*nV=hn?n.V:nullptr; attn_unit<THRL,CFG>(wave,u,lds,i>0,nK,nV); }
}
#undef SBAR
#undef WAIT_BAR
}
typedef unsigned u32x2g __attribute__((ext_vector_type(2)));
#define GAS __attribute__((address_space(1)))
#define LAS __attribute__((address_space(3)))
typedef unsigned short bf16;
typedef unsigned v4u __attribute__((ext_vector_type(4)));
typedef float f32x4 __attribute__((ext_vector_type(4)));
typedef short bf16x8 __attribute__((ext_vector_type(8)));
typedef GAS unsigned gu32;
typedef GAS unsigned long long gu64;
#define RLX_AGENT __ATOMIC_RELAXED, __HIP_MEMORY_SCOPE_AGENT
#define LDS_WAIT() asm volatile("s_waitcnt lgkmcnt(0)" ::: "memory")
#define VM_WAIT() asm volatile("s_waitcnt vmcnt(0)" ::: "memory")
__device__ __forceinline__ unsigned long long rt() { return __builtin_amdgcn_s_memrealtime(); }
__device__ __forceinline__ unsigned f2bf(float f) { unsigned u = __builtin_bit_cast(unsigned, f); return (u + 0x7fffu + ((u >> 16) & 1u)) >> 16; }
__device__ __forceinline__ unsigned pk2(float lo, float hi) { return f2bf(lo) | (f2bf(hi) << 16); }

#define XB_TMO      128
#define XB_XCNT(j)  (256  + 64 * (j))
#define XB_XSUB(j)  (1280 + 64 * (j))
#define XB_XGEN(j)  (2304 + 64 * (j))
#define XB_TOP      3328
#define XB_TOPGEN   3392
#define XCD_BAR_WORDS 3456
#define XB_SPIN_CAP (1u << 18)

__device__ __forceinline__ unsigned xb_ld(unsigned* p)              { return __hip_atomic_load(p, __ATOMIC_RELAXED, __HIP_MEMORY_SCOPE_AGENT); }
__device__ __forceinline__ unsigned xb_add(unsigned* p, unsigned v) { return __hip_atomic_fetch_add(p, v, __ATOMIC_RELAXED, __HIP_MEMORY_SCOPE_AGENT); }
__device__ __forceinline__ unsigned xb_xcc_id() { return (unsigned)__builtin_amdgcn_s_getreg((3 << 11) | 20) & 0xFu; }
#define XB_SPIN(cond, bar) do { unsigned _sp = 0; while (cond) { __builtin_amdgcn_s_sleep(1); \
    if ((++_sp & 255u) == 0u) { if (xb_ld(&(bar)[XB_TMO])) break; if (_sp > XB_SPIN_CAP) { atomicAdd(&(bar)[XB_TMO], 1u); break; } } } } while (0)

struct XcdBarrier {
    unsigned* bar; unsigned x;
    volatile LAS unsigned* st;
};

__device__ __forceinline__ XcdBarrier xcd_barrier_post(unsigned* bar, volatile LAS unsigned* st) {
    XcdBarrier b; b.bar = bar; b.x = xb_xcc_id(); b.st = st;
    if (threadIdx.x == 0) (void)xb_add(&bar[XB_XCNT(b.x)], 1u);
    return b;
}
__device__ __forceinline__ void xcd_barrier_complete(unsigned* bar, unsigned x, unsigned& nloc, unsigned& nx) {
    const unsigned G = gridDim.x * gridDim.y * gridDim.z;
    unsigned sum, cnt, mine, sp = 0u;
    for (;;) {
        sum = 0u; cnt = 0u; mine = 0u;
#pragma unroll
        for (unsigned j = 0; j < 16; ++j) { const unsigned c = xb_ld(&bar[XB_XCNT(j)]); sum += c; cnt += (c > 0u) ? 1u : 0u; mine = (j == x) ? c : mine; }
        if (sum == G) break;
        __builtin_amdgcn_s_sleep(1);
        if ((++sp & 255u) == 0u) { if (xb_ld(&bar[XB_TMO])) break; if (sp > XB_SPIN_CAP) { atomicAdd(&bar[XB_TMO], 1u); break; } }
    }
    nloc = mine > 0u ? mine : 1u; nx = cnt > 0u ? cnt : 1u;
}

__device__ __forceinline__ void xcd_barrier(const XcdBarrier& b, const bool is_t0  ) {
    asm volatile("s_waitcnt vmcnt(0)" ::: "memory");
    __syncthreads();
    if (is_t0) {
        unsigned* bar = b.bar;
        __builtin_amdgcn_s_waitcnt(0);
        unsigned nloc = b.st[0], nx = b.st[1];
        if (nloc == 0u) { xcd_barrier_complete(bar, b.x, nloc, nx); b.st[0] = nloc; b.st[1] = nx; }
        const unsigned old = xb_add(&bar[XB_XSUB(b.x)], 1u);
        const unsigned gen = old / nloc;
        if (old + 1u == (gen + 1u) * nloc) {
            __builtin_amdgcn_fence(__ATOMIC_RELEASE, "agent");
            asm volatile("s_waitcnt vmcnt(0)" ::: "memory");
            const unsigned og = xb_add(&bar[XB_TOP], 1u);
            const unsigned tg = og / nx;
            if (og + 1u == (tg + 1u) * nx) xb_add(&bar[XB_TOPGEN], 1u);
            else XB_SPIN(xb_ld(&bar[XB_TOPGEN]) == tg, bar);
            __builtin_amdgcn_fence(__ATOMIC_ACQUIRE, "agent");
            xb_add(&bar[XB_XGEN(b.x)], 1u);
            asm volatile("s_waitcnt vmcnt(0)" ::: "memory");
        } else {
            XB_SPIN(xb_ld(&bar[XB_XGEN(b.x)]) == gen, bar);
            __builtin_amdgcn_fence(__ATOMIC_ACQUIRE, "agent");
            asm volatile("s_waitcnt vmcnt(0)" ::: "memory");
        }
    }
    __syncthreads();
}
#ifndef MK_N_LAUNCHES
#define MK_N_LAUNCHES 1
#endif
constexpr int NWAVES = 8;
constexpr int PPL = 9;
constexpr int N_PHASES = 2 + PPL * DEPTH;
constexpr size_t MiB = 1u << 20;
constexpr size_t WS_CTL = 0, CTL_ZERO_BYTES = 64 * 1024;
constexpr size_t WS_ROPE = 1 * MiB;
constexpr size_t WS_MOD = 2 * MiB;
constexpr size_t WS_ROWLIST = 4 * MiB, WS_GATEW = 6 * MiB;
constexpr size_t WS_WIN = 8 * MiB, WS_WPA = 18 * MiB, WS_WPB = 19 * MiB, WS_WO = 20 * MiB, WS_WGU = 22 * MiB, WS_WDN = 38 * MiB;
constexpr size_t WS_H = 48 * MiB;
constexpr size_t WS_OUTB = 112 * MiB;
constexpr size_t WS_QA = 128 * MiB, WS_KA = 160 * MiB, WS_VA = 168 * MiB, WS_QD = 176 * MiB, WS_KD = 224 * MiB, WS_VDT = 272 * MiB, WS_G = 320 * MiB;
constexpr size_t WS_MERGED = 160 * MiB;
constexpr size_t WS_TMP = 224 * MiB;
constexpr size_t WS_ACT = 224 * MiB;
constexpr size_t WS_Y2 = 320 * MiB;
constexpr size_t WS_TRASH = 448 * MiB;
constexpr size_t WS_LSE = 449 * MiB;
constexpr size_t WS_STATS = 451 * MiB;
constexpr size_t WS_XS = 385 * MiB;
constexpr size_t WS_GMIX = 452 * MiB;
constexpr size_t WS_END = 516 * MiB;
constexpr int CW_GCNT = 1024;
constexpr int CW_BAR = 4096;
constexpr int CW_PANEL = 8192;
constexpr int RING_OFF = 0, RING_BYTES = 131072;
constexpr int LDSCTL_OFF = RING_BYTES, MISC_OFF = LDSCTL_OFF + 320;
constexpr int MOETAB_OFF = LDSCTL_OFF + 512;
constexpr int LDS_BYTES = 147456;

struct Frame {
    LAS unsigned char* lds;
    volatile LAS unsigned* MISC;
    gu32* ctl;
    int tid, lane, wave, vcu, G;
};
__device__ __forceinline__ float wave_sum(float v) {
#pragma unroll
    for (int o = 1; o < 64; o <<= 1) v += __shfl_xor(v, o);
    return v;
}
__device__ __forceinline__ float bf2f_(unsigned short b) { return __uint_as_float((unsigned)b << 16); }

__device__ __forceinline__ int hpw_row(int n) { const int c = n & 255; return (n & ~255) + 128 * ((c >> 5) & 1) + 32 * (c >> 6) + 16 * ((c >> 2) & 1) + 4 * ((c >> 3) & 3) + (c & 3); }
__device__ __forceinline__ int hpw_row16(int n) { const int c = n & 255; return (n & ~255) + 128 * ((c >> 3) & 1) + 32 * (c >> 6) + 16 * ((c >> 2) & 1) + 4 * ((c >> 4) & 3) + (c & 3); }
__device__ __forceinline__ int gu_row(int f, int which) { return (f >> 7) * 256 + 128 * ((f >> 2) & 1) + 32 * ((f >> 5) & 3) + 16 * which + 4 * ((f >> 3) & 3) + (f & 3); }

constexpr float FP8_SA = 16.0f, FP8_SWIN = 256.0f;
__device__ __forceinline__ float sat8(float x) { return __builtin_amdgcn_fmed3f(x, -448.0f, 448.0f); }
__device__ __forceinline__ unsigned pk4_fp8(float a, float b, float c, float d) { unsigned w = 0; w = __builtin_amdgcn_cvt_pk_fp8_f32(sat8(a), sat8(b), w, false); w = __builtin_amdgcn_cvt_pk_fp8_f32(sat8(c), sat8(d), w, true); return w; }
template <int MODE>
__device__ __forceinline__ void transpose_item_fp8(const float* W, int K, int N, unsigned char* WT, int row_off, LAS float* scr, int item, int lane, const float FP8_SW) {
    const int nblk = N / 32, kb = item / nblk, nb = item % nblk, k0 = 64 * kb, n0 = 32 * nb;
#pragma unroll
    for (int i = 0; i < 32; ++i) { const int kk = 2 * i + (lane >> 5); scr[kk * 33 + (lane & 31)] = W[(size_t)(k0 + kk) * N + n0 + (lane & 31)]; }
    LDS_WAIT(); asm volatile("" ::: "memory");
    const int n = lane >> 1, kh = (lane & 1) * 32; const LAS float* s = scr + kh * 33 + n;
    v4u o0, o1;
    o0.x = pk4_fp8(s[0 * 33] * FP8_SW, s[1 * 33] * FP8_SW, s[2 * 33] * FP8_SW, s[3 * 33] * FP8_SW); o0.y = pk4_fp8(s[4 * 33] * FP8_SW, s[5 * 33] * FP8_SW, s[6 * 33] * FP8_SW, s[7 * 33] * FP8_SW);
    o0.z = pk4_fp8(s[8 * 33] * FP8_SW, s[9 * 33] * FP8_SW, s[10 * 33] * FP8_SW, s[11 * 33] * FP8_SW); o0.w = pk4_fp8(s[12 * 33] * FP8_SW, s[13 * 33] * FP8_SW, s[14 * 33] * FP8_SW, s[15 * 33] * FP8_SW);
    o1.x = pk4_fp8(s[16 * 33] * FP8_SW, s[17 * 33] * FP8_SW, s[18 * 33] * FP8_SW, s[19 * 33] * FP8_SW); o1.y = pk4_fp8(s[20 * 33] * FP8_SW, s[21 * 33] * FP8_SW, s[22 * 33] * FP8_SW, s[23 * 33] * FP8_SW);
    o1.z = pk4_fp8(s[24 * 33] * FP8_SW, s[25 * 33] * FP8_SW, s[26 * 33] * FP8_SW, s[27 * 33] * FP8_SW); o1.w = pk4_fp8(s[28 * 33] * FP8_SW, s[29 * 33] * FP8_SW, s[30 * 33] * FP8_SW, s[31 * 33] * FP8_SW);
    const int drow_ = MODE == 0 ? hpw_row(n0 + n) : MODE == 3 ? hpw_row16(n0 + n) : MODE == 4 ? (n0 >= 3072 ? hpw_row16(n0 + n) : hpw_row(n0 + n)) : gu_row(n0 + n, MODE - 1);
    unsigned char* dst = WT + (size_t)(row_off + drow_) * K + k0 + kh;
    *(GAS v4u*)dst = o0; *(GAS v4u*)(dst + 16) = o1;
    LDS_WAIT(); asm volatile("" ::: "memory");
}
template <int MODE>
__device__ __forceinline__ void transpose_item(const float* W, int K, int N, pg8::bf16_t* WT, int row_off, LAS float* scr, int item, int lane) {
    const int nblk = N / 32, kb = item / nblk, nb = item % nblk, k0 = 64 * kb, n0 = 32 * nb;
#pragma unroll 8
    for (int i = 0; i < 32; ++i) { const int kk = 2 * i + (lane >> 5); scr[kk * 33 + (lane & 31)] = W[(size_t)(k0 + kk) * N + n0 + (lane & 31)]; }
    LDS_WAIT(); asm volatile("" ::: "memory");
    const int c = lane & 7;
#pragma unroll
    for (int j = 0; j < 4; ++j) { const int n = (lane >> 3) + 8 * j; const LAS float* s = scr + (8 * c) * 33 + n;
        v4u o; o.x = pk2(s[0 * 33], s[1 * 33]); o.y = pk2(s[2 * 33], s[3 * 33]); o.z = pk2(s[4 * 33], s[5 * 33]); o.w = pk2(s[6 * 33], s[7 * 33]);
        const int drow = row_off + (MODE == 0 ? hpw_row(n0 + n) : gu_row(n0 + n, MODE - 1));
        *(GAS v4u*)(WT + (size_t)drow * K + k0 + 8 * c) = o; }
    LDS_WAIT(); asm volatile("" ::: "memory");
}
struct Weights { const float *w_in, *w_pa, *w_pb, *w_o, *w_g, *w_u, *w_d; };
__device__ __forceinline__ void convert_layer(Frame& F0, const Weights& W, unsigned char* ws) {
    Frame F = F0;
    LAS float* scr = (LAS float*)(F.lds + RING_OFF + F.wave * 16384);
    const int gw = F.vcu * NWAVES + F.wave, NGW = F.G * NWAVES;
    constexpr int I_IN = 16 * 160, I_PA = 8 * 32, I_PB = 4 * 32, I_O = 16 * 32, I_G = 16 * 128, I_D = 16 * 128;
    constexpr int NITEMS = I_IN + I_PA + I_PB + I_O + 2 * I_G + I_D;
    for (int it = gw; it < NITEMS; it += NGW) {
        int r = it;
        if (r < I_IN) { transpose_item_fp8<4>(W.w_in, 1024, N_IN, ws + WS_WIN, 0, scr, r, F.lane, FP8_SWIN); continue; } r -= I_IN;
        if (r < I_PA) { transpose_item_fp8<3>(W.w_pa, 768, 1024, ws + WS_WPA, 0, scr, r, F.lane, PAB_WSCALE); continue; } r -= I_PA;
        if (r < I_PB) { transpose_item_fp8<3>(W.w_pb, 768, 1024, ws + WS_WPA + 512, 0, scr, r, F.lane, PAB_WSCALE); continue; } r -= I_PB;
        if (r < I_O) { transpose_item_fp8<3>(W.w_o, 1024, 1024, ws + WS_WO, 0, scr, r, F.lane, WO_SCALE); continue; } r -= I_O;
        if (r < I_G) { const int e = r >> 7; transpose_item_fp8<1>(W.w_g + (size_t)e * 1024 * 256, 1024, 256, ws + WS_WGU, e * 512, scr, r & 127, F.lane, GU_WSCALE); continue; } r -= I_G;
        if (r < I_G) { const int e = r >> 7; transpose_item_fp8<2>(W.w_u + (size_t)e * 1024 * 256, 1024, 256, ws + WS_WGU, e * 512, scr, r & 127, F.lane, GU_WSCALE); continue; } r -= I_G;
        { const int e = r >> 7; transpose_item_fp8<3>(W.w_d + (size_t)e * 256 * 1024, 256, 1024, ws + WS_WDN, e * 1024, scr, r & 127, F.lane, DN_WSCALE); }
    }
}

__device__ __forceinline__ void row_stats(const f32x4 (&v)[4], float& mean, float& rstd) {
    float s = 0.f;
#pragma unroll
    for (int j = 0; j < 4; ++j) s += (v[j].x + v[j].y) + (v[j].z + v[j].w);
    mean = wave_sum(s) * (1.f / DM); float s2 = 0.f;
#pragma unroll
    for (int j = 0; j < 4; ++j) { const f32x4 d = v[j] - mean; s2 += (d.x * d.x + d.y * d.y) + (d.z * d.z + d.w * d.w); }
    rstd = 1.f / sqrtf(wave_sum(s2) * (1.f / DM) + LN_EPS);
}
__device__ __forceinline__ void store_row_fp8(unsigned char* orow, int lane, const f32x4 (&v)[4]) {
    GAS unsigned* o4 = (GAS unsigned*)orow + lane;
#pragma unroll
    for (int j = 0; j < 4; ++j) o4[64 * j] = pk4_fp8(sat8(v[j].x * FP8_SA), sat8(v[j].y * FP8_SA), sat8(v[j].z * FP8_SA), sat8(v[j].w * FP8_SA));
}
__device__ __forceinline__ void store_row_bf16(pg8::bf16_t* orow, int lane, const f32x4 (&v)[4]) {
    GAS unsigned long long* o8 = (GAS unsigned long long*)orow + lane;
#pragma unroll
    for (int j = 0; j < 4; ++j) o8[64 * j] = (unsigned long long)pk2(v[j].x, v[j].y) | ((unsigned long long)pk2(v[j].z, v[j].w) << 32);
}

__device__ __forceinline__ void phase_pr0(Frame& F, const float* c, const float* w_ada, const float* b_ada, float* mod, float* rope, const Weights& W0, unsigned char* ws) {
    LAS float* condT = (LAS float*)(F.lds);
    LAS float* red = (LAS float*)(F.lds + 65536);
    for (int idx = F.tid; idx < 16 * 1024; idx += NWAVES * 64) { const int b = idx >> 10, k = idx & 1023; const float x = c[idx]; condT[k * 16 + b] = x / (1.f + __expf(-x)); }
    __syncthreads();
    for (int it = F.vcu; it < 4 * 96; it += F.G) {
        const int l = it / 96, cb = it % 96, n = cb * 64 + F.lane;
        const float* wp = w_ada + ((size_t)l * 1024 + F.wave * 128) * 6144 + n;
        float a[16];
#pragma unroll
        for (int b = 0; b < 16; ++b) a[b] = 0.f;
        for (int k0 = 0; k0 < 128; k0 += 8) {
            float wv[8];
#pragma unroll
            for (int kk = 0; kk < 8; ++kk) wv[kk] = wp[(size_t)(k0 + kk) * 6144];
#pragma unroll
            for (int kk = 0; kk < 8; ++kk) {
                const LAS f32x4* cp = (const LAS f32x4*)(condT + (F.wave * 128 + k0 + kk) * 16);
#pragma unroll
                for (int q = 0; q < 4; ++q) { const f32x4 cv = cp[q]; a[4 * q] += wv[kk] * cv.x; a[4 * q + 1] += wv[kk] * cv.y; a[4 * q + 2] += wv[kk] * cv.z; a[4 * q + 3] += wv[kk] * cv.w; }
            }
        }
#pragma unroll
        for (int b = 0; b < 16; ++b) red[(F.wave * 16 + b) * 64 + F.lane] = a[b];
        __syncthreads();
        for (int o = F.tid; o < 1024; o += NWAVES * 64) { const int b = o >> 6, nn = o & 63; float s = b_ada[(size_t)l * 6144 + cb * 64 + nn];
#pragma unroll
            for (int w = 0; w < 8; ++w) s += red[(w * 16 + b) * 64 + nn];
            mod[((size_t)l * 16 + b) * 6144 + cb * 64 + nn] = s; }
        __syncthreads();
    }
    if (F.vcu == 0 && F.tid < 16) {
        const int k = F.tid; double th = 1.0; for (int i = 0; i < k; ++i) th *= 0.5623413251903491;
        double c1 = 1.0, s1 = th; { double tc = 1.0, tsn = th; const double t2 = th * th;
            for (int i = 1; i < 14; ++i) { tc *= -t2 / ((2.0 * i - 1.0) * (2.0 * i)); tsn *= -t2 / ((2.0 * i) * (2.0 * i + 1.0)); c1 += tc; s1 += tsn; } }
        double cc = 1.0, sn = 0.0;
        for (int a = 0; a < 64; ++a) { rope[(a * 16 + k) * 2] = (float)cc; rope[(a * 16 + k) * 2 + 1] = (float)sn; const double nc = cc * c1 - sn * s1, ns = sn * c1 + cc * s1; cc = nc; sn = ns; }
    }
    __syncthreads();
    convert_layer(F, W0, ws);
}
__device__ __forceinline__ void phase_pr1(Frame& F, const float* x, const float* mod0, pg8::bf16_t* H) {
    for (int blk = F.vcu; blk < T_TOK / 128; blk += F.G) {
        const int b = blk >> 4; const float* mb = mod0 + (size_t)b * 6144;
        f32x4 sh[4], sc[4];
#pragma unroll
        for (int j = 0; j < 4; ++j) { sh[j] = *(const f32x4*)(mb + 4 * F.lane + 256 * j); sc[j] = *(const f32x4*)(mb + 1024 + 4 * F.lane + 256 * j) + 1.0f; }
        for (int k = 0; k < 16; k += 4) {
            const int row0 = blk * 128 + F.wave * 16 + k;
            f32x4 v[4][4];
#pragma unroll
            for (int q = 0; q < 4; ++q) { const GAS f32x4* xr = (const GAS f32x4*)(x + (size_t)(row0 + q) * DM) + F.lane;
#pragma unroll
                for (int j = 0; j < 4; ++j) v[q][j] = xr[64 * j]; }
#pragma unroll
            for (int q = 0; q < 4; ++q) {
                float mean, rstd; row_stats(v[q], mean, rstd);
#pragma unroll
                for (int j = 0; j < 4; ++j) v[q][j] = (v[q][j] - mean) * rstd * sc[j] + sh[j];
                store_row_fp8((unsigned char*)H + (size_t)(row0 + q) * DM, F.lane, v[q]);
            }
        }
    }
}
template <bool XF32>
__device__ __forceinline__ void phase_ln1(Frame& F0, const float* xb, const pg8::bf16_t* gmix, const float* ln_g, const float* ln_b, const float* modl, const float* w_router, const float* rbias,
                                          pg8::bf16_t* H, int* rowlist, float* gatew, gu32* gcnt, float* stats, const bool dry = false) {
    Frame F = F0;
    LAS float* wr = (LAS float*)(F.lds);
    LAS float* cst = (LAS float*)(F.lds + 65536);
    LAS int* lcnt = (LAS int*)(F.lds + 81920);
    LAS int* gbase = lcnt + 16;
    LAS int* st_e = lcnt + 32;
    LAS float* st_g = (LAS float*)(lcnt + 32 + 256);
    { f32x4 t[8];
#pragma unroll
      for (int i = 0; i < 8; ++i) t[i] = ((const f32x4*)w_router)[F.tid + NWAVES * 64 * i];
#pragma unroll
      for (int i = 0; i < 8; ++i) { const int q4 = F.tid + NWAVES * 64 * i, k = q4 >> 2, e0 = (q4 & 3) * 4;
          wr[(e0 + 0) * 1024 + k] = t[i].x; wr[(e0 + 1) * 1024 + k] = t[i].y; wr[(e0 + 2) * 1024 + k] = t[i].z; wr[(e0 + 3) * 1024 + k] = t[i].w; } }
    const float rbl = rbias[F.lane & 15];
    for (int blk = F.vcu; blk < T_TOK / 128; blk += F.G) {
        const int b = blk >> 4; const float* mb = modl + (size_t)b * 6144;
        __syncthreads();
        for (int idx = F.tid; idx < 1024; idx += NWAVES * 64) { cst[idx] = ln_g[idx]; cst[1024 + idx] = ln_b[idx]; cst[2048 + idx] = 1.0f + mb[4 * 1024 + idx]; cst[3072 + idx] = mb[3 * 1024 + idx]; }
        if (F.tid < 16) lcnt[F.tid] = 0;
        __syncthreads();
        for (int it = 0; it < 4; ++it) {
            f32x4 vv[4][4]; unsigned gm[4][4];
            const int row0 = blk * 128 + F.wave * 16 + it * 4;
#pragma unroll
            for (int q = 0; q < 4; ++q) { const GAS unsigned* gr = (const GAS unsigned*)((const unsigned char*)gmix + (size_t)(row0 + q) * DM) + F.lane;
                if constexpr (XF32) { const GAS f32x4* xr = (const GAS f32x4*)(xb + (size_t)(row0 + q) * DM) + F.lane;
#pragma unroll
                    for (int j = 0; j < 4; ++j) vv[q][j] = xr[64 * j]; }
                else { const GAS u32x2g* xr = (const GAS u32x2g*)((const pg8::bf16_t*)xb + (size_t)(row0 + q) * DM) + F.lane;
#pragma unroll
                    for (int j = 0; j < 4; ++j) { const u32x2g w = xr[64 * j]; vv[q][j].x = __uint_as_float(w.x << 16); vv[q][j].y = __uint_as_float(w.x & 0xffff0000u); vv[q][j].z = __uint_as_float(w.y << 16); vv[q][j].w = __uint_as_float(w.y & 0xffff0000u); } }
#pragma unroll
                for (int j = 0; j < 4; ++j) gm[q][j] = gr[64 * j]; }
#pragma unroll
            for (int q = 0; q < 4; ++q)
#pragma unroll
                for (int j = 0; j < 4; ++j) { typedef float f32x2v __attribute__((ext_vector_type(2))); const f32x2v g0 = __builtin_amdgcn_cvt_pk_f32_fp8(gm[q][j], false), g1 = __builtin_amdgcn_cvt_pk_f32_fp8(gm[q][j], true);
                    f32x4 g4; g4.x = g0[0] * GMIX_DESCALE; g4.y = g0[1] * GMIX_DESCALE; g4.z = g1[0] * GMIX_DESCALE; g4.w = g1[1] * GMIX_DESCALE;
                    vv[q][j] = vv[q][j] * DN_ALPHA + g4; }
            float hq[4][16];
#pragma unroll
            for (int q = 0; q < 4; ++q) {
                const int row = row0 + q;
                f32x4 v[4];
#pragma unroll
                for (int j = 0; j < 4; ++j) v[j] = vv[q][j];
                float mean, rstd; row_stats(v, mean, rstd);
                if (F.lane == 0) { stats[2 * (size_t)row] = mean; stats[2 * (size_t)row + 1] = rstd; }
#pragma unroll
                for (int j = 0; j < 4; ++j) { const f32x4 g4 = *(const LAS f32x4*)(cst + 4 * F.lane + 256 * j), b4 = *(const LAS f32x4*)(cst + 1024 + 4 * F.lane + 256 * j);
                    v[j] = (v[j] - mean) * rstd * g4 + b4; }
                row_stats(v, mean, rstd);
#pragma unroll
                for (int j = 0; j < 4; ++j) { const f32x4 s4 = *(const LAS f32x4*)(cst + 2048 + 4 * F.lane + 256 * j), h4 = *(const LAS f32x4*)(cst + 3072 + 4 * F.lane + 256 * j);
                    v[j] = (v[j] - mean) * rstd * s4 + h4; hq[q][4 * j] = v[j].x; hq[q][4 * j + 1] = v[j].y; hq[q][4 * j + 2] = v[j].z; hq[q][4 * j + 3] = v[j].w; }
                store_row_fp8((unsigned char*)H + (size_t)row * DM, F.lane, v);
            }
            float ac[64];
            typedef float f32x2r __attribute__((ext_vector_type(2)));
#pragma unroll
            for (int e = 0; e < 16; ++e) {
                f32x2r a0 = {0.f, 0.f}, a1 = {0.f, 0.f}, a2 = {0.f, 0.f}, a3 = {0.f, 0.f};
#pragma unroll
                for (int j = 0; j < 4; ++j) { const f32x4 w4 = *(const LAS f32x4*)(wr + e * 1024 + 256 * j + 4 * F.lane);
                    const f32x2r wl = {w4.x, w4.y}, wh = {w4.z, w4.w};
                    a0 = (f32x2r){hq[0][4 * j], hq[0][4 * j + 1]} * wl + a0; a0 = (f32x2r){hq[0][4 * j + 2], hq[0][4 * j + 3]} * wh + a0;
                    a1 = (f32x2r){hq[1][4 * j], hq[1][4 * j + 1]} * wl + a1; a1 = (f32x2r){hq[1][4 * j + 2], hq[1][4 * j + 3]} * wh + a1;
                    a2 = (f32x2r){hq[2][4 * j], hq[2][4 * j + 1]} * wl + a2; a2 = (f32x2r){hq[2][4 * j + 2], hq[2][4 * j + 3]} * wh + a2;
                    a3 = (f32x2r){hq[3][4 * j], hq[3][4 * j + 1]} * wl + a3; a3 = (f32x2r){hq[3][4 * j + 2], hq[3][4 * j + 3]} * wh + a3; }
                ac[e] = a0.x + a0.y; ac[16 + e] = a1.x + a1.y; ac[32 + e] = a2.x + a2.y; ac[48 + e] = a3.x + a3.y;
            }
#pragma unroll
            for (int s = 5; s >= 0; --s) { const int half = 1 << s; const bool up = (F.lane >> s) & 1;
#pragma unroll
                for (int i = 0; i < half; ++i) { const float keep = up ? ac[i + half] : ac[i], send = up ? ac[i] : ac[i + half]; ac[i] = keep + __shfl_xor(send, half); } }
            {
                const int L = F.lane, rowb = L & ~15, quadb = L & ~3;
                const float score = 1.0f / (1.0f + __expf(-ac[0])), selv = score + rbl;
                const float a = __shfl(selv, quadb), bb = __shfl(selv, quadb + 1), cc = __shfl(selv, quadb + 2), d = __shfl(selv, quadb + 3);
                const float hi1 = fmaxf(a, bb), lo1 = fminf(a, bb), hi2 = fmaxf(cc, d), lo2 = fminf(cc, d);
                const float gsq = fmaxf(hi1, hi2) + fmaxf(fminf(hi1, hi2), fmaxf(lo1, lo2));
                float gs[4];
#pragma unroll
                for (int g = 0; g < 4; ++g) gs[g] = __shfl(gsq, rowb + 4 * g);
                int best = 0; float bv = gs[0];
#pragma unroll
                for (int g = 1; g < 4; ++g) if (gs[g] > bv) { bv = gs[g]; best = g; }
                float s4[4], c4[4];
#pragma unroll
                for (int k = 0; k < 4; ++k) { s4[k] = __shfl(selv, rowb + 4 * best + k); c4[k] = __shfl(score, rowb + 4 * best + k); }
                int i1 = 0; float v1 = s4[0];
#pragma unroll
                for (int k = 1; k < 4; ++k) if (s4[k] > v1) { v1 = s4[k]; i1 = k; }
                int i2 = -1; float v2 = -INFINITY;
#pragma unroll
                for (int k = 0; k < 4; ++k) if (k != i1 && s4[k] > v2) { v2 = s4[k]; i2 = k; }
                if (i2 < 0) i2 = (i1 + 1) & 3;
                const float t1 = i1 == 0 ? c4[0] : i1 == 1 ? c4[1] : i1 == 2 ? c4[2] : c4[3];
                const float t2 = i2 == 0 ? c4[0] : i2 == 1 ? c4[1] : i2 == 2 ? c4[2] : c4[3];
                const float inv = 1.0f / (t1 + t2);
                if ((L & 15) == 0 && !dry) {
                    const int rl = F.wave * 16 + it * 4 + (L >> 4), e1 = 4 * best + i1, e2 = 4 * best + i2;
                    const int p1 = atomicAdd((int*)(lcnt + e1), 1), p2 = atomicAdd((int*)(lcnt + e2), 1);
                    st_e[2 * rl] = e1 | (p1 << 8); st_g[2 * rl] = t1 * inv; st_e[2 * rl + 1] = e2 | (p2 << 8); st_g[2 * rl + 1] = t2 * inv;
                }
            }
        }
        __syncthreads();
        if (F.tid < 16 && !dry) gbase[F.tid] = (int)__hip_atomic_fetch_add(gcnt + F.tid, (unsigned)lcnt[F.tid], __ATOMIC_RELAXED, __HIP_MEMORY_SCOPE_AGENT);
        __syncthreads();
        if (F.tid < 256 && !dry) { const int ee = st_e[F.tid], e = ee & 255, lp = ee >> 8, pos = gbase[e] + lp;
            rowlist[(size_t)e * CAP + pos] = ((blk * 128 + (F.tid >> 1)) << 1) | (F.tid & 1); gatew[(size_t)e * CAP + pos] = st_g[F.tid]; }
    }
    __syncthreads();
}
template <bool XF32> struct Ln2Raw { typename std::conditional<XF32, f32x4, u32x2g>::type x[2][4]; unsigned ya[2][4], yb[2][4], gm[2][4]; float st[2][2]; };
template <bool XF32, bool OUTF32>
__device__ __forceinline__ void phase_ln2(Frame& F0, const float* xb, const pg8::bf16_t* gmix, const pg8::bf16_t* y2, const float* stats, const float* ln1_g, const float* ln1_b, const float* ln_g, const float* ln_b, const float* modl, const float* modn, pg8::bf16_t* H, float* xdst) {
    Frame F = F0;
    LAS float* const PRM = (LAS float*)(F.lds + RING_OFF);
    for (int blk = F.vcu; blk < T_TOK / 128; blk += F.G) {
        const int b = blk >> 4; const float* mb = modl + (size_t)b * 6144 + 5 * 1024;
        __syncthreads();
        { const int c4 = F.tid & 255;
          if (F.tid < 256) { *(LAS f32x4*)(PRM + 0 * 1024 + 4 * c4) = *(const f32x4*)(ln1_g + 4 * c4); *(LAS f32x4*)(PRM + 1 * 1024 + 4 * c4) = *(const f32x4*)(ln1_b + 4 * c4);
                             *(LAS f32x4*)(PRM + 2 * 1024 + 4 * c4) = *(const f32x4*)(mb + 4 * c4);    *(LAS f32x4*)(PRM + 3 * 1024 + 4 * c4) = *(const f32x4*)(ln_g + 4 * c4); }
          else { *(LAS f32x4*)(PRM + 4 * 1024 + 4 * c4) = *(const f32x4*)(ln_b + 4 * c4);
                 if (modn) { const float* mn = modn + (size_t)b * 6144; *(LAS f32x4*)(PRM + 5 * 1024 + 4 * c4) = *(const f32x4*)(mn + 1024 + 4 * c4) + 1.0f; *(LAS f32x4*)(PRM + 6 * 1024 + 4 * c4) = *(const f32x4*)(mn + 4 * c4); } } }
        __syncthreads();
#define LN2_PRM(a, j) (*(const LAS f32x4*)(PRM + (a) * 1024 + 4 * F.lane + 256 * (j)))
        const int rowb = blk * 128 + F.wave * 16;
        auto load2 = [&](Ln2Raw<XF32>& R, const int row0) __attribute__((always_inline)) {
#pragma unroll
            for (int q = 0; q < 2; ++q) { R.st[q][0] = stats[2 * (size_t)(row0 + q)]; R.st[q][1] = stats[2 * (size_t)(row0 + q) + 1]; }
#pragma unroll
            for (int q = 0; q < 2; ++q) {
                if constexpr (XF32) { const GAS f32x4* xr = (const GAS f32x4*)(xb + (size_t)(row0 + q) * DM) + F.lane;
#pragma unroll
                    for (int j = 0; j < 4; ++j) R.x[q][j] = xr[64 * j]; }
                else { const GAS u32x2g* xr = (const GAS u32x2g*)((const pg8::bf16_t*)xb + (size_t)(row0 + q) * DM) + F.lane;
#pragma unroll
                    for (int j = 0; j < 4; ++j) R.x[q][j] = xr[64 * j]; }
                const GAS unsigned* pa = (const GAS unsigned*)((const unsigned char*)y2 + (size_t)(row0 + q) * DM) + F.lane; const GAS unsigned* pb = (const GAS unsigned*)((const unsigned char*)y2 + ((size_t)T_TOK + row0 + q) * DM) + F.lane;
                const GAS unsigned* gr = (const GAS unsigned*)((const unsigned char*)gmix + (size_t)(row0 + q) * DM) + F.lane;
#pragma unroll
                for (int j = 0; j < 4; ++j) { R.ya[q][j] = pa[64 * j]; R.yb[q][j] = pb[64 * j]; R.gm[q][j] = gr[64 * j]; } } };
        auto norm2 = [&](const Ln2Raw<XF32>& R, const int row0) __attribute__((always_inline)) {
            f32x4 v[2][4];
#pragma unroll
            for (int j = 0; j < 4; ++j) { asm volatile("" ::: "memory"); const f32x4 l1g = LN2_PRM(0, j), l1b = LN2_PRM(1, j), g2 = LN2_PRM(2, j);
#pragma unroll
                for (int q = 0; q < 2; ++q) { const unsigned a = R.ya[q][j], c = R.yb[q][j];
                    typedef float f32x2v __attribute__((ext_vector_type(2)));
                    const f32x2v a0 = __builtin_amdgcn_cvt_pk_f32_fp8(a, false), a1 = __builtin_amdgcn_cvt_pk_f32_fp8(a, true), c0 = __builtin_amdgcn_cvt_pk_f32_fp8(c, false), c1 = __builtin_amdgcn_cvt_pk_f32_fp8(c, true);
                    f32x4 ff; ff.x = (a0[0] + c0[0]) * Y2_DESCALE; ff.y = (a0[1] + c0[1]) * Y2_DESCALE; ff.z = (a1[0] + c1[0]) * Y2_DESCALE; ff.w = (a1[1] + c1[1]) * Y2_DESCALE;
                    const f32x2v gg0 = __builtin_amdgcn_cvt_pk_f32_fp8(R.gm[q][j], false), gg1 = __builtin_amdgcn_cvt_pk_f32_fp8(R.gm[q][j], true);
                    f32x4 g4; g4.x = gg0[0] * GMIX_DESCALE; g4.y = gg0[1] * GMIX_DESCALE; g4.z = gg1[0] * GMIX_DESCALE; g4.w = gg1[1] * GMIX_DESCALE;
                    f32x4 xq;
                    if constexpr (XF32) xq = R.x[q][j];
                    else { const u32x2g w = R.x[q][j]; xq.x = __uint_as_float(w.x << 16); xq.y = __uint_as_float(w.x & 0xffff0000u); xq.z = __uint_as_float(w.y << 16); xq.w = __uint_as_float(w.y & 0xffff0000u); }
                    const f32x4 y1 = xq * DN_ALPHA + g4;
                    const f32x4 x1 = (y1 - R.st[q][0]) * R.st[q][1] * l1g + l1b;
                    v[q][j] = x1 * DN_ALPHA + g2 * ff; } }
            float mean[2], rstd[2];
#pragma unroll
            for (int q = 0; q < 2; ++q) row_stats(v[q], mean[q], rstd[q]);
#pragma unroll
            for (int j = 0; j < 4; ++j) { asm volatile("" ::: "memory"); const f32x4 lg = LN2_PRM(3, j), lb = LN2_PRM(4, j);
#pragma unroll
                for (int q = 0; q < 2; ++q) v[q][j] = (v[q][j] - mean[q]) * rstd[q] * lg + lb; }
#pragma unroll
            for (int q = 0; q < 2; ++q) { const int row = row0 + q;
                if constexpr (OUTF32) { GAS f32x4* xr = (GAS f32x4*)(xdst + (size_t)row * DM) + F.lane;
#pragma unroll
                    for (int j = 0; j < 4; ++j) xr[64 * j] = v[q][j]; }
                else store_row_bf16((pg8::bf16_t*)xdst + (size_t)row * DM, F.lane, v[q]); }
            if (modn) {
#pragma unroll
                for (int q = 0; q < 2; ++q) row_stats(v[q], mean[q], rstd[q]);
#pragma unroll
                for (int j = 0; j < 4; ++j) { asm volatile("" ::: "memory"); const f32x4 s4 = LN2_PRM(5, j), h4 = LN2_PRM(6, j);
#pragma unroll
                    for (int q = 0; q < 2; ++q) v[q][j] = (v[q][j] - mean[q]) * rstd[q] * s4 + h4; }
#pragma unroll
                for (int q = 0; q < 2; ++q) store_row_fp8((unsigned char*)H + (size_t)(row0 + q) * DM, F.lane, v[q]);
            } };
        Ln2Raw<XF32> RA, RB;
        load2(RA, rowb);
#pragma nounroll
        for (int k = 0; k < 16; k += 4) {
            load2(RB, rowb + k + 2);
            norm2(RA, rowb + k);
            if (k + 4 < 16) load2(RA, rowb + k + 4);
            norm2(RB, rowb + k + 2);
        }
#undef LN2_PRM
    }
    __syncthreads();
}
__device__ __forceinline__ void phase_combine(Frame& F0, const pg8::bf16_t* OD, const float* LSE, pg8::bf16_t* OUTB, gu32* pcnt) {
    Frame F = F0;
    const int hh = F.lane >> 4, d4 = (F.lane & 15) * 4;
    for (int blk = F.vcu; blk < T_TOK / 128; blk += F.G) {
        const int b = blk >> 4;
        for (int k = 0; k < 16; k += 8) {
            unsigned ov[8][3]; float ls[8][3];
#pragma unroll
            for (int q = 0; q < 8; ++q) { const int s = (blk & 15) * 128 + F.wave * 16 + k + q;
#pragma unroll
                for (int g = 0; g < 3; ++g) { const size_t rg = (size_t)(b * 12 + g * 4 + hh) * SEQ + pg8::pg_perm(g, s);
                    ls[q][g] = LSE[rg]; ov[q][g] = *(const GAS unsigned*)((const unsigned char*)OD + rg * 64 + d4); } }
#pragma unroll
            for (int q = 0; q < 8; ++q) { const int s = (blk & 15) * 128 + F.wave * 16 + k + q;
                const float m = fmaxf(fmaxf(ls[q][0], ls[q][1]), ls[q][2]);
                const float w0 = __builtin_amdgcn_exp2f(ls[q][0] - m), w1 = __builtin_amdgcn_exp2f(ls[q][1] - m), w2 = __builtin_amdgcn_exp2f(ls[q][2] - m), inv = 1.0f / (w0 + w1 + w2);
                float o[4];
                { typedef float f32x2v __attribute__((ext_vector_type(2)));
                  const f32x2v a0 = __builtin_amdgcn_cvt_pk_f32_fp8(ov[q][0], false), a1 = __builtin_amdgcn_cvt_pk_f32_fp8(ov[q][0], true), b0 = __builtin_amdgcn_cvt_pk_f32_fp8(ov[q][1], false), b1 = __builtin_amdgcn_cvt_pk_f32_fp8(ov[q][1], true),
                              c0 = __builtin_amdgcn_cvt_pk_f32_fp8(ov[q][2], false), c1 = __builtin_amdgcn_cvt_pk_f32_fp8(ov[q][2], true);
                  const float is_ = inv * (1.0f / attn_body::OUT_SCALE);
                  o[0] = (w0 * a0[0] + w1 * b0[0] + w2 * c0[0]) * is_; o[1] = (w0 * a0[1] + w1 * b0[1] + w2 * c0[1]) * is_;
                  o[2] = (w0 * a1[0] + w1 * b1[0] + w2 * c1[0]) * is_; o[3] = (w0 * a1[1] + w1 * b1[1] + w2 * c1[1]) * is_; }
                __hip_atomic_store((GAS unsigned*)((unsigned char*)OUTB + ((size_t)b * SEQ + s) * 768 + 512 + hh * 64 + d4), pk4_fp8(sat8(o[0] * PAB_ASCALE), sat8(o[1] * PAB_ASCALE), sat8(o[2] * PAB_ASCALE), sat8(o[3] * PAB_ASCALE)), __ATOMIC_RELAXED, __HIP_MEMORY_SCOPE_AGENT); }
        }
        VM_WAIT();
        if (F.lane == 0) (void)__hip_atomic_fetch_add(pcnt + 16 * (blk >> 1), 1u, __ATOMIC_RELAXED, __HIP_MEMORY_SCOPE_AGENT);
    }
}
__device__ __forceinline__ void moe_table(Frame& F, gu32* gcnt) {
    LAS int* tab = (LAS int*)(F.lds + MOETAB_OFF);
    __syncthreads();
    if (F.wave == 0) {
        const int ln = hw_lane(); int c = 0;
        if (ln < 16) { c = (int)__hip_atomic_load(gcnt + ln, __ATOMIC_RELAXED, __HIP_MEMORY_SCOPE_AGENT); if (c > CAP) c = CAP; if (c < 0) c = 0; }
        const int tiles = (c + 255) >> 8; int inc = tiles;
#pragma unroll
        for (int o = 1; o < 16; o <<= 1) { const int t = __shfl_up(inc, o); if (ln >= o) inc += t; }
        if (ln < 16) { tab[ln] = c; tab[16 + ln] = inc - tiles; }
        if (ln == 15) tab[32] = inc; }
    __syncthreads();
}
struct Args { const float* in[19]; float* out; unsigned char* ws; int ph_lo, ph_hi; };
typedef const __attribute__((address_space(4))) Args* KArgs;
__device__ __forceinline__ Weights layer_weights(KArgs ap_, int l) {
    struct { const float* in[19]; } a; a.in[4] = ap_->in[4]; a.in[7] = ap_->in[7]; a.in[8] = ap_->in[8]; a.in[9] = ap_->in[9]; a.in[14] = ap_->in[14]; a.in[15] = ap_->in[15]; a.in[16] = ap_->in[16];
    Weights W; W.w_in = a.in[4] + (size_t)l * 1024 * N_IN; W.w_pa = a.in[7] + (size_t)l * 512 * 1024; W.w_pb = a.in[8] + (size_t)l * 256 * 1024; W.w_o = a.in[9] + (size_t)l * 1024 * 1024;
    W.w_g = a.in[14] + (size_t)l * 16 * 1024 * 256; W.w_u = a.in[15] + (size_t)l * 16 * 1024 * 256; W.w_d = a.in[16] + (size_t)l * 16 * 256 * 1024; return W;
}
#ifndef SKIPMASK
#define SKIPMASK 0
#endif
#define IN(k) (lo <= (k) && (k) < hi)
#define SEAM(k) do { if (IN(k) && IN((k) + 1)) { XcdBarrier b2_ = bar; asm volatile("" : "+s"(b2_.x), "+s"(b2_.bar)); int w0_ = F.wave; asm volatile("" : "+s"(w0_)); REPS(20) xcd_barrier(b2_, w0_ == 0 && hw_lane() == 0); } } while (0)
#ifndef PROBE_DUP
#define PROBE_DUP -1
#endif
#define REPS(k) _Pragma("unroll") for (int rep_ = 0; rep_ < ((PROBE_DUP) == (k) ? 2 : 1); ++rep_)
#define PHASE_ARGS KArgs ap = kargs; int bx_ = (int)blockIdx.x; Frame FF = F; asm volatile("" : "+s"(ap), "+s"(bx_), "+s"(FF.G), "+s"(FF.vcu), "+s"(FF.wave)); FF.lane = hw_lane(); FF.tid = FF.wave * 64 + FF.lane; unsigned char* const ws = ap->ws; (void)ws; (void)bx_
template <int l>
__device__ __forceinline__ void layer_phases(Frame& F, const KArgs kargs, const int lo, const int hi, const XcdBarrier& bar, unsigned char* lds) {
    using pg8::bf16_t;
    const LAS int* tab = (const LAS int*)(F.lds + MOETAB_OFF);
    {
        const int P = 2 + PPL * l;
        if (IN(P + 0)) {
            PHASE_ARGS;
            pg8::Gemm g{(const bf16_t*)(ws + WS_H), (const bf16_t*)(ws + WS_WIN), T_TOK, N_IN, 1024}; pg8::StaticOrder S; S.init(T_TOK, N_IN, FF.G, bx_);
            pg8::EpiIn E{(bf16_t*)(ws + WS_QA), (bf16_t*)(ws + WS_KA), (bf16_t*)(ws + WS_VA), (bf16_t*)(ws + WS_QD), (bf16_t*)(ws + WS_KD), (bf16_t*)(ws + WS_VDT), (bf16_t*)(ws + WS_G),
                         ap->in[5] + l * 64, ap->in[6] + l * 64, (const float*)(ws + WS_ROPE)};
#ifdef IN_STAGGER
            { const unsigned long long t0_ = __builtin_amdgcn_s_memrealtime(), dl_ = (unsigned long long)(FF.vcu & 3) * IN_STAGGER;
              while (__builtin_amdgcn_s_memrealtime() - t0_ < dl_) __builtin_amdgcn_s_sleep(8); }
#endif
            REPS(0) { pg8::gemm_phase<pg8::EpiIn, pg8::StaticOrder, true, false, true>(F.lds + RING_OFF, g, S, E, FF.wave);
#ifdef PROBE_BAR
              if (rep_ == 0) { XcdBarrier b3_ = bar; asm volatile("" : "+s"(b3_.x), "+s"(b3_.bar)); xcd_barrier(b3_, FF.wave == 0 && hw_lane() == 0); }
#endif
            }
            SEAM(P + 0);
        }
        if (IN(P + 1)) {
            PHASE_ARGS;
            { const attn_body::AttnTensors BT{(const attn_body::bf16*)(ws + WS_QD), (const attn_body::bf16*)(ws + WS_KD), (const attn_body::bf16*)(ws + WS_VDT), (attn_body::bf16*)(ws + WS_QD), ws + WS_H + 24 * MiB};
              const attn_body::OrderB S{FF.vcu, FF.G, BT, (float*)(ws + WS_LSE)};
              attn_body::attn_phase<attn_body::CfgB, attn_body::OrderB>((char*)lds + RING_OFF, S, FF.wave); }
            { const attn_body::AttnTensors AT{(const attn_body::bf16*)(ws + WS_QA), (const attn_body::bf16*)(ws + WS_KA), (const attn_body::bf16*)(ws + WS_VA), (attn_body::bf16*)(ws + WS_QA), ws + WS_H};
              const attn_body::OrderA S{FF.vcu, FF.G, AT};
              attn_body::attn_phase<attn_body::CfgA, attn_body::OrderA>((char*)lds + RING_OFF, S, FF.wave); }
            SEAM(P + 1);
        }
        if (IN(P + 2)) {
            PHASE_ARGS;
            gu32* const pcnt = F.ctl + CW_PANEL + 2048 * l;
            phase_combine(FF, (const bf16_t*)(ws + WS_H + 24 * MiB), (const float*)(ws + WS_LSE), (bf16_t*)(ws + WS_H), pcnt);
            { pg8::StaticOrder S; S.init(T_TOK, 1024, FF.G, bx_);
              if (FF.wave == 0) {
                  pg8::Unit u; unsigned sp = 0;
                  for (int i = 0; S.next(i, u); ++i)
                      while (__builtin_amdgcn_readfirstlane((int)__hip_atomic_load(pcnt + 16 * u.pm, __ATOMIC_RELAXED, __HIP_MEMORY_SCOPE_AGENT)) < 16) { __builtin_amdgcn_s_sleep(2); if (++sp > (1u << 22)) break; } }
              VM_WAIT(); __builtin_amdgcn_fence(__ATOMIC_ACQUIRE, "agent"); VM_WAIT(); __syncthreads();
              pg8::Gemm g{(const bf16_t*)(ws + WS_H), (const bf16_t*)(ws + WS_WPA), T_TOK, 1024, 768};
              pg8::EpiMergeF E{(const bf16_t*)(ws + WS_G), (bf16_t*)(ws + WS_MERGED)};
              pg8::gemm_phase<pg8::EpiMergeF, pg8::StaticOrder, true, false, true, true>(F.lds + RING_OFF, g, S, E, FF.wave); }
            SEAM(P + 2);
        }
        if (IN(P + 4)) {
            PHASE_ARGS;
            pg8::Gemm g{(const bf16_t*)(ws + WS_MERGED), (const bf16_t*)(ws + WS_WO), T_TOK, 1024, 1024}; pg8::StaticOrder S; S.init(T_TOK, 1024, FF.G, bx_);
            REPS(3) { pg8::EpiRes E{(bf16_t*)(ws + WS_GMIX), (const float*)(ws + WS_MOD) + (size_t)l * 16 * 6144 + 2 * 1024};
            pg8::gemm_phase<pg8::EpiRes, pg8::StaticOrder, true, false, true>(F.lds + RING_OFF, g, S, E, FF.wave); }
            SEAM(P + 4);
        }
        if (IN(P + 5)) {
            PHASE_ARGS;
            if ((PROBE_DUP) == 40) { phase_ln1<l == 0>(FF, l == 0 ? ap->in[0] : (const float*)(ws + WS_XS), (const bf16_t*)(ws + WS_GMIX), ap->in[10] + l * 1024, ap->in[11] + l * 1024, (const float*)(ws + WS_MOD) + (size_t)l * 16 * 6144, ap->in[12], ap->in[13], (bf16_t*)(ws + WS_QD),
                      (int*)(ws + WS_ROWLIST), (float*)(ws + WS_GATEW), F.ctl + CW_GCNT + 64 * l, (float*)(ws + WS_LSE), true); VM_WAIT(); __syncthreads(); }
            phase_ln1<l == 0>(FF, l == 0 ? ap->in[0] : (const float*)(ws + WS_XS), (const bf16_t*)(ws + WS_GMIX), ap->in[10] + l * 1024, ap->in[11] + l * 1024, (const float*)(ws + WS_MOD) + (size_t)l * 16 * 6144, ap->in[12], ap->in[13], (bf16_t*)(ws + WS_H),
                      (int*)(ws + WS_ROWLIST), (float*)(ws + WS_GATEW), F.ctl + CW_GCNT + 64 * l, (float*)(ws + WS_STATS));
            SEAM(P + 5);
        }
        if (IN(P + 6)) {
            PHASE_ARGS;
            moe_table(FF, F.ctl + CW_GCNT + 64 * l);
            pg8::Gemm g{(const bf16_t*)(ws + WS_H), (const bf16_t*)(ws + WS_WGU), T_TOK, 512, 1024};
            pg8::MoeOrder<true> S{tab, (const int*)(ws + WS_ROWLIST), 2, FF.G, bx_};
            pg8::EpiGU E{(bf16_t*)(ws + WS_ACT), (const float*)(ws + WS_GATEW), tab};
            REPS(5) pg8::gemm_phase<pg8::EpiGU, pg8::MoeOrder<true>, true, true, true>(F.lds + RING_OFF, g, S, E, FF.wave);
            SEAM(P + 6);
        }
        if (IN(P + 7)) {
            PHASE_ARGS;
            moe_table(FF, F.ctl + CW_GCNT + 64 * l);
            pg8::Gemm g{(const bf16_t*)(ws + WS_ACT), (const bf16_t*)(ws + WS_WDN), T_TOK, 1024, 256};
            pg8::MoeOrder<false> S{tab, (const int*)(ws + WS_ROWLIST), 4, FF.G, bx_};
            pg8::EpiDown E{(bf16_t*)(ws + WS_Y2), (const int*)(ws + WS_ROWLIST), tab};
            REPS(6) { pg8::gemm_phase<pg8::EpiDown, pg8::MoeOrder<false>, true, false, true>(F.lds + RING_OFF, g, S, E, FF.wave); VM_WAIT(); __syncthreads(); }
            SEAM(P + 7);
        }
        if (IN(P + 8)) {
            PHASE_ARGS;
            const float* modl = (const float*)(ws + WS_MOD) + (size_t)l * 16 * 6144;
            if ((PROBE_DUP) == 41) { phase_ln2<l == 0, true>(FF, l == 0 ? ap->in[0] : (const float*)(ws + WS_XS), (const bf16_t*)(ws + WS_GMIX), (const bf16_t*)(ws + WS_Y2), (const float*)(ws + WS_STATS), ap->in[10] + l * 1024, ap->in[11] + l * 1024, ap->in[17] + l * 1024, ap->in[18] + l * 1024, modl, l + 1 < DEPTH ? modl + 16 * 6144 : nullptr, (bf16_t*)(ws + WS_OUTB), (float*)(ws + WS_QA)); VM_WAIT(); __syncthreads(); }
            phase_ln2<l == 0, l + 1 == DEPTH>(FF, l == 0 ? ap->in[0] : (const float*)(ws + WS_XS), (const bf16_t*)(ws + WS_GMIX), (const bf16_t*)(ws + WS_Y2), (const float*)(ws + WS_STATS), ap->in[10] + l * 1024, ap->in[11] + l * 1024, ap->in[17] + l * 1024, ap->in[18] + l * 1024, modl, l + 1 < DEPTH ? modl + 16 * 6144 : nullptr, (bf16_t*)(ws + WS_H), l + 1 == DEPTH ? ap->out : (float*)(ws + WS_XS));
            if (l + 1 < DEPTH) { __syncthreads(); const Weights Wn = layer_weights(ap, l + 1); REPS(7) convert_layer(FF, Wn, ws); }
            SEAM(P + 8);
        }
    }
}
__global__ void __launch_bounds__(NWAVES * 64, 2) fwd_kernel(Args args_unused) {
    extern __shared__ __attribute__((aligned(16))) unsigned char lds[];
    Frame F;
    F.lds = (LAS unsigned char*)lds;
    F.MISC = (volatile LAS unsigned*)(F.lds + MISC_OFF);
    F.wave = __builtin_amdgcn_readfirstlane((int)threadIdx.x >> 6); F.lane = hw_lane(); F.tid = F.wave * 64 + F.lane;
    F.G = gridDim.x; { const int bx = blockIdx.x; F.vcu = (F.G % 8 == 0) ? (bx % 8) * (F.G / 8) + bx / 8 : bx; }
    const KArgs kargs = (KArgs)__builtin_amdgcn_kernarg_segment_ptr();
    F.ctl = (gu32*)(kargs->ws + WS_CTL);
    for (int u = F.tid; u < (LDS_BYTES - LDSCTL_OFF) / 4; u += NWAVES * 64) ((LAS unsigned*)(F.lds + LDSCTL_OFF))[u] = 0u;
    __syncthreads();
    const int lo = kargs->ph_lo, hi = kargs->ph_hi;
    XcdBarrier bar; bar.bar = (unsigned*)(F.ctl + CW_BAR); bar.x = 0; bar.st = nullptr;
    if (hi - lo > 1) bar = xcd_barrier_post((unsigned*)(F.ctl + CW_BAR), F.MISC + 8);
    using pg8::bf16_t;
    const LAS int* tab = (const LAS int*)(F.lds + MOETAB_OFF);

    if (IN(0)) { PHASE_ARGS; const Weights W0 = layer_weights(ap, 0); REPS(30) { phase_pr0(FF, ap->in[1], ap->in[2], ap->in[3], (float*)(ws + WS_MOD), (float*)(ws + WS_ROPE), W0, ws); VM_WAIT(); __syncthreads(); } SEAM(0); }
    if (IN(1)) { PHASE_ARGS; REPS(31) phase_pr1(FF, ap->in[0], (const float*)(ws + WS_MOD), (bf16_t*)(ws + WS_H)); SEAM(1); }

    layer_phases<0>(F, kargs, lo, hi, bar, lds); layer_phases<1>(F, kargs, lo, hi, bar, lds); layer_phases<2>(F, kargs, lo, hi, bar, lds); layer_phases<3>(F, kargs, lo, hi, bar, lds);
#undef IN
#undef SEAM
#undef PHASE_ARGS
}

extern "C" void kernel_launch(void* const* d_in, const int* in_sizes, int n_in, void* d_out, int out_size, void* d_ws, size_t ws_size, hipStream_t stream) {
    static int grid = 0;
    if (grid == 0) {
        if (n_in != 19 || in_sizes[0] != T_TOK * DM || out_size != T_TOK * DM || ws_size < WS_END) { fprintf(stderr, "kernel_launch: unexpected shapes/workspace (n_in %d, ws %zu); nothing launched\n", n_in, ws_size); grid = -1; return; }
        int dev = 0, cus = 0, per_cu = 0;
        if (hipGetDevice(&dev) != hipSuccess || hipDeviceGetAttribute(&cus, hipDeviceAttributeMultiprocessorCount, dev) != hipSuccess) { grid = -1; return; }
        if (hipFuncSetAttribute((const void*)fwd_kernel, hipFuncAttributeMaxDynamicSharedMemorySize, LDS_BYTES) != hipSuccess) { fprintf(stderr, "kernel_launch: hipFuncSetAttribute failed\n"); grid = -1; return; }
        if (hipOccupancyMaxActiveBlocksPerMultiprocessor(&per_cu, (const void*)fwd_kernel, NWAVES * 64, LDS_BYTES) != hipSuccess || per_cu < 1) { fprintf(stderr, "kernel_launch: occupancy query reports %d\n", per_cu); }
        (void)hipGetLastError();
        grid = cus;
    }
    if (grid < 0) return;
    if (hipMemsetAsync((char*)d_ws + WS_CTL, 0, CTL_ZERO_BYTES, stream) != hipSuccess) return;
    Args a{};
    for (int i = 0; i < 19; ++i) a.in[i] = (const float*)d_in[i];
    a.out = (float*)d_out; a.ws = (unsigned char*)d_ws;
#if MK_N_LAUNCHES == 1
    a.ph_lo = 0; a.ph_hi = N_PHASES;
    hipLaunchKernelGGL(fwd_kernel, dim3(grid), dim3(NWAVES * 64), LDS_BYTES, stream, a);
#else
    for (int p = 0; p < N_PHASES; ++p) { a.ph_lo = p; a.ph_hi = p + 1; hipLaunchKernelGGL(fwd_kernel, dim3(grid), dim3(NWAVES * 64), LDS_BYTES, stream, a); }
#endif
}
```

```cpp
#include <hip/hip_runtime.h>
#include <hip/hip_bf16.h>
#include <cstdio>
#include <cstdint>
#include <cmath>
__device__ __forceinline__ int hw_lane() { int l; asm volatile("v_mbcnt_lo_u32_b32 %0, -1, 0\n\tv_mbcnt_hi_u32_b32 %0, -1, %0" : "=v"(l)); return l; }
namespace pg8 {
#define PG8_LAS __attribute__((address_space(3)))
typedef unsigned short bf16_t;
typedef short bf16x8 __attribute__((ext_vector_type(8)));
typedef float f32x4 __attribute__((ext_vector_type(4)));
typedef unsigned u32x4 __attribute__((ext_vector_type(4)));
typedef unsigned u32x2 __attribute__((ext_vector_type(2)));
typedef int i32x4 __attribute__((ext_vector_type(4)));
typedef int i32x8 __attribute__((ext_vector_type(8)));
constexpr int BM = 256, BK = 64, HALF = 128, HTB = HALF * BK * 2  , STAGE_BYTES = 8 * HTB, NXCD = 8, WGM = 8;

__host__ __device__ __forceinline__ int lds_byte(int r, int c) { const int st = (r >> 4) * 2 + (c >> 5), rr = r & 15, cc = c & 31, ob = rr * 64 + cc * 2; return st * 1024 + (ob ^ (((ob >> 9) & 1) << 5)); }
__host__ __device__ __forceinline__ void stage_rc(int b, int& R, int& C) { const int st = b / 1024, sb = b % 1024, swz = sb ^ (((sb >> 9) & 1) << 5); R = (st >> 1) * 16 + swz / 64; C = (st & 1) * 32 + (swz % 64) / 2; }

struct Unit { int pm, pn, e, lt; };
struct Gemm { const bf16_t* A; const bf16_t* Bt; int M, N, K; };

struct StaticOrder {
    int nM, nN, nwg, G, c;
    __host__ __device__ void init(int M, int N, int G_, int c_) { nM = M / BM; nN = N / BM; nwg = nM * nN; G = G_; c = c_; }
    __host__ __device__ bool next(int i, Unit& u) const {
        const long L = (long)i * G + c; if (L >= nwg) return false;
        int wgid = (int)L; { const int q = nwg / NXCD, r = nwg % NXCD, xcd = wgid % NXCD, off = wgid / NXCD; wgid = (xcd < r ? xcd * (q + 1) : r * (q + 1) + (xcd - r) * q) + off; }
        const int nig = WGM * nN, gid = wgid / nig, fm = gid * WGM, gsz = (nM - fm) < WGM ? (nM - fm) : WGM;
        u.pm = fm + ((wgid % nig) % gsz); u.pn = (wgid % nig) / gsz; u.e = 0; u.lt = 0; return true;
    }
    __device__ __forceinline__ int arow(const Unit& u, int R) const { return u.pm * BM + R; }
};

__device__ __forceinline__ unsigned cvt_pk_bf16(float lo, float hi) { unsigned r; asm volatile("v_cvt_pk_bf16_f32 %0, %1, %2" : "=v"(r) : "v"(lo), "v"(hi)); return r; }

template <class Epi, class Sched, bool ALIGN_EPI, bool GATHER = false, bool FP8 = false, bool MID = false>
__device__ __forceinline__ void gemm_phase(PG8_LAS unsigned char* lds, const Gemm g, const Sched& S, const Epi& E, const int wave) {
    const int lane = hw_lane(), wid = wave, tid = wid * 64 + lane,
              wr = wid >> 2, wc = wid & 3, fr = lane & 15, fq = lane >> 4;
    const int K = g.K, RB = FP8 ? K : 2 * K  , nt = RB / (BK * 2);
    unsigned voffB[2];
#pragma unroll
    for (int i = 0; i < 2; ++i) { int R_, C_; stage_rc(tid * 16 + i * 8192, R_, C_); voffB[i] = (unsigned)(R_ * RB + C_ * 2); }
    const size_t kstep = (size_t)(BK * 2);
    const size_t hstep = (size_t)HALF * RB;
    const size_t tstep = 2 * hstep;
    const unsigned ldsw = (unsigned)wid * 1024u;
    const int aoff = lds_byte(wr * 64 + fr, fq * 8), boff = lds_byte(wc * 32 + fr, fq * 8);
#define PG8_SA(b, h) (((b) * 2 + (h)) * HTB)
#define PG8_SB(b, h) ((4 + (b) * 2 + (h)) * HTB)
#define PG8_STAGE(bufoff, gbase, voff) do { _Pragma("unroll") for (int _i = 0; _i < 2; ++_i) \
        __builtin_amdgcn_global_load_lds((const unsigned*)((const char*)(gbase) + (voff)[_i]), (PG8_LAS unsigned*)(lds + (bufoff) + ldsw + _i * 8192), 16, 0, 0); } while (0)
#define PG8_LDA(dst, b, h) do { _Pragma("unroll") for (int m = 0; m < 4; ++m) { if constexpr (FP8) { \
            const i32x4 l0_ = *(const PG8_LAS i32x4*)(lds + PG8_SA(b, h) + aoff + m * 2048), l1_ = *(const PG8_LAS i32x4*)(lds + PG8_SA(b, h) + aoff + m * 2048 + 1024); \
            dst##8[m] = __builtin_shufflevector(l0_, l1_, 0, 1, 2, 3, 4, 5, 6, 7); } \
        else { _Pragma("unroll") for (int k = 0; k < 2; ++k) dst[m][k] = *(const PG8_LAS bf16x8*)(lds + PG8_SA(b, h) + aoff + m * 2048 + k * 1024); } } } while (0)
#define PG8_LDB(dst, b, h) do { _Pragma("unroll") for (int n = 0; n < 2; ++n) { if constexpr (FP8) { \
            const i32x4 l0_ = *(const PG8_LAS i32x4*)(lds + PG8_SB(b, h) + boff + n * 2048), l1_ = *(const PG8_LAS i32x4*)(lds + PG8_SB(b, h) + boff + n * 2048 + 1024); \
            dst##8[n] = __builtin_shufflevector(l0_, l1_, 0, 1, 2, 3, 4, 5, 6, 7); } \
        else { _Pragma("unroll") for (int k = 0; k < 2; ++k) dst[n][k] = *(const PG8_LAS bf16x8*)(lds + PG8_SB(b, h) + boff + n * 2048 + k * 1024); } } } while (0)
#define PG8_MMA(ai, bj, At, Bt) do { __builtin_amdgcn_s_setprio(1); _Pragma("unroll") for (int m = 0; m < 4; ++m) _Pragma("unroll") for (int n = 0; n < 2; ++n) { \
        if constexpr (FP8) { asm volatile("v_mfma_f32_16x16x128_f8f6f4 %0, %1, %2, %0" : "+v"(acc[ai][bj][m][n]) : "v"(Bt##8[n]), "v"(At##8[m])); }   \
        else { _Pragma("unroll") for (int k = 0; k < 2; ++k) acc[ai][bj][m][n] = __builtin_amdgcn_mfma_f32_16x16x32_bf16(Bt[n][k], At[m][k], acc[ai][bj][m][n], 0, 0, 0); } } \
        __builtin_amdgcn_s_setprio(0); } while (0)
#define PG8_WAIT_V(n) asm volatile("s_waitcnt vmcnt(" #n ")" ::: "memory")
#define PG8_WAIT_V8R(rx) do { if (rx) PG8_WAIT_V(24); else PG8_WAIT_V(8); } while (0)
#define PG8_WAIT_L(n) asm volatile("s_waitcnt lgkmcnt(" #n ")" ::: "memory")
#define PG8_BAR __builtin_amdgcn_s_barrier()
#define PG8_SCHED __builtin_amdgcn_sched_barrier(0)
#define PG8_AOFF(dst, u) do { if constexpr (GATHER) { _Pragma("unroll") for (int _h = 0; _h < 2; ++_h) _Pragma("unroll") for (int _i = 0; _i < 2; ++_i) { int R_, C_; stage_rc(tid * 16 + _i * 8192, R_, C_); \
        dst[_h][_i] = (unsigned)S.arow(u, _h * HALF + R_) * (unsigned)RB + (unsigned)(C_ * 2); } } } while (0)
#define PG8_STAGE_A(bufoff, base, h, NXT) do { if constexpr (GATHER) { if (NXT) PG8_STAGE(bufoff, base, o2[h]); else PG8_STAGE(bufoff, base, voA[h]); } else { PG8_STAGE(bufoff, (base) + (h) * hstep, voffB); } } while (0)
    Unit cur, nxt; int ui = 0; bool relax = false;
    if (!S.next(0, cur)) return;
    f32x4 acc[2][2][4][2];
#pragma unroll
    for (int a = 0; a < 2; ++a)
#pragma unroll
        for (int b = 0; b < 2; ++b)
#pragma unroll
            for (int m = 0; m < 4; ++m)
#pragma unroll
                for (int n = 0; n < 2; ++n) acc[a][b][m][n] = (f32x4){0.f, 0.f, 0.f, 0.f};
    bf16x8 At[4][2], B0[2][2], B1[2][2];
    i32x8 At8[4], B08[2], B18[2];
    unsigned voA[2][2], voN[2][2], o2[2][2];
    PG8_AOFF(voA, cur);
    const char* cA = GATHER ? (const char*)g.A : (const char*)g.A + (size_t)cur.pm * tstep;
    const char* cB = (const char*)g.Bt + (size_t)cur.pn * tstep;
    PG8_STAGE(PG8_SB(0, 0), cB, voffB); PG8_STAGE(PG8_SB(0, 1), cB + hstep, voffB); PG8_STAGE_A(PG8_SA(0, 0), cA, 0, 0); PG8_STAGE_A(PG8_SA(0, 1), cA, 1, 0);
    if (wr == 1) PG8_BAR;
    PG8_WAIT_V(2); PG8_BAR;
    PG8_STAGE(PG8_SB(1, 0), cB + kstep, voffB); PG8_STAGE_A(PG8_SA(1, 0), cA + kstep, 0, 0); PG8_STAGE(PG8_SB(1, 1), cB + hstep + kstep, voffB);
    PG8_WAIT_V(6); PG8_BAR;
    for (;;) {
        const bool has_next = S.next(ui + 1, nxt);
        if constexpr (GATHER) {
            if (has_next) { PG8_AOFF(voN, nxt); }
            else {
#pragma unroll
                for (int _h = 0; _h < 2; ++_h) { voN[_h][0] = voA[_h][0]; voN[_h][1] = voA[_h][1]; } } }
        const char* nA = (GATHER || !has_next) ? cA : (const char*)g.A + (size_t)nxt.pm * tstep;
        const char* nB = has_next ? (const char*)g.Bt + (size_t)nxt.pn * tstep : cB;
#pragma nounroll
        for (int t = 0; t < nt; t += 2) {
            const bool last = (t == nt - 2);
            const char* a1 = cA + (size_t)(t + 1) * kstep;
            const char* a2 = last ? nA : cA + (size_t)(t + 2) * kstep; const char* b2 = last ? nB : cB + (size_t)(t + 2) * kstep;
            const char* a3 = a2 + kstep; const char* b3 = b2 + kstep;
            if constexpr (GATHER) {
#pragma unroll
                for (int _h = 0; _h < 2; ++_h) { o2[_h][0] = last ? voN[_h][0] : voA[_h][0]; o2[_h][1] = last ? voN[_h][1] : voA[_h][1]; } }
            if constexpr (MID) { if (t == Epi::MID_T) { E.mid(acc, cur, wr, wc, fr, fq); PG8_SCHED; } }
            const bool rx = relax && t == 0;
            PG8_LDB(B0, 0, 0); PG8_LDB(B1, 0, 1); PG8_SCHED; PG8_LDA(At, 0, 0); PG8_STAGE_A(PG8_SA(1, 1), a1, 1, 0);
            PG8_WAIT_V8R(rx); PG8_WAIT_L(0); PG8_BAR; PG8_MMA(0, 0, At, B0); PG8_MMA(0, 1, At, B1); PG8_BAR; PG8_SCHED;
            PG8_LDA(At, 0, 1); PG8_STAGE(PG8_SB(0, 0), b2, voffB); PG8_STAGE(PG8_SB(0, 1), b2 + hstep, voffB); PG8_STAGE_A(PG8_SA(0, 0), a2, 0, 1);
            PG8_WAIT_V8R(rx); PG8_WAIT_L(0); PG8_BAR; PG8_MMA(1, 0, At, B0); PG8_MMA(1, 1, At, B1); PG8_BAR; PG8_SCHED;
            PG8_LDB(B0, 1, 0); PG8_LDB(B1, 1, 1); PG8_SCHED; PG8_LDA(At, 1, 0); PG8_STAGE_A(PG8_SA(0, 1), a2, 1, 1);
            PG8_WAIT_V(8); PG8_WAIT_L(0); PG8_BAR; PG8_MMA(0, 0, At, B0); PG8_MMA(0, 1, At, B1); PG8_BAR; PG8_SCHED;
            PG8_LDA(At, 1, 1); PG8_STAGE(PG8_SB(1, 0), b3, voffB); PG8_STAGE(PG8_SB(1, 1), b3 + hstep, voffB); PG8_STAGE_A(PG8_SA(1, 0), a3, 0, 1);
            PG8_WAIT_V(8); PG8_WAIT_L(0); PG8_BAR; PG8_MMA(1, 0, At, B0); PG8_MMA(1, 1, At, B1); PG8_BAR; PG8_SCHED;
        }
        if constexpr (ALIGN_EPI) { if (wr == 0) PG8_BAR; }
        E(acc, cur, wr, wc, fr, fq); relax = Epi::leaves16(cur);
#ifdef PROBE_EPI2
        if constexpr (Epi::PROBE_TWICE) E(acc, cur, wr, wc, fr, fq);
#endif
        if (!has_next) break;
#pragma unroll
        for (int a = 0; a < 2; ++a)
#pragma unroll
            for (int b = 0; b < 2; ++b)
#pragma unroll
                for (int m = 0; m < 4; ++m)
#pragma unroll
                    for (int n = 0; n < 2; ++n) acc[a][b][m][n] = (f32x4){0.f, 0.f, 0.f, 0.f};
        cur = nxt; cA = nA; cB = nB; ++ui;
        if constexpr (GATHER) {
#pragma unroll
            for (int _h = 0; _h < 2; ++_h) { voA[_h][0] = voN[_h][0]; voA[_h][1] = voN[_h][1]; } }
        if constexpr (ALIGN_EPI) { if (wr == 1) PG8_BAR; }
    }
    PG8_WAIT_V(0);
    if constexpr (!ALIGN_EPI) { if (wr == 0) PG8_BAR; }
    PG8_BAR;
#undef PG8_SA
#undef PG8_SB
#undef PG8_STAGE
#undef PG8_LDA
#undef PG8_LDB
#undef PG8_MMA
#undef PG8_WAIT_V
#undef PG8_WAIT_V8R
#undef PG8_WAIT_L
#undef PG8_BAR
#undef PG8_SCHED
#undef PG8_AOFF
#undef PG8_STAGE_A
}
}
constexpr int T_TOK = 32768, SEQ = 2048, DM = 1024, NB = 16, DEPTH = 4;
constexpr int N_IN = 5120, CAP = 32768;
constexpr float C2F = 0.125f * 1.4426950408889634f;
constexpr float DN_ALPHA = 1.681792830507429f;
constexpr float LN_EPS = 1e-5f, RMS_EPS = 1e-6f;
constexpr float IN_DESCALE = 1.0f / (16.0f * 256.0f);
constexpr float GU_WSCALE = 256.0f, GU_DESCALE = 1.0f / (16.0f * 256.0f), ACT_SCALE = 16.0f, DN_WSCALE = 1024.0f, DN_DESCALE = 1.0f / (16.0f * 1024.0f);
constexpr float PAB_ASCALE = 32.0f, PAB_WSCALE = 256.0f, PAB_DESCALE = 1.0f / (32.0f * 256.0f);
constexpr float GMIX_SCALE = 512.0f, GMIX_DESCALE = 1.0f / 512.0f;
constexpr float Y2_SCALE = 128.0f, Y2_DESCALE = 1.0f / 128.0f;
constexpr float GATE_SCALE = 128.0f, GATE_DESCALE = 1.0f / 128.0f;
constexpr float MERGED_SCALE = 64.0f, WO_SCALE = 2048.0f, WO_DESCALE = 1.0f / (64.0f * 2048.0f);

#ifndef PROBE_SCALE_A
#define PROBE_SCALE_A 1.0f
#endif
#ifndef PROBE_SCALE_B
#define PROBE_SCALE_B 1.0f
#endif
namespace pg8 {
__device__ __forceinline__ float bf2f(unsigned short b) { return __uint_as_float((unsigned)b << 16); }
__device__ __forceinline__ float bflo(unsigned w) { return __uint_as_float(w << 16); }
__device__ __forceinline__ float bfhi(unsigned w) { return __uint_as_float(w & 0xffff0000u); }
__device__ __forceinline__ float sat8e(float x) { return __builtin_amdgcn_fmed3f(x, -448.0f, 448.0f); }
__device__ __forceinline__ unsigned pk4_fp8e(float a, float b, float c, float d) { unsigned w = 0; w = __builtin_amdgcn_cvt_pk_fp8_f32(sat8e(a), sat8e(b), w, false); w = __builtin_amdgcn_cvt_pk_fp8_f32(sat8e(c), sat8e(d), w, true); return w; }
__device__ __forceinline__ float sigmoidf_(float x) { return __builtin_amdgcn_rcpf(1.f + __expf(-x)); }
__device__ __forceinline__ void sigmoid16(float (&v)[16]) {
#pragma unroll
    for (int q = 0; q < 4; ++q) {
        const float a = 1.f + __expf(-v[4 * q]), b = 1.f + __expf(-v[4 * q + 1]), c = 1.f + __expf(-v[4 * q + 2]), d = 1.f + __expf(-v[4 * q + 3]);
        const float ab = a * b, cd = c * d;
        if (ab * cd < 1e30f) { const float r = __builtin_amdgcn_rcpf(ab * cd) * GATE_SCALE, rcd = r * cd, rab = r * ab;
            v[4 * q] = rcd * b; v[4 * q + 1] = rcd * a; v[4 * q + 2] = rab * d; v[4 * q + 3] = rab * c; }
        else { v[4 * q] = GATE_SCALE * __builtin_amdgcn_rcpf(a); v[4 * q + 1] = GATE_SCALE * __builtin_amdgcn_rcpf(b); v[4 * q + 2] = GATE_SCALE * __builtin_amdgcn_rcpf(c); v[4 * q + 3] = GATE_SCALE * __builtin_amdgcn_rcpf(d); }
    }
}
__device__ __forceinline__ void store16(bf16_t* dst, const float (&v)[16]) {
    u32x4 w0, w1;
    w0.x = cvt_pk_bf16(v[0], v[1]); w0.y = cvt_pk_bf16(v[2], v[3]); w0.z = cvt_pk_bf16(v[4], v[5]); w0.w = cvt_pk_bf16(v[6], v[7]);
    w1.x = cvt_pk_bf16(v[8], v[9]); w1.y = cvt_pk_bf16(v[10], v[11]); w1.z = cvt_pk_bf16(v[12], v[13]); w1.w = cvt_pk_bf16(v[14], v[15]);
#ifdef NT_STORES
    __builtin_nontemporal_store(w0, (u32x4*)dst); __builtin_nontemporal_store(w1, (u32x4*)(dst + 32));
#else
    *(u32x4*)dst = w0; *(u32x4*)(dst + 32) = w1;
#endif
}
__device__ __forceinline__ void load16bf(const bf16_t* src, float (&v)[16]) {
    const u32x4 w0 = *(const u32x4*)src, w1 = *(const u32x4*)(src + 32);
    v[0] = bflo(w0.x); v[1] = bfhi(w0.x); v[2] = bflo(w0.y); v[3] = bfhi(w0.y); v[4] = bflo(w0.z); v[5] = bfhi(w0.z); v[6] = bflo(w0.w); v[7] = bfhi(w0.w);
    v[8] = bflo(w1.x); v[9] = bfhi(w1.x); v[10] = bflo(w1.y); v[11] = bfhi(w1.y); v[12] = bflo(w1.z); v[13] = bfhi(w1.z); v[14] = bflo(w1.w); v[15] = bfhi(w1.w);
}
__device__ __forceinline__ void load16f8(const unsigned char* src, float (&v)[16]) {
    const u32x2 w0 = *(const u32x2*)src, w1 = *(const u32x2*)(src + 32);
    typedef float f32x2v __attribute__((ext_vector_type(2)));
#pragma unroll
    for (int h = 0; h < 2; ++h) { const u32x2 w = h ? w1 : w0;
        const f32x2v a = __builtin_amdgcn_cvt_pk_f32_fp8(w.x, false), b = __builtin_amdgcn_cvt_pk_f32_fp8(w.x, true), c = __builtin_amdgcn_cvt_pk_f32_fp8(w.y, false), d = __builtin_amdgcn_cvt_pk_f32_fp8(w.y, true);
        v[8 * h] = a[0] * GATE_DESCALE; v[8 * h + 1] = a[1] * GATE_DESCALE; v[8 * h + 2] = b[0] * GATE_DESCALE; v[8 * h + 3] = b[1] * GATE_DESCALE;
        v[8 * h + 4] = c[0] * GATE_DESCALE; v[8 * h + 5] = c[1] * GATE_DESCALE; v[8 * h + 6] = d[0] * GATE_DESCALE; v[8 * h + 7] = d[1] * GATE_DESCALE; }
}
__device__ __forceinline__ void store16f8c(unsigned char* dst, const float (&v)[16]) {
    u32x4 w; w.x = pk4_fp8e(v[0], v[1], v[2], v[3]); w.y = pk4_fp8e(v[4], v[5], v[6], v[7]); w.z = pk4_fp8e(v[8], v[9], v[10], v[11]); w.w = pk4_fp8e(v[12], v[13], v[14], v[15]);
    *(u32x4*)dst = w;
}
__device__ __forceinline__ void load16f8c(const unsigned char* src, float (&v)[16]) {
    const u32x4 w = *(const u32x4*)src;
    typedef float f32x2v __attribute__((ext_vector_type(2)));
#pragma unroll
    for (int h = 0; h < 4; ++h) { const unsigned x = w[h];
        const f32x2v a = __builtin_amdgcn_cvt_pk_f32_fp8(x, false), b = __builtin_amdgcn_cvt_pk_f32_fp8(x, true);
        v[4 * h] = a[0] * GATE_DESCALE; v[4 * h + 1] = a[1] * GATE_DESCALE; v[4 * h + 2] = b[0] * GATE_DESCALE; v[4 * h + 3] = b[1] * GATE_DESCALE; }
}
__device__ __forceinline__ void dec16f8c(const u32x4 w, float (&v)[16]) {
    typedef float f32x2v __attribute__((ext_vector_type(2)));
#pragma unroll
    for (int h = 0; h < 4; ++h) { const unsigned x = w[h];
        const f32x2v a = __builtin_amdgcn_cvt_pk_f32_fp8(x, false), b = __builtin_amdgcn_cvt_pk_f32_fp8(x, true);
        v[4 * h] = a[0] * GATE_DESCALE; v[4 * h + 1] = a[1] * GATE_DESCALE; v[4 * h + 2] = b[0] * GATE_DESCALE; v[4 * h + 3] = b[1] * GATE_DESCALE; }
}
#define PG8_PIN8(a) asm volatile("" :: "v"(a[0]), "v"(a[1]), "v"(a[2]), "v"(a[3]), "v"(a[4]), "v"(a[5]), "v"(a[6]), "v"(a[7]))
#define PG8_GATHER16(v, acc, ai, m) do { _Pragma("unroll") for (int _bj = 0; _bj < 2; ++_bj) _Pragma("unroll") for (int _n = 0; _n < 2; ++_n) _Pragma("unroll") for (int _j = 0; _j < 4; ++_j) \
        v[8 * _bj + 4 * _n + _j] = acc[ai][_bj][m][_n][_j]; } while (0)

__device__ __forceinline__ int pg_perm(int g, int s) { return g == 0 ? s : (g == 1 ? ((s & 3) * 512 + (s >> 2)) : ((s & 15) * 128 + (s >> 4))); }

struct EpiIn {
    static constexpr bool PROBE_TWICE = true;
    static __device__ __forceinline__ bool leaves16(const Unit& u) { return u.pn < 12; }
    bf16_t *QA, *KA, *VA, *QD, *KD, *VDT, *G;
    const float* qg; const float* kg;
    const float* rope;
    __device__ __forceinline__ void rms_rope(float (&v)[16], const float* gain, int s, int fq, float scale) const {
        float ss = 0.f;
#pragma unroll
        for (int e = 0; e < 16; ++e) ss += v[e] * v[e];
        ss += __shfl_xor(ss, 16); ss += __shfl_xor(ss, 32);
        const float rinv = 1.0f / sqrtf(ss * (1.0f / 64.0f) + RMS_EPS);
#pragma unroll
        for (int hb = 0; hb < 2; ++hb) {
            const int a = hb == 0 ? (s >> 6) : (s & 63);
            const f32x4* rp = (const f32x4*)(rope + (size_t)(a * 16 + 4 * fq) * 2);
            const f32x4* gp = (const f32x4*)(gain + 32 * hb + 8 * fq);
#pragma unroll
            for (int q = 0; q < 2; ++q) {
                const f32x4 cs = rp[q], gg = gp[q];
                const int e0 = 8 * hb + 4 * q;
                const float x0 = v[e0] * rinv * gg[0], x1 = v[e0 + 1] * rinv * gg[1], x2 = v[e0 + 2] * rinv * gg[2], x3 = v[e0 + 3] * rinv * gg[3];
                v[e0] = (x0 * cs[0] - x1 * cs[1]) * scale; v[e0 + 1] = (x0 * cs[1] + x1 * cs[0]) * scale;
                v[e0 + 2] = (x2 * cs[2] - x3 * cs[3]) * scale; v[e0 + 3] = (x2 * cs[3] + x3 * cs[2]) * scale;
            }
        }
    }
    __device__ __forceinline__ void operator()(const f32x4 (&acc)[2][2][4][2], const Unit& u, int wr, int wc, int fr, int fq) const {
        const int pn = u.pn;
        const int b = (u.pm * BM) >> 11;
#pragma unroll
        for (int ai = 0; ai < 2; ++ai)
#pragma unroll
            for (int m = 0; m < 4; ++m) {
                const int row = u.pm * BM + ai * HALF + wr * 64 + m * 16 + fr, s = row & (SEQ - 1);
                float v[16]; PG8_GATHER16(v, acc, ai, m);
#pragma unroll
                for (int e = 0; e < 16; ++e) v[e] *= IN_DESCALE;
                if (pn < 2) {
                    rms_rope(v, qg, s, fq, C2F);
                    store16(QA + (size_t)row * 512 + (pn * 4 + wc) * 64 + 8 * fq, v);
                } else if (pn == 2) {
                    if (wc < 2) { rms_rope(v, kg, s, fq, 1.0f); store16(KA + (size_t)row * 128 + wc * 64 + 8 * fq, v); }
                    else store16(VA + (size_t)row * 128 + (wc - 2) * 64 + 8 * fq, v);
                } else if (pn < 12) {
                    const int kind = (pn - 3) / 3, g = (pn - 3) - 3 * kind, gh = g * 4 + wc;
                    if (kind == 0) {
#pragma unroll
                        for (int e = 0; e < 16; ++e) v[e] *= C2F; }
                    store16((kind == 0 ? QD : kind == 1 ? KD : VDT) + ((size_t)(b * 12 + gh) * SEQ + pg_perm(g, s)) * 64 + 8 * fq, v);
                } else {
#pragma unroll
                    for (int e = 0; e < 16; ++e) v[e] = sigmoidf_(v[e]) * GATE_SCALE;
                    store16f8c((unsigned char*)G + (size_t)row * 2048 + (pn - 12) * 256 + wc * 64 + 16 * fq, v);
                }
                if (m & 1) asm volatile("" ::: "memory");
            }
    }
};
struct EpiMergeF {
    static constexpr bool PROBE_TWICE = false;
    static constexpr int MID_T = 4;
    static constexpr float GB_MIN = 7.62939453125e-06f;
    static __device__ __forceinline__ bool leaves16(const Unit&) { return false; }
    const bf16_t* G; bf16_t* merged;
    __device__ __forceinline__ void mid(f32x4 (&acc)[2][2][4][2], const Unit& u, int wr, int wc, int fr, int fq) const {
        const int col0 = u.pn * BM + wc * 64 + 16 * fq;
#pragma unroll
        for (int ai = 0; ai < 2; ++ai) {
            u32x4 raw[8];
#pragma unroll
            for (int m = 0; m < 4; ++m) { const unsigned char* gp = (const unsigned char*)G + (size_t)(u.pm * BM + ai * HALF + wr * 64 + m * 16 + fr) * 2048 + col0;
                raw[2 * m] = *(const u32x4*)gp; raw[2 * m + 1] = *(const u32x4*)(gp + 1024); }
            PG8_PIN8(raw);
#pragma unroll
            for (int m = 0; m < 4; ++m) {
                float ga[16], gb[16]; dec16f8c(raw[2 * m], ga); dec16f8c(raw[2 * m + 1], gb);
#pragma unroll
                for (int e = 0; e < 16; ++e) ga[e] *= __builtin_amdgcn_rcpf(fmaxf(gb[e], GB_MIN));
#pragma unroll
                for (int bj = 0; bj < 2; ++bj)
#pragma unroll
                    for (int n = 0; n < 2; ++n)
#pragma unroll
                        for (int j = 0; j < 4; ++j) acc[ai][bj][m][n][j] *= ga[8 * bj + 4 * n + j];
            }
        }
    }
    __device__ __forceinline__ void operator()(const f32x4 (&acc)[2][2][4][2], const Unit& u, int wr, int wc, int fr, int fq) const {
        const int col0 = u.pn * BM + wc * 64 + 16 * fq;
        u32x4 raw[8];
#pragma unroll
        for (int ai = 0; ai < 2; ++ai)
#pragma unroll
            for (int m = 0; m < 4; ++m) raw[ai * 4 + m] = *(const u32x4*)((const unsigned char*)G + (size_t)(u.pm * BM + ai * HALF + wr * 64 + m * 16 + fr) * 2048 + 1024 + col0);
        PG8_PIN8(raw);
#pragma unroll
        for (int ai = 0; ai < 2; ++ai)
#pragma unroll
            for (int m = 0; m < 4; ++m) {
                const int row = u.pm * BM + ai * HALF + wr * 64 + m * 16 + fr;
                float v[16], gb[16]; PG8_GATHER16(v, acc, ai, m);
                dec16f8c(raw[ai * 4 + m], gb);
#pragma unroll
                for (int e = 0; e < 16; ++e) v[e] *= fmaxf(gb[e], GB_MIN) * (PAB_DESCALE * MERGED_SCALE);
                store16f8c((unsigned char*)merged + (size_t)row * DM + col0, v);
                if (m & 1) asm volatile("" ::: "memory");
            }
    }
};
struct EpiRes {
    static constexpr bool PROBE_TWICE = false;
    static __device__ __forceinline__ bool leaves16(const Unit&) { return false; }
    bf16_t* gmix; const float* gmod;
    __device__ __forceinline__ void operator()(const f32x4 (&acc)[2][2][4][2], const Unit& u, int wr, int wc, int fr, int fq) const {
        const int col0 = u.pn * BM + wc * 64 + 16 * fq;
        const int b = (u.pm * BM) >> 11;
        float gv[16];
#pragma unroll
        for (int q = 0; q < 4; ++q) { const f32x4 t = *(const f32x4*)(gmod + (size_t)b * 6144 + col0 + 4 * q); gv[4 * q] = t[0] * WO_DESCALE; gv[4 * q + 1] = t[1] * WO_DESCALE; gv[4 * q + 2] = t[2] * WO_DESCALE; gv[4 * q + 3] = t[3] * WO_DESCALE; }
#pragma unroll
        for (int ai = 0; ai < 2; ++ai)
#pragma unroll
            for (int m = 0; m < 4; ++m) {
                const size_t off = (size_t)(u.pm * BM + ai * HALF + wr * 64 + m * 16 + fr) * DM + col0;
                float v[16]; PG8_GATHER16(v, acc, ai, m);
#pragma unroll
                for (int e = 0; e < 16; ++e) v[e] *= gv[e] * GMIX_SCALE;
                store16f8c((unsigned char*)gmix + off, v);
                if (m & 1) asm volatile("" ::: "memory");
            }
    }
};
struct EpiGU {
    static constexpr bool PROBE_TWICE = false;
    static __device__ __forceinline__ bool leaves16(const Unit&) { return false; }
    bf16_t* act; const float* gatew; const PG8_LAS int* tab;
    __device__ __forceinline__ void operator()(const f32x4 (&acc)[2][2][4][2], const Unit& u, int wr, int wc, int fr, int fq) const {
        const int e = u.e, cnt = tab[e], f0 = (u.pn & 1) * 128 + wc * 32 + fq * 8;
        float gwa[8];
#pragma unroll
        for (int ai = 0; ai < 2; ++ai)
#pragma unroll
            for (int m = 0; m < 4; ++m) { const int li = u.lt * BM + ai * HALF + wr * 64 + m * 16 + fr; gwa[ai * 4 + m] = gatew[(size_t)e * CAP + (li < CAP ? li : CAP - 1)]; }
        PG8_PIN8(gwa);
#pragma unroll
        for (int ai = 0; ai < 2; ++ai)
#pragma unroll
            for (int m = 0; m < 4; ++m) {
                const int rit = ai * HALF + wr * 64 + m * 16 + fr, li = u.lt * BM + rit;
                const float gw = li < cnt ? gwa[ai * 4 + m] : 0.f;
                float a[8];
#pragma unroll
                for (int bj = 0; bj < 2; ++bj)
#pragma unroll
                    for (int j = 0; j < 4; ++j) { const float gt = acc[ai][bj][m][0][j] * GU_DESCALE, up = acc[ai][bj][m][1][j] * GU_DESCALE; a[4 * bj + j] = gt * sigmoidf_(gt) * up * gw * ACT_SCALE; }
                u32x2 w; w.x = pk4_fp8e(a[0], a[1], a[2], a[3]); w.y = pk4_fp8e(a[4], a[5], a[6], a[7]);
                *(u32x2*)((unsigned char*)act + (size_t)(u.pm * BM + rit) * 256 + f0) = w;
                if (m & 1) asm volatile("" ::: "memory");
            }
    }
};
struct EpiDown {
    static constexpr bool PROBE_TWICE = false;
    static __device__ __forceinline__ bool leaves16(const Unit&) { return false; }
    bf16_t* y2; const int* rowlist; const PG8_LAS int* tab;
    __device__ __forceinline__ void operator()(const f32x4 (&acc)[2][2][4][2], const Unit& u, int wr, int wc, int fr, int fq) const {
        const int e = u.e, cnt = tab[e], col0 = (u.pn & 3) * BM + wc * 64 + 16 * fq;
        int ents[8];
#pragma unroll
        for (int ai = 0; ai < 2; ++ai)
#pragma unroll
            for (int m = 0; m < 4; ++m) { const int li = u.lt * BM + ai * HALF + wr * 64 + m * 16 + fr; ents[ai * 4 + m] = rowlist[(size_t)e * CAP + (li < CAP ? li : CAP - 1)]; }
        PG8_PIN8(ents);
#pragma unroll
        for (int ai = 0; ai < 2; ++ai)
#pragma unroll
            for (int m = 0; m < 4; ++m) {
                const int li = u.lt * BM + ai * HALF + wr * 64 + m * 16 + fr;
                const int ent = ents[ai * 4 + m];
                float v[16]; PG8_GATHER16(v, acc, ai, m);
#pragma unroll
                for (int e2 = 0; e2 < 16; ++e2) v[e2] *= DN_DESCALE * Y2_SCALE;
                store16f8c((unsigned char*)y2 + (li < cnt ? ((size_t)(ent & 1) * T_TOK + (ent >> 1)) * DM : (size_t)2 * T_TOK * DM) + col0, v);
                if (m & 1) asm volatile("" ::: "memory");
            }
    }
};
template <bool GATHER> struct MoeOrder {
    const PG8_LAS int* tab; const int* rowlist; int nct, G, c;
    __device__ __forceinline__ bool next(int i, Unit& u) const {
        const int nwg = tab[32] * nct; const long L = (long)i * G + c; if (L >= nwg) return false;
        int w = (int)L; { const int q = nwg / NXCD, r = nwg % NXCD, xcd = w % NXCD, off = w / NXCD; w = (xcd < r ? xcd * (q + 1) : r * (q + 1) + (xcd - r) * q) + off; }
        const int rt = w / nct, ct = w - rt * nct; int e = 0;
        for (int k = 1; k < 16; ++k) e += (rt >= tab[16 + k]) ? 1 : 0;
        u.pm = rt; u.e = e; u.lt = rt - tab[16 + e]; u.pn = e * nct + ct; return true;
    }
    __device__ __forceinline__ int arow(const Unit& u, int R) const {
        if (GATHER) { const int li = u.lt * BM + R; const int ent = rowlist[(size_t)u.e * CAP + (li < CAP ? li : CAP - 1)]; return li < tab[u.e] ? (ent >> 1) : 0; }
        return u.pm * BM + R;
    }
};
}
namespace attn_body {
using bf16=__hip_bfloat16;
using bf16x8=__attribute__((ext_vector_type(8)))short;
using s16x4=__attribute__((ext_vector_type(4)))short;
using f32x16=__attribute__((ext_vector_type(16)))float;
using u32x4=__attribute__((ext_vector_type(4)))unsigned;
constexpr int BATCH=16,NHEAD=8,SEQ=2048,D=64;
constexpr int NW=8,QBLK=32,QB=QBLK*NW,KVBLK=64,NQB=SEQ/QB;
constexpr int ATTN_UNIT_ROWS=QB;
__device__ __forceinline__ int crow(int r,int hi){return (r&3)+8*(r>>2)+4*hi;}
#define SBAR() __builtin_amdgcn_sched_barrier(0)
__device__ __forceinline__ void cmask(f32x16&p0,f32x16&p1,int jb,int qrel,int hi){
  const float NEG=-INFINITY; int kb=64*jb+4*hi;
  #pragma unroll
  for(int r=0;r<16;++r){int kv=kb+(r&3)+8*(r>>2); if(kv>qrel)p0[r]=NEG; if(kv+32>qrel)p1[r]=NEG;}
}

constexpr int NSLOT=3, SLOTB=8192;
constexpr int LDS_K=0, LDS_V=NSLOT*SLOTB, LDS_WS=2*NSLOT*SLOTB, LDS_OST=LDS_WS+NW*64*4, LDS_BYTES=LDS_OST+NW*4096;
constexpr float C2=0.125f*1.4426950408889634f;
__device__ __forceinline__ void glds16(const void*gsrc,unsigned lds_dst){unsigned keep;
  asm volatile("s_mov_b32 %0, m0\n\ts_mov_b32 m0, %2\n\ts_nop 0\n\tglobal_load_lds_dwordx4 %1, off\n\ts_mov_b32 m0, %0":"=&s"(keep):"v"(gsrc),"s"(lds_dst):"memory");}
__device__ __forceinline__ float max3f(float a,float b,float c){float r;asm("v_max3_f32 %0, %1, %2, %3":"=v"(r):"v"(a),"v"(b),"v"(c));return r;}
__device__ __forceinline__ float max2f(float a,float b){float r;asm("v_max_f32_e32 %0, %1, %2":"=v"(r):"v"(a),"v"(b));return r;}
__device__ __forceinline__ float fadd_s(float a,float b){float r;asm("v_add_f32_e32 %0, %1, %2":"=v"(r):"v"(a),"v"(b));return r;}
__device__ __forceinline__ float fsub_s(float a,float b){float r;asm("v_sub_f32_e32 %0, %1, %2":"=v"(r):"v"(a),"v"(b));return r;}
typedef float f32x2_t __attribute__((ext_vector_type(2))); typedef __bf16 bf16x2_t __attribute__((ext_vector_type(2)));
__device__ __forceinline__ unsigned cvtpk_s(float lo,float hi){f32x2_t v={lo,hi};bf16x2_t b=__builtin_convertvector(v,bf16x2_t);return __builtin_bit_cast(unsigned,b);}
#define WAIT_BAR(N) asm volatile("s_waitcnt vmcnt(" #N ") lgkmcnt(0)\n\ts_barrier":::"memory")

__device__ __forceinline__ void qkt(f32x16&p0,f32x16&p1,const char*Kslot,const bf16x8*qr,const f32x16&negm,int r32,int hi){
  const char*kb=Kslot+hi*1024+r32*16;
  #pragma unroll
  for(int d0=0;d0<4;++d0){
    const bf16x8 b0=*reinterpret_cast<const bf16x8*>(kb+d0*2048);
    const bf16x8 b1=*reinterpret_cast<const bf16x8*>(kb+d0*2048+512);
    if(d0==0){p0=__builtin_amdgcn_mfma_f32_32x32x16_bf16(b0,qr[0],negm,0,0,0);p1=__builtin_amdgcn_mfma_f32_32x32x16_bf16(b1,qr[0],negm,0,0,0);}
    else{p0=__builtin_amdgcn_mfma_f32_32x32x16_bf16(b0,qr[d0],p0,0,0,0);p1=__builtin_amdgcn_mfma_f32_32x32x16_bf16(b1,qr[d0],p1,0,0,0);}}
}
typedef __attribute__((address_space(3))) const char* lds_cptr;
typedef short v4i16_t __attribute__((ext_vector_type(4)));
__device__ __forceinline__ void kload8(bf16x8*kf,lds_cptr kp){
  kf[0]=*(const __attribute__((address_space(3))) bf16x8*)(kp);      kf[1]=*(const __attribute__((address_space(3))) bf16x8*)(kp+512);
  kf[2]=*(const __attribute__((address_space(3))) bf16x8*)(kp+2048); kf[3]=*(const __attribute__((address_space(3))) bf16x8*)(kp+2560);
  kf[4]=*(const __attribute__((address_space(3))) bf16x8*)(kp+4096); kf[5]=*(const __attribute__((address_space(3))) bf16x8*)(kp+4608);
  kf[6]=*(const __attribute__((address_space(3))) bf16x8*)(kp+6144); kf[7]=*(const __attribute__((address_space(3))) bf16x8*)(kp+6656);
}
__device__ __forceinline__ void kload2(bf16x8*kf,lds_cptr kp,int j){ kf[2*j]=*(const __attribute__((address_space(3))) bf16x8*)(kp+j*2048); kf[2*j+1]=*(const __attribute__((address_space(3))) bf16x8*)(kp+j*2048+512); }
__device__ __forceinline__ s16x4 vtr(lds_cptr p){ return __builtin_bit_cast(s16x4,__builtin_amdgcn_ds_read_tr16_b64_v4i16((__attribute__((address_space(3))) v4i16_t*)p)); }
__device__ __forceinline__ float rowmax(const f32x16&p0,const f32x16&p1){
  float a=max3f(p0[0],p0[1],p1[0]),b=max3f(p0[2],p0[3],p1[1]);a=max3f(a,p1[2],p1[3]);
  #pragma unroll
  for(int r=4;r<16;r+=4){a=max3f(a,p0[r],p0[r+1]);b=max3f(b,p0[r+2],p0[r+3]);a=max3f(a,p1[r],p1[r+1]);b=max3f(b,p1[r+2],p1[r+3]);}
  const float m=max2f(a,b);
  auto rr=__builtin_amdgcn_permlane32_swap(__float_as_uint(m),__float_as_uint(m),false,false);
  return max2f(__uint_as_float(rr[0]),__uint_as_float(rr[1]));
}
__device__ __forceinline__ void pv(f32x16*o,int vb,bf16x8 pa0,bf16x8 pa1,bf16x8 pa2,bf16x8 pa3){
  #pragma unroll
  for(int d0=0;d0<2;++d0){s16x4 lo[4],hi[4];
    #pragma unroll
    for(int ks=0;ks<4;++ks){
      asm volatile("ds_read_b64_tr_b16 %0,%1 offset:%c2":"=&v"(lo[ks]):"v"(vb),"i"(d0*4096+ks*1024):"memory");
      asm volatile("ds_read_b64_tr_b16 %0,%1 offset:%c2":"=&v"(hi[ks]):"v"(vb),"i"(d0*4096+ks*1024+512):"memory");}
    asm volatile("s_waitcnt lgkmcnt(0)":::"memory");SBAR();
    #define PK(k) (bf16x8){lo[k][0],lo[k][1],lo[k][2],lo[k][3],hi[k][0],hi[k][1],hi[k][2],hi[k][3]}
    o[d0]=__builtin_amdgcn_mfma_f32_32x32x16_bf16(pa0,PK(0),o[d0],0,0,0);
    o[d0]=__builtin_amdgcn_mfma_f32_32x32x16_bf16(pa1,PK(1),o[d0],0,0,0);
    o[d0]=__builtin_amdgcn_mfma_f32_32x32x16_bf16(pa2,PK(2),o[d0],0,0,0);
    o[d0]=__builtin_amdgcn_mfma_f32_32x32x16_bf16(pa3,PK(3),o[d0],0,0,0);
    #undef PK
  }
}

#ifndef ATTN_STORE16
#define ATTN_STORE16(p,v) (*(u32x4*)(p)=(v))
#endif
struct UnitP { const bf16* Q; const bf16* K; const bf16* V; bf16* O; unsigned char* O8; float* lse; int NT; int qa0; int kk0; int ngmask; float sl2; int NTL, hs0, hs1; };
struct CfgA { static constexpr int QP=512,KP=128,VP=128,OP=768; static constexpr bool BAND=false,OFP8=true; };
struct CfgB { static constexpr int QP=64,KP=64,VP=64,OP=64; static constexpr bool BAND=true,OFP8=true; };
constexpr float OUT_SCALE=32.0f;
constexpr float NEGBAND=-30000.0f;
__device__ __forceinline__ void bandmask(f32x16&p0,f32x16&p1,int kt0,int qa,int hi,int ngmask,float sl2){
  const bool cls_ok=((kt0&ngmask)==(qa&ngmask));
  const float fb=(float)(kt0+4*hi-qa);
  #pragma unroll
  for(int r=0;r<16;++r){ const float f0=fb+(float)((r&3)+8*(r>>2)),f1=f0+32.0f; const float a0=__builtin_fabsf(f0),a1=__builtin_fabsf(f1);
    const float v0=__builtin_fmaf(-sl2,a0,p0[r]),v1=__builtin_fmaf(-sl2,a1,p1[r]);
    p0[r]=(cls_ok&&a0<=64.0f)?v0:NEGBAND; p1[r]=(cls_ok&&a1<=64.0f)?v1:NEGBAND; }
}
template<int THRL,class CFG> __device__ __forceinline__ void attn_unit(const int wave,const UnitP&U,char*shm,const bool pre,const bf16*nK,const bf16*nV,const int nNTL){
  constexpr int QP=CFG::QP,KP=CFG::KP,VP=CFG::VP,OP=CFG::OP;
  const int lane=hw_lane(),r32=lane&31,hi=lane>>5; const int wid=wave;
  const bf16*Qw=U.Q+(long)(wid*QBLK)*QP;
  const bf16*Kh=U.K,*Vh=U.V;
  const int qa=U.qa0+wid*QBLK+r32;
  const unsigned lds0=(unsigned)(uintptr_t)shm;
  constexpr bool AR=CFG::BAND;
  constexpr int NS=AR?6:NSLOT, LV=NS*SLOTB, LWS=2*NS*SLOTB, LOST=LWS+NW*64*4, OSTW=AR?2048:4096;
  const int hsh=AR?((wid>>2)?U.hs1:U.hs0):0, hoff=hsh*SLOTB, kk0w=U.kk0+64*hsh;
  float*wsf=(float*)(shm+LWS)+wid*64;
  const bf16*ksrc=Kh+(long)lane*KP+wid*8;
  const bf16*vsrc=Vh+(long)(16*(wid&3)+(lane>>2))*VP+(wid>>2)*32+(lane&3)*8;
  const unsigned kdst=lds0+LDS_K+wid*1024, vdst=lds0+LV+wid*1024;
  #define DMA_K(t,slot) glds16(ksrc+(long)(t)*KVBLK*KP,(unsigned)__builtin_amdgcn_readfirstlane(kdst+(slot)))
  #define DMA_V(t,slot) glds16(vsrc+(long)(t)*KVBLK*VP,(unsigned)__builtin_amdgcn_readfirstlane(vdst+(slot)))
  const int vb0=(int)(lds0+LV)+hoff+((lane>>4)&1)*32+(lane&3)*8+(4*hi+((lane&15)>>2))*64;
  const char*Kbase=shm+LDS_K+hoff; bf16x8 kf[8];
  const lds_cptr shm3=(lds_cptr)shm; const lds_cptr kp0=shm3+LDS_K+hoff+hi*1024+r32*16; const lds_cptr vp0=shm3+LV+hoff+((lane>>4)&1)*32+(lane&3)*8+(4*hi+((lane&15)>>2))*64;
  const int NT=U.NT;
  if constexpr(AR){ if(!pre){
    #pragma unroll
    for(int tt=0;tt<6;++tt) if(tt<U.NTL){DMA_K(tt,tt*SLOTB);DMA_V(tt,tt*SLOTB);} } }
  else if(!pre){DMA_K(0,0);DMA_V(0,0);DMA_K(1,SLOTB);}
  bf16x8 qr[4];
  #pragma unroll
  for(int d0=0;d0<4;++d0)qr[d0]=*reinterpret_cast<const bf16x8*>(&Qw[(long)r32*QP+d0*16+hi*8]);
  float mhat=0.f,l_reg=0.f;f32x16 o[2];o[0]=f32x16{};o[1]=f32x16{};f32x16 negm=f32x16{};asm volatile("":"+v"(negm));

  #define CMASK(P0,P1,t) do{ if constexpr(CFG::BAND) bandmask(P0,P1,kk0w+64*(t),qa,hi,U.ngmask,U.sl2); }while(0)
  bool resc=false;
  #define START(P0,P1) do{ const float rm=rowmax(P0,P1); resc=false; \
    { const float dl=rm; mhat=fadd_s(mhat,dl); \
      _Pragma("unroll") for(int r=0;r<16;++r){P0[r]=fsub_s(P0[r],dl);P1[r]=fsub_s(P1[r],dl);} \
      _Pragma("unroll") for(int r=0;r<16;++r)negm[r]=-mhat; asm volatile("":"+v"(negm)); } \
    _Pragma("unroll") for(int r=0;r<16;++r)P0[r]=__builtin_amdgcn_exp2f(P0[r]); }while(0)
  #define RESC() do{ if(resc){ asm volatile("s_waitcnt lgkmcnt(0)":::"memory"); \
      _Pragma("unroll") for(int d_=0;d_<2;++d_) _Pragma("unroll") for(int r=0;r<16;++r)o[d_][r]*=wsf[crow(r,hi)]; } }while(0)
  f32x16 pA0,pA1,pB0,pB1;
  int sl_prev=0,sl_cur=0,sl_next=SLOTB;
  #define ROT() do{sl_prev=sl_cur;sl_cur=sl_next;sl_next=(sl_next==(NS-1)*SLOTB)?0:sl_next+SLOTB;}while(0)
  if constexpr(!AR) DMA_K(2,2*SLOTB);
  if constexpr(AR) WAIT_BAR(0); else
  WAIT_BAR(3);
  qkt(pA0,pA1,Kbase,qr,negm,r32,hi);asm volatile("s_nop 15\n\ts_nop 7":"+v"(pA0),"+v"(pA1));CMASK(pA0,pA1,0);
  START(pA0,pA1);
  _Pragma("unroll") for(int r=0;r<16;++r)pA1[r]=__builtin_amdgcn_exp2f(pA1[r]);
  WAIT_BAR(0);
  if constexpr(!AR){DMA_K(3,0);DMA_V(1,SLOTB);}
  ROT();
  kload8(kf,kp0+sl_cur);
  WAIT_BAR(2);
  s16x4 vlo[8],vhi[8]; u32x4 pw0,pw1,pw2,pw3;
  #define PKW(P,B) cvtpk_s(P[B],P[B+1])
  #define PAF(k) __builtin_bit_cast(bf16x8,pw##k)
  #define VFR(i) (bf16x8){vlo[i][0],vlo[i][1],vlo[i][2],vlo[i][3],vhi[i][0],vhi[i][1],vhi[i][2],vhi[i][3]}
  #define PIN(x) asm volatile("":"+v"(x))
  #define MX3(a,b,c) __builtin_fmaxf(__builtin_fmaxf((a),(b)),(c))
  #define GAPA(MF,A0,A1,A2,A3,W0,W1,PW) do{ MF; sacc+=A0; sacc+=A1; sacc+=A2; sacc+=A3; PIN(sacc); W0; W1; PIN(PW); SBAR(); }while(0)
  #define EX(v) __builtin_amdgcn_exp2f(v)
  #define GAPB(MF,X,B) do{ MF; X[B]=EX(X[B]); X[B+1]=EX(X[B+1]); X[B+2]=EX(X[B+2]); X[B+3]=EX(X[B+3]); PIN(X); SBAR(); }while(0)
  #define VRD(i) do{ vlo[i]=vtr(vp_+(((i)>>2)*4096+((i)&3)*1024)); vhi[i]=vtr(vp_+(((i)>>2)*4096+((i)&3)*1024+512)); }while(0)
  #define KRD(G,j) do{ if(G){ kload2(kf,kp0+sl_next,j); SBAR(); } }while(0)
  #define STEP(C0,C1,P0,P1,t,GK,GV,GL) do{ SBAR(); \
    const lds_cptr vp_=vp0+sl_prev; \
    VRD(0); SBAR(); float sacc=(P0[0]+P0[1]); \
    GAPA(C0=__builtin_amdgcn_mfma_f32_32x32x16_bf16(kf[0],qr[0],negm,0,0,0), P0[2],P0[3],P0[4],P0[5],     pw0[0]=PKW(P0,0), pw0[1]=PKW(P0,2), pw0); \
    VRD(4); SBAR(); GAPA(C1=__builtin_amdgcn_mfma_f32_32x32x16_bf16(kf[1],qr[0],negm,0,0,0), P0[6],P0[7],P0[8],P0[9],     pw0[2]=PKW(P0,4), pw0[3]=PKW(P0,6), pw0); \
    VRD(1); SBAR(); GAPA(C0=__builtin_amdgcn_mfma_f32_32x32x16_bf16(kf[2],qr[1],C0,0,0,0),   P0[10],P0[11],P0[12],P0[13], pw1[0]=PKW(P0,8), pw1[1]=PKW(P0,10), pw1); \
    VRD(5); SBAR(); GAPA(C1=__builtin_amdgcn_mfma_f32_32x32x16_bf16(kf[3],qr[1],C1,0,0,0),   P0[14],P0[15],P1[0],P1[1],   pw1[2]=PKW(P0,12),pw1[3]=PKW(P0,14), pw1); \
    VRD(2); SBAR(); GAPA(C0=__builtin_amdgcn_mfma_f32_32x32x16_bf16(kf[4],qr[2],C0,0,0,0),   P1[2],P1[3],P1[4],P1[5],     pw2[0]=PKW(P1,0), pw2[1]=PKW(P1,2), pw2); \
    VRD(6); SBAR(); GAPA(C1=__builtin_amdgcn_mfma_f32_32x32x16_bf16(kf[5],qr[2],C1,0,0,0),   P1[6],P1[7],P1[8],P1[9],     pw2[2]=PKW(P1,4), pw2[3]=PKW(P1,6), pw2); \
    VRD(3); SBAR(); GAPA(C0=__builtin_amdgcn_mfma_f32_32x32x16_bf16(kf[6],qr[3],C0,0,0,0),   P1[10],P1[11],P1[12],P1[13], pw3[0]=PKW(P1,8), pw3[1]=PKW(P1,10), pw3); \
    VRD(7); SBAR(); GAPA(C1=__builtin_amdgcn_mfma_f32_32x32x16_bf16(kf[7],qr[3],C1,0,0,0),   P1[14],P1[15],0.f,0.f,       pw3[2]=PKW(P1,12),pw3[3]=PKW(P1,14), pw3); \
    l_reg+=sacc; \
    if(GK){DMA_K((t)+3,sl_cur);} if(GV){DMA_V((t)+1,sl_next);} \
    CMASK(C0,C1,t); \
    { float a=MX3(C0[0],C0[1],C1[0]),b=MX3(C0[2],C0[3],C1[1]); a=MX3(a,C1[2],C1[3]); \
      _Pragma("unroll") for(int r=4;r<16;r+=4){a=MX3(a,C0[r],C0[r+1]);b=MX3(b,C0[r+2],C0[r+3]);a=MX3(a,C1[r],C1[r+1]);b=MX3(b,C1[r+2],C1[r+3]);} \
      float rm=__builtin_fmaxf(a,b); { auto rr=__builtin_amdgcn_permlane32_swap(__float_as_uint(rm),__float_as_uint(rm),false,false); rm=__builtin_fmaxf(__uint_as_float(rr[0]),__uint_as_float(rr[1])); } \
      resc=false; \
      if(__builtin_expect(__any(rm>(float)THRL),0)){ const float dl=__builtin_fmaxf(rm,0.f); mhat+=dl; \
        _Pragma("unroll") for(int r=0;r<16;++r){C0[r]-=dl;C1[r]-=dl;} \
        _Pragma("unroll") for(int r=0;r<16;++r)negm[r]=-mhat; asm volatile("":"+v"(negm)); \
        const float f=__builtin_amdgcn_exp2f(-dl); l_reg*=f; if(hi==0)wsf[r32]=f; resc=true; } } \
    SBAR(); \
    GAPB(o[0]=__builtin_amdgcn_mfma_f32_32x32x16_bf16(PAF(0),VFR(0),o[0],0,0,0), C0,0); \
    GAPB(o[1]=__builtin_amdgcn_mfma_f32_32x32x16_bf16(PAF(0),VFR(4),o[1],0,0,0), C0,4); \
    KRD(GL,0); GAPB(o[0]=__builtin_amdgcn_mfma_f32_32x32x16_bf16(PAF(1),VFR(1),o[0],0,0,0), C0,8); \
    KRD(GL,1); GAPB(o[1]=__builtin_amdgcn_mfma_f32_32x32x16_bf16(PAF(1),VFR(5),o[1],0,0,0), C0,12); \
    KRD(GL,2); GAPB(o[0]=__builtin_amdgcn_mfma_f32_32x32x16_bf16(PAF(2),VFR(2),o[0],0,0,0), C1,0); \
    KRD(GL,3); GAPB(o[1]=__builtin_amdgcn_mfma_f32_32x32x16_bf16(PAF(2),VFR(6),o[1],0,0,0), C1,4); \
    GAPB(o[0]=__builtin_amdgcn_mfma_f32_32x32x16_bf16(PAF(3),VFR(3),o[0],0,0,0), C1,8); \
    GAPB(o[1]=__builtin_amdgcn_mfma_f32_32x32x16_bf16(PAF(3),VFR(7),o[1],0,0,0), C1,12); \
    }while(0)
  int t=1;
  #undef CMASK
  #define CMASK(P0,P1,t) do{ if constexpr(CFG::BAND) bandmask(P0,P1,kk0w+64*(t),qa,hi,U.ngmask,U.sl2); }while(0)
  for(;t+5<NT;t+=2){
    STEP(pB0,pB1,pA0,pA1,t,!AR,!AR,true);     WAIT_BAR(2); RESC(); ROT();
    STEP(pA0,pA1,pB0,pB1,t+1,!AR,!AR,true);   WAIT_BAR(2); RESC(); ROT();
  }
  #undef CMASK
  #define CMASK(P0,P1,t) do{ if constexpr(CFG::BAND) bandmask(P0,P1,kk0w+64*(t),qa,hi,U.ngmask,U.sl2); }while(0)
  #define ENDW(tt) do{ if((tt)+3<NT){WAIT_BAR(2);} else if((tt)+2<NT){WAIT_BAR(1);} else {WAIT_BAR(0);} }while(0)
  for(;t+1<NT;t+=2){
    STEP(pB0,pB1,pA0,pA1,t,(!AR&&(t+3<NT)),(!AR&&(t+1<NT)),(t+1<NT));       ENDW(t);   RESC(); ROT();
    STEP(pA0,pA1,pB0,pB1,t+1,(!AR&&(t+4<NT)),(!AR&&(t+2<NT)),(t+2<NT));     ENDW(t+1); RESC(); ROT();
  }
  STEP(pB0,pB1,pA0,pA1,NT-1,false,false,false); RESC();
  { float sacc=pB0[0]+pB0[1]; _Pragma("unroll") for(int r=2;r<16;++r)sacc+=pB0[r]; _Pragma("unroll") for(int r=0;r<16;++r)sacc+=pB1[r]; l_reg+=sacc;
    pw0=(u32x4){PKW(pB0,0),PKW(pB0,2),PKW(pB0,4),PKW(pB0,6)};pw1=(u32x4){PKW(pB0,8),PKW(pB0,10),PKW(pB0,12),PKW(pB0,14)};pw2=(u32x4){PKW(pB1,0),PKW(pB1,2),PKW(pB1,4),PKW(pB1,6)};pw3=(u32x4){PKW(pB1,8),PKW(pB1,10),PKW(pB1,12),PKW(pB1,14)};
    SBAR(); pv(o,vb0+sl_cur,PAF(0),PAF(1),PAF(2),PAF(3)); }
  #undef PKW
  #undef PAF
  #undef VFR
  #undef PIN
  #undef MX3
  #undef GAPA
  #undef GAPB
  #undef EX
  #undef VRD
  #undef KRD
  #undef STEP
  #undef ENDW
  asm volatile("s_waitcnt lgkmcnt(0)\n\ts_barrier":::"memory");
  if(nK){ const bf16*ks2=nK+(long)lane*KP+wid*8; const bf16*vs2=nV+(long)(16*(wid&3)+(lane>>2))*VP+(wid>>2)*32+(lane&3)*8;
    if constexpr(AR){
      #pragma unroll
      for(int tt=0;tt<6;++tt) if(tt<nNTL){ glds16(ks2+(long)tt*KVBLK*KP,(unsigned)__builtin_amdgcn_readfirstlane(kdst+tt*SLOTB)); glds16(vs2+(long)tt*KVBLK*VP,(unsigned)__builtin_amdgcn_readfirstlane(vdst+tt*SLOTB)); } }
    else { glds16(ks2,(unsigned)__builtin_amdgcn_readfirstlane(kdst)); glds16(vs2,(unsigned)__builtin_amdgcn_readfirstlane(vdst)); glds16(ks2+(long)KVBLK*KP,(unsigned)__builtin_amdgcn_readfirstlane(kdst+SLOTB)); } }
  {auto rr=__builtin_amdgcn_permlane32_swap(__float_as_uint(l_reg),__float_as_uint(l_reg),false,false);l_reg=__uint_as_float(rr[0])+__uint_as_float(rr[1]);}
  if constexpr(CFG::BAND){ if(hi==0)U.lse[wid*QBLK+r32]=mhat+__builtin_amdgcn_logf(l_reg); }
  if(hi==0)wsf[32+r32]=l_reg;asm volatile("s_waitcnt lgkmcnt(0)":::"memory");
  float rli[16];
  #pragma unroll
  for(int r=0;r<16;++r)rli[r]=__builtin_amdgcn_rcpf(wsf[32+crow(r,hi)]);
  if constexpr(CFG::OFP8){
    unsigned char*Ow8=U.O8+(long)(wid*QBLK)*OP;
    unsigned char*stg8=(unsigned char*)(shm+LOST)+wid*OSTW;
    #pragma unroll
    for(int r=0;r<16;++r){const int orow=crow(r,hi);
      #pragma unroll
      for(int d0=0;d0<2;++d0){ const float x=__builtin_amdgcn_fmed3f(o[d0][r]*rli[r]*OUT_SCALE,-448.0f,448.0f); stg8[orow*64+d0*32+r32]=(unsigned char)(__builtin_amdgcn_cvt_pk_fp8_f32(x,x,0u,false)&0xffu); } }
    asm volatile("s_waitcnt lgkmcnt(0)":::"memory");
    #pragma unroll
    for(int i=0;i<2;++i){const int row=i*16+(lane>>2),ch=lane&3; const u32x4 v=*(const u32x4*)(stg8+row*64+ch*16); ATTN_STORE16(Ow8+(long)row*OP+ch*16,v);} }
  else {
  bf16*Ow=U.O+(long)(wid*QBLK)*OP;
  { bf16*stg=(bf16*)(shm+LOST)+wid*2048;
    #pragma unroll
    for(int r=0;r<16;++r){const int orow=crow(r,hi);
      #pragma unroll
      for(int d0=0;d0<2;++d0)stg[orow*64+d0*32+r32]=__float2bfloat16(o[d0][r]*rli[r]);}
    asm volatile("s_waitcnt lgkmcnt(0)":::"memory");
    #pragma unroll
    for(int i=0;i<4;++i){const int row=i*8+(lane>>3),ch=lane&7; const u32x4 v=*(const u32x4*)(stg+row*64+ch*8); ATTN_STORE16(Ow+(long)row*OP+ch*8,v);} }
  }
  if(!nK) asm volatile("s_waitcnt lgkmcnt(0)\n\ts_barrier":::"memory");
  #undef DMA_K
  #undef DMA_V
  #undef CMASK
  #undef START
  #undef RESC
  #undef ROT
}
constexpr int ATTN_LDS_BYTES=LDS_BYTES;
struct AttnTensors { const bf16* Q; const bf16* K; const bf16* V; bf16* O; unsigned char* O8; };
struct OrderA {
  int vcu, G; AttnTensors T;
  __device__ __forceinline__ bool next(int i,UnitP&u)const{ const int L=(G==256)?(vcu*4+i):(vcu+i*G); if((G==256&&i>=4)||L>=BATCH*NHEAD*NQB)return false;
    const int bh=L>>3,qb=L&7,b=bh/NHEAD,h=bh%NHEAD; const long rowbase=(long)b*SEQ;
    u.Q=T.Q+(rowbase+qb*QB)*CfgA::QP+h*D; u.K=T.K+rowbase*CfgA::KP+(h>>2)*D; u.V=T.V+rowbase*CfgA::VP+(h>>2)*D; u.O=T.O+(rowbase+qb*QB)*CfgA::OP+h*D; u.O8=T.O8+(rowbase+qb*QB)*CfgA::OP+h*D;
    u.lse=nullptr; u.NT=SEQ/KVBLK; u.qa0=0; u.kk0=0; u.ngmask=0; u.sl2=0.f; u.NTL=0; u.hs0=0; u.hs1=0; return true; }
};
struct OrderB {
  int vcu, G; AttnTensors T; float* lse;
  __device__ __forceinline__ bool next(int i,UnitP&u)const{ const int L=(G==256)?(vcu*6+i):(vcu+i*G); if((G==256&&i>=6)||L>=BATCH*12*NQB)return false;
    const int blk=L&7,bgh=L>>3,gh=bgh%12,g=gh>>2; const long hb=(long)bgh*SEQ;
    const int ng=SEQ>>(2*g),q0=blk*QB; int t_lo,nt,h0=0,h1=2;
    if(g==2){ t_lo=q0>>6; nt=4; } else { const int c_lo=(q0&~(ng-1))>>6,c_hi=c_lo+(ng>>6),t0=(q0>>6)-1; t_lo=t0; if(t_lo<c_lo)t_lo=c_lo; if(t_lo>c_hi-6)t_lo=c_hi-6; nt=6; const int d=t0-t_lo; h0=d>0?d:0; h1=2+(d<0?d:0); }
    u.Q=T.Q+(hb+q0)*D; u.K=T.K+(hb+t_lo*64)*D; u.V=T.V+(hb+t_lo*64)*D; u.O=T.O+(hb+q0)*D; u.O8=T.O8+(hb+q0)*D; u.lse=lse+hb+q0;
    u.NT=nt-2; u.NTL=nt; u.hs0=h0; u.hs1=h1; u.qa0=q0; u.kk0=t_lo*64; u.ngmask=~(ng-1); u.sl2=__builtin_amdgcn_exp2f(-8.0f*(float)(gh+1)/12.0f)*1.4426950408889634f*(float)(1<<(2*g)); return true; }
};
template<class CFG,class Sched,int THRL=8> __device__ __forceinline__ void attn_phase(char*lds,const Sched&S,const int wave){
  UnitP u;
  for(int i=0;S.next(i,u);++i){ UnitP n; const bool hn=S.next(i+1,n); const bf16*nK=hn?n.K:nullptr,*nV=hn?n.V:nullptr; const int nNTL=hn?n.NTL:0; attn_unit<THRL,CFG>(wave,u,lds,i>0,nK,nV,nNTL); }
}
#undef SBAR
#undef WAIT_BAR
}
typedef unsigned u32x2g __attribute__((ext_vector_type(2)));
#define GAS __attribute__((address_space(1)))
#define LAS __attribute__((address_space(3)))
typedef unsigned short bf16;
typedef unsigned v4u __attribute__((ext_vector_type(4)));
typedef float f32x4 __attribute__((ext_vector_type(4)));
typedef short bf16x8 __attribute__((ext_vector_type(8)));
typedef GAS unsigned gu32;
typedef GAS unsigned long long gu64;
#define RLX_AGENT __ATOMIC_RELAXED, __HIP_MEMORY_SCOPE_AGENT
#define LDS_WAIT() asm volatile("s_waitcnt lgkmcnt(0)" ::: "memory")
#define VM_WAIT() asm volatile("s_waitcnt vmcnt(0)" ::: "memory")
__device__ __forceinline__ unsigned long long rt() { return __builtin_amdgcn_s_memrealtime(); }
__device__ __forceinline__ unsigned f2bf(float f) { unsigned u = __builtin_bit_cast(unsigned, f); return (u + 0x7fffu + ((u >> 16) & 1u)) >> 16; }
__device__ __forceinline__ unsigned pk2(float lo, float hi) { return f2bf(lo) | (f2bf(hi) << 16); }

#define XB_TMO      128
#define XB_XCNT(j)  (256  + 64 * (j))
#define XB_XSUB(j)  (1280 + 64 * (j))
#define XB_XGEN(j)  (2304 + 64 * (j))
#define XB_TOP      3328
#define XB_TOPGEN   3392
#define XCD_BAR_WORDS 3456
#define XB_SPIN_CAP (1u << 18)

__device__ __forceinline__ unsigned xb_ld(unsigned* p)              { return __hip_atomic_load(p, __ATOMIC_RELAXED, __HIP_MEMORY_SCOPE_AGENT); }
__device__ __forceinline__ unsigned xb_add(unsigned* p, unsigned v) { return __hip_atomic_fetch_add(p, v, __ATOMIC_RELAXED, __HIP_MEMORY_SCOPE_AGENT); }
__device__ __forceinline__ unsigned xb_xcc_id() { return (unsigned)__builtin_amdgcn_s_getreg((3 << 11) | 20) & 0xFu; }
#define XB_SPIN(cond, bar) do { unsigned _sp = 0; while (cond) { __builtin_amdgcn_s_sleep(1); \
    if ((++_sp & 255u) == 0u) { if (xb_ld(&(bar)[XB_TMO])) break; if (_sp > XB_SPIN_CAP) { atomicAdd(&(bar)[XB_TMO], 1u); break; } } } } while (0)

struct XcdBarrier {
    unsigned* bar; unsigned x;
    volatile LAS unsigned* st;
};

__device__ __forceinline__ XcdBarrier xcd_barrier_post(unsigned* bar, volatile LAS unsigned* st) {
    XcdBarrier b; b.bar = bar; b.x = xb_xcc_id(); b.st = st;
    if (threadIdx.x == 0) (void)xb_add(&bar[XB_XCNT(b.x)], 1u);
    return b;
}
__device__ __forceinline__ void xcd_barrier_complete(unsigned* bar, unsigned x, unsigned& nloc, unsigned& nx) {
    const unsigned G = gridDim.x * gridDim.y * gridDim.z;
    unsigned sum, cnt, mine, sp = 0u;
    for (;;) {
        sum = 0u; cnt = 0u; mine = 0u;
#pragma unroll
        for (unsigned j = 0; j < 16; ++j) { const unsigned c = xb_ld(&bar[XB_XCNT(j)]); sum += c; cnt += (c > 0u) ? 1u : 0u; mine = (j == x) ? c : mine; }
        if (sum == G) break;
        __builtin_amdgcn_s_sleep(1);
        if ((++sp & 255u) == 0u) { if (xb_ld(&bar[XB_TMO])) break; if (sp > XB_SPIN_CAP) { atomicAdd(&bar[XB_TMO], 1u); break; } }
    }
    nloc = mine > 0u ? mine : 1u; nx = cnt > 0u ? cnt : 1u;
}

__device__ __forceinline__ void xcd_barrier(const XcdBarrier& b, const bool is_t0  ) {
    asm volatile("s_waitcnt vmcnt(0)" ::: "memory");
    __syncthreads();
    if (is_t0) {
        unsigned* bar = b.bar;
        __builtin_amdgcn_s_waitcnt(0);
        unsigned nloc = b.st[0], nx = b.st[1];
        if (nloc == 0u) { xcd_barrier_complete(bar, b.x, nloc, nx); b.st[0] = nloc; b.st[1] = nx; }
        const unsigned old = xb_add(&bar[XB_XSUB(b.x)], 1u);
        const unsigned gen = old / nloc;
        if (old + 1u == (gen + 1u) * nloc) {
            __builtin_amdgcn_fence(__ATOMIC_RELEASE, "agent");
            asm volatile("s_waitcnt vmcnt(0)" ::: "memory");
            const unsigned og = xb_add(&bar[XB_TOP], 1u);
            const unsigned tg = og / nx;
            if (og + 1u == (tg + 1u) * nx) xb_add(&bar[XB_TOPGEN], 1u);
            else XB_SPIN(xb_ld(&bar[XB_TOPGEN]) == tg, bar);
            __builtin_amdgcn_fence(__ATOMIC_ACQUIRE, "agent");
            xb_add(&bar[XB_XGEN(b.x)], 1u);
            asm volatile("s_waitcnt vmcnt(0)" ::: "memory");
        } else {
            XB_SPIN(xb_ld(&bar[XB_XGEN(b.x)]) == gen, bar);
            __builtin_amdgcn_fence(__ATOMIC_ACQUIRE, "agent");
            asm volatile("s_waitcnt vmcnt(0)" ::: "memory");
        }
    }
    __syncthreads();
}
#ifndef MK_N_LAUNCHES
#define MK_N_LAUNCHES 1
#endif
constexpr int NWAVES = 8;
constexpr int PPL = 9;
constexpr int N_PHASES = 2 + PPL * DEPTH;
constexpr size_t MiB = 1u << 20;
constexpr size_t WS_CTL = 0, CTL_ZERO_BYTES = 64 * 1024;
constexpr size_t WS_ROPE = 1 * MiB;
constexpr size_t WS_MOD = 2 * MiB;
constexpr size_t WS_ROWLIST = 4 * MiB, WS_GATEW = 6 * MiB;
constexpr size_t WS_WIN = 8 * MiB, WS_WPA = 18 * MiB, WS_WPB = 19 * MiB, WS_WO = 20 * MiB, WS_WGU = 22 * MiB, WS_WDN = 38 * MiB;
constexpr size_t WS_H = 48 * MiB;
constexpr size_t WS_OUTB = 112 * MiB;
constexpr size_t WS_QA = 128 * MiB, WS_KA = 160 * MiB, WS_VA = 168 * MiB, WS_QD = 176 * MiB, WS_KD = 224 * MiB, WS_VDT = 272 * MiB, WS_G = 320 * MiB;
constexpr size_t WS_MERGED = 160 * MiB;
constexpr size_t WS_TMP = 224 * MiB;
constexpr size_t WS_ACT = 224 * MiB;
constexpr size_t WS_Y2 = 320 * MiB;
constexpr size_t WS_TRASH = 448 * MiB;
constexpr size_t WS_LSE = 449 * MiB;
constexpr size_t WS_STATS = 451 * MiB;
constexpr size_t WS_XS = 385 * MiB;
constexpr size_t WS_GMIX = 452 * MiB;
constexpr size_t WS_END = 516 * MiB;
constexpr int CW_GCNT = 1024;
constexpr int CW_BAR = 4096;
constexpr int CW_PANEL = 8192;
constexpr int RING_OFF = 0, RING_BYTES = 131072;
constexpr int LDSCTL_OFF = RING_BYTES, MISC_OFF = LDSCTL_OFF + 320;
constexpr int MOETAB_OFF = LDSCTL_OFF + 512;
constexpr int LDS_BYTES = 147456;

struct Frame {
    LAS unsigned char* lds;
    volatile LAS unsigned* MISC;
    gu32* ctl;
    int tid, lane, wave, vcu, G;
};
__device__ __forceinline__ float wave_sum(float v) {
#pragma unroll
    for (int o = 1; o < 64; o <<= 1) v += __shfl_xor(v, o);
    return v;
}
__device__ __forceinline__ float bf2f_(unsigned short b) { return __uint_as_float((unsigned)b << 16); }

__device__ __forceinline__ int hpw_row(int n) { const int c = n & 255; return (n & ~255) + 128 * ((c >> 5) & 1) + 32 * (c >> 6) + 16 * ((c >> 2) & 1) + 4 * ((c >> 3) & 3) + (c & 3); }
__device__ __forceinline__ int hpw_row16(int n) { const int c = n & 255; return (n & ~255) + 128 * ((c >> 3) & 1) + 32 * (c >> 6) + 16 * ((c >> 2) & 1) + 4 * ((c >> 4) & 3) + (c & 3); }
__device__ __forceinline__ int gu_row(int f, int which) { return (f >> 7) * 256 + 128 * ((f >> 2) & 1) + 32 * ((f >> 5) & 3) + 16 * which + 4 * ((f >> 3) & 3) + (f & 3); }

constexpr float FP8_SA = 16.0f, FP8_SWIN = 256.0f;
__device__ __forceinline__ float sat8(float x) { return __builtin_amdgcn_fmed3f(x, -448.0f, 448.0f); }
__device__ __forceinline__ unsigned pk4_fp8(float a, float b, float c, float d) { unsigned w = 0; w = __builtin_amdgcn_cvt_pk_fp8_f32(sat8(a), sat8(b), w, false); w = __builtin_amdgcn_cvt_pk_fp8_f32(sat8(c), sat8(d), w, true); return w; }
template <int MODE>
__device__ __forceinline__ void transpose_item_fp8(const float* W, int K, int N, unsigned char* WT, int row_off, LAS float* scr, int item, int lane, const float FP8_SW) {
    const int nblk = N / 32, kb = item / nblk, nb = item % nblk, k0 = 64 * kb, n0 = 32 * nb;
#pragma unroll
    for (int i = 0; i < 32; ++i) { const int kk = 2 * i + (lane >> 5); scr[kk * 33 + (lane & 31)] = W[(size_t)(k0 + kk) * N + n0 + (lane & 31)]; }
    LDS_WAIT(); asm volatile("" ::: "memory");
    const int n = lane >> 1, kh = (lane & 1) * 32; const LAS float* s = scr + kh * 33 + n;
    v4u o0, o1;
    o0.x = pk4_fp8(s[0 * 33] * FP8_SW, s[1 * 33] * FP8_SW, s[2 * 33] * FP8_SW, s[3 * 33] * FP8_SW); o0.y = pk4_fp8(s[4 * 33] * FP8_SW, s[5 * 33] * FP8_SW, s[6 * 33] * FP8_SW, s[7 * 33] * FP8_SW);
    o0.z = pk4_fp8(s[8 * 33] * FP8_SW, s[9 * 33] * FP8_SW, s[10 * 33] * FP8_SW, s[11 * 33] * FP8_SW); o0.w = pk4_fp8(s[12 * 33] * FP8_SW, s[13 * 33] * FP8_SW, s[14 * 33] * FP8_SW, s[15 * 33] * FP8_SW);
    o1.x = pk4_fp8(s[16 * 33] * FP8_SW, s[17 * 33] * FP8_SW, s[18 * 33] * FP8_SW, s[19 * 33] * FP8_SW); o1.y = pk4_fp8(s[20 * 33] * FP8_SW, s[21 * 33] * FP8_SW, s[22 * 33] * FP8_SW, s[23 * 33] * FP8_SW);
    o1.z = pk4_fp8(s[24 * 33] * FP8_SW, s[25 * 33] * FP8_SW, s[26 * 33] * FP8_SW, s[27 * 33] * FP8_SW); o1.w = pk4_fp8(s[28 * 33] * FP8_SW, s[29 * 33] * FP8_SW, s[30 * 33] * FP8_SW, s[31 * 33] * FP8_SW);
    const int drow_ = MODE == 0 ? hpw_row(n0 + n) : MODE == 3 ? hpw_row16(n0 + n) : MODE == 4 ? (n0 >= 3072 ? hpw_row16(n0 + n) : hpw_row(n0 + n)) : gu_row(n0 + n, MODE - 1);
    unsigned char* dst = WT + (size_t)(row_off + drow_) * K + k0 + kh;
    *(GAS v4u*)dst = o0; *(GAS v4u*)(dst + 16) = o1;
    LDS_WAIT(); asm volatile("" ::: "memory");
}
template <int MODE>
__device__ __forceinline__ void transpose_item(const float* W, int K, int N, pg8::bf16_t* WT, int row_off, LAS float* scr, int item, int lane) {
    const int nblk = N / 32, kb = item / nblk, nb = item % nblk, k0 = 64 * kb, n0 = 32 * nb;
#pragma unroll 8
    for (int i = 0; i < 32; ++i) { const int kk = 2 * i + (lane >> 5); scr[kk * 33 + (lane & 31)] = W[(size_t)(k0 + kk) * N + n0 + (lane & 31)]; }
    LDS_WAIT(); asm volatile("" ::: "memory");
    const int c = lane & 7;
#pragma unroll
    for (int j = 0; j < 4; ++j) { const int n = (lane >> 3) + 8 * j; const LAS float* s = scr + (8 * c) * 33 + n;
        v4u o; o.x = pk2(s[0 * 33], s[1 * 33]); o.y = pk2(s[2 * 33], s[3 * 33]); o.z = pk2(s[4 * 33], s[5 * 33]); o.w = pk2(s[6 * 33], s[7 * 33]);
        const int drow = row_off + (MODE == 0 ? hpw_row(n0 + n) : gu_row(n0 + n, MODE - 1));
        *(GAS v4u*)(WT + (size_t)drow * K + k0 + 8 * c) = o; }
    LDS_WAIT(); asm volatile("" ::: "memory");
}
struct Weights { const float *w_in, *w_pa, *w_pb, *w_o, *w_g, *w_u, *w_d; };
__device__ __forceinline__ void convert_layer(Frame& F0, const Weights& W, unsigned char* ws) {
    Frame F = F0;
    LAS float* scr = (LAS float*)(F.lds + RING_OFF + F.wave * 16384);
    const int gw = F.vcu * NWAVES + F.wave, NGW = F.G * NWAVES;
    constexpr int I_IN = 16 * 160, I_PA = 8 * 32, I_PB = 4 * 32, I_O = 16 * 32, I_G = 16 * 128, I_D = 16 * 128;
    constexpr int NITEMS = I_IN + I_PA + I_PB + I_O + 2 * I_G + I_D;
    for (int it = gw; it < NITEMS; it += NGW) {
        int r = it;
        if (r < I_IN) { transpose_item_fp8<4>(W.w_in, 1024, N_IN, ws + WS_WIN, 0, scr, r, F.lane, FP8_SWIN); continue; } r -= I_IN;
        if (r < I_PA) { transpose_item_fp8<3>(W.w_pa, 768, 1024, ws + WS_WPA, 0, scr, r, F.lane, PAB_WSCALE); continue; } r -= I_PA;
        if (r < I_PB) { transpose_item_fp8<3>(W.w_pb, 768, 1024, ws + WS_WPA + 512, 0, scr, r, F.lane, PAB_WSCALE); continue; } r -= I_PB;
        if (r < I_O) { transpose_item_fp8<3>(W.w_o, 1024, 1024, ws + WS_WO, 0, scr, r, F.lane, WO_SCALE); continue; } r -= I_O;
        if (r < I_G) { const int e = r >> 7; transpose_item_fp8<1>(W.w_g + (size_t)e * 1024 * 256, 1024, 256, ws + WS_WGU, e * 512, scr, r & 127, F.lane, GU_WSCALE); continue; } r -= I_G;
        if (r < I_G) { const int e = r >> 7; transpose_item_fp8<2>(W.w_u + (size_t)e * 1024 * 256, 1024, 256, ws + WS_WGU, e * 512, scr, r & 127, F.lane, GU_WSCALE); continue; } r -= I_G;
        { const int e = r >> 7; transpose_item_fp8<3>(W.w_d + (size_t)e * 256 * 1024, 256, 1024, ws + WS_WDN, e * 1024, scr, r & 127, F.lane, DN_WSCALE); }
    }
}

__device__ __forceinline__ void row_stats(const f32x4 (&v)[4], float& mean, float& rstd) {
    float s = 0.f;
#pragma unroll
    for (int j = 0; j < 4; ++j) s += (v[j].x + v[j].y) + (v[j].z + v[j].w);
    mean = wave_sum(s) * (1.f / DM); float s2 = 0.f;
#pragma unroll
    for (int j = 0; j < 4; ++j) { const f32x4 d = v[j] - mean; s2 += (d.x * d.x + d.y * d.y) + (d.z * d.z + d.w * d.w); }
    rstd = 1.f / sqrtf(wave_sum(s2) * (1.f / DM) + LN_EPS);
}
__device__ __forceinline__ void store_row_fp8(unsigned char* orow, int lane, const f32x4 (&v)[4]) {
    GAS unsigned* o4 = (GAS unsigned*)orow + lane;
#pragma unroll
    for (int j = 0; j < 4; ++j) o4[64 * j] = pk4_fp8(sat8(v[j].x * FP8_SA), sat8(v[j].y * FP8_SA), sat8(v[j].z * FP8_SA), sat8(v[j].w * FP8_SA));
}
__device__ __forceinline__ void store_row_bf16(pg8::bf16_t* orow, int lane, const f32x4 (&v)[4]) {
    GAS unsigned long long* o8 = (GAS unsigned long long*)orow + lane;
#pragma unroll
    for (int j = 0; j < 4; ++j) o8[64 * j] = (unsigned long long)pk2(v[j].x, v[j].y) | ((unsigned long long)pk2(v[j].z, v[j].w) << 32);
}

__device__ __forceinline__ void phase_pr0(Frame& F, const float* c, const float* w_ada, const float* b_ada, float* mod, float* rope, const Weights& W0, unsigned char* ws) {
    LAS float* condT = (LAS float*)(F.lds);
    LAS float* red = (LAS float*)(F.lds + 65536);
    for (int idx = F.tid; idx < 16 * 1024; idx += NWAVES * 64) { const int b = idx >> 10, k = idx & 1023; const float x = c[idx]; condT[k * 16 + b] = x / (1.f + __expf(-x)); }
    __syncthreads();
    for (int it = F.vcu; it < 4 * 96; it += F.G) {
        const int l = it / 96, cb = it % 96, n = cb * 64 + F.lane;
        const float* wp = w_ada + ((size_t)l * 1024 + F.wave * 128) * 6144 + n;
        float a[16];
#pragma unroll
        for (int b = 0; b < 16; ++b) a[b] = 0.f;
        for (int k0 = 0; k0 < 128; k0 += 8) {
            float wv[8];
#pragma unroll
            for (int kk = 0; kk < 8; ++kk) wv[kk] = wp[(size_t)(k0 + kk) * 6144];
#pragma unroll
            for (int kk = 0; kk < 8; ++kk) {
                const LAS f32x4* cp = (const LAS f32x4*)(condT + (F.wave * 128 + k0 + kk) * 16);
#pragma unroll
                for (int q = 0; q < 4; ++q) { const f32x4 cv = cp[q]; a[4 * q] += wv[kk] * cv.x; a[4 * q + 1] += wv[kk] * cv.y; a[4 * q + 2] += wv[kk] * cv.z; a[4 * q + 3] += wv[kk] * cv.w; }
            }
        }
#pragma unroll
        for (int b = 0; b < 16; ++b) red[(F.wave * 16 + b) * 64 + F.lane] = a[b];
        __syncthreads();
        for (int o = F.tid; o < 1024; o += NWAVES * 64) { const int b = o >> 6, nn = o & 63; float s = b_ada[(size_t)l * 6144 + cb * 64 + nn];
#pragma unroll
            for (int w = 0; w < 8; ++w) s += red[(w * 16 + b) * 64 + nn];
            mod[((size_t)l * 16 + b) * 6144 + cb * 64 + nn] = s; }
        __syncthreads();
    }
    if (F.vcu == 0 && F.tid < 16) {
        const int k = F.tid; double th = 1.0; for (int i = 0; i < k; ++i) th *= 0.5623413251903491;
        double c1 = 1.0, s1 = th; { double tc = 1.0, tsn = th; const double t2 = th * th;
            for (int i = 1; i < 14; ++i) { tc *= -t2 / ((2.0 * i - 1.0) * (2.0 * i)); tsn *= -t2 / ((2.0 * i) * (2.0 * i + 1.0)); c1 += tc; s1 += tsn; } }
        double cc = 1.0, sn = 0.0;
        for (int a = 0; a < 64; ++a) { rope[(a * 16 + k) * 2] = (float)cc; rope[(a * 16 + k) * 2 + 1] = (float)sn; const double nc = cc * c1 - sn * s1, ns = sn * c1 + cc * s1; cc = nc; sn = ns; }
    }
    __syncthreads();
    convert_layer(F, W0, ws);
}
__device__ __forceinline__ void phase_pr1(Frame& F, const float* x, const float* mod0, pg8::bf16_t* H) {
    for (int blk = F.vcu; blk < T_TOK / 128; blk += F.G) {
        const int b = blk >> 4; const float* mb = mod0 + (size_t)b * 6144;
        f32x4 sh[4], sc[4];
#pragma unroll
        for (int j = 0; j < 4; ++j) { sh[j] = *(const f32x4*)(mb + 4 * F.lane + 256 * j); sc[j] = *(const f32x4*)(mb + 1024 + 4 * F.lane + 256 * j) + 1.0f; }
        for (int k = 0; k < 16; k += 4) {
            const int row0 = blk * 128 + F.wave * 16 + k;
            f32x4 v[4][4];
#pragma unroll
            for (int q = 0; q < 4; ++q) { const GAS f32x4* xr = (const GAS f32x4*)(x + (size_t)(row0 + q) * DM) + F.lane;
#pragma unroll
                for (int j = 0; j < 4; ++j) v[q][j] = xr[64 * j]; }
#pragma unroll
            for (int q = 0; q < 4; ++q) {
                float mean, rstd; row_stats(v[q], mean, rstd);
#pragma unroll
                for (int j = 0; j < 4; ++j) v[q][j] = (v[q][j] - mean) * rstd * sc[j] + sh[j];
                store_row_fp8((unsigned char*)H + (size_t)(row0 + q) * DM, F.lane, v[q]);
            }
        }
    }
}
template <bool XF32>
__device__ __forceinline__ void phase_ln1(Frame& F0, const float* xb, const pg8::bf16_t* gmix, const float* ln_g, const float* ln_b, const float* modl, const float* w_router, const float* rbias,
                                          pg8::bf16_t* H, int* rowlist, float* gatew, gu32* gcnt, float* stats, const bool dry = false) {
    Frame F = F0;
    LAS float* wr = (LAS float*)(F.lds);
    LAS float* cst = (LAS float*)(F.lds + 65536);
    LAS int* lcnt = (LAS int*)(F.lds + 81920);
    LAS int* gbase = lcnt + 16;
    LAS int* st_e = lcnt + 32;
    LAS float* st_g = (LAS float*)(lcnt + 32 + 256);
    { f32x4 t[8];
#pragma unroll
      for (int i = 0; i < 8; ++i) t[i] = ((const f32x4*)w_router)[F.tid + NWAVES * 64 * i];
#pragma unroll
      for (int i = 0; i < 8; ++i) { const int q4 = F.tid + NWAVES * 64 * i, k = q4 >> 2, e0 = (q4 & 3) * 4;
          wr[(e0 + 0) * 1024 + k] = t[i].x; wr[(e0 + 1) * 1024 + k] = t[i].y; wr[(e0 + 2) * 1024 + k] = t[i].z; wr[(e0 + 3) * 1024 + k] = t[i].w; } }
    const float rbl = rbias[F.lane & 15];
    for (int blk = F.vcu; blk < T_TOK / 128; blk += F.G) {
        const int b = blk >> 4; const float* mb = modl + (size_t)b * 6144;
        __syncthreads();
        for (int idx = F.tid; idx < 1024; idx += NWAVES * 64) { cst[idx] = ln_g[idx]; cst[1024 + idx] = ln_b[idx]; cst[2048 + idx] = 1.0f + mb[4 * 1024 + idx]; cst[3072 + idx] = mb[3 * 1024 + idx]; }
        if (F.tid < 16) lcnt[F.tid] = 0;
        __syncthreads();
        for (int it = 0; it < 4; ++it) {
            f32x4 vv[4][4]; unsigned gm[4][4];
            const int row0 = blk * 128 + F.wave * 16 + it * 4;
#pragma unroll
            for (int q = 0; q < 4; ++q) { const GAS unsigned* gr = (const GAS unsigned*)((const unsigned char*)gmix + (size_t)(row0 + q) * DM) + F.lane;
                if constexpr (XF32) { const GAS f32x4* xr = (const GAS f32x4*)(xb + (size_t)(row0 + q) * DM) + F.lane;
#pragma unroll
                    for (int j = 0; j < 4; ++j) vv[q][j] = xr[64 * j]; }
                else { const GAS u32x2g* xr = (const GAS u32x2g*)((const pg8::bf16_t*)xb + (size_t)(row0 + q) * DM) + F.lane;
#pragma unroll
                    for (int j = 0; j < 4; ++j) { const u32x2g w = xr[64 * j]; vv[q][j].x = __uint_as_float(w.x << 16); vv[q][j].y = __uint_as_float(w.x & 0xffff0000u); vv[q][j].z = __uint_as_float(w.y << 16); vv[q][j].w = __uint_as_float(w.y & 0xffff0000u); } }
#pragma unroll
                for (int j = 0; j < 4; ++j) gm[q][j] = gr[64 * j]; }
#pragma unroll
            for (int q = 0; q < 4; ++q)
#pragma unroll
                for (int j = 0; j < 4; ++j) { typedef float f32x2v __attribute__((ext_vector_type(2))); const f32x2v g0 = __builtin_amdgcn_cvt_pk_f32_fp8(gm[q][j], false), g1 = __builtin_amdgcn_cvt_pk_f32_fp8(gm[q][j], true);
                    f32x4 g4; g4.x = g0[0] * GMIX_DESCALE; g4.y = g0[1] * GMIX_DESCALE; g4.z = g1[0] * GMIX_DESCALE; g4.w = g1[1] * GMIX_DESCALE;
                    vv[q][j] = vv[q][j] * DN_ALPHA + g4; }
            float hq[4][16];
#pragma unroll
            for (int q = 0; q < 4; ++q) {
                const int row = row0 + q;
                f32x4 v[4];
#pragma unroll
                for (int j = 0; j < 4; ++j) v[j] = vv[q][j];
                float mean, rstd; row_stats(v, mean, rstd);
                if (F.lane == 0) { stats[2 * (size_t)row] = mean; stats[2 * (size_t)row + 1] = rstd; }
#pragma unroll
                for (int j = 0; j < 4; ++j) { const f32x4 g4 = *(const LAS f32x4*)(cst + 4 * F.lane + 256 * j), b4 = *(const LAS f32x4*)(cst + 1024 + 4 * F.lane + 256 * j);
                    v[j] = (v[j] - mean) * rstd * g4 + b4; }
                row_stats(v, mean, rstd);
#pragma unroll
                for (int j = 0; j < 4; ++j) { const f32x4 s4 = *(const LAS f32x4*)(cst + 2048 + 4 * F.lane + 256 * j), h4 = *(const LAS f32x4*)(cst + 3072 + 4 * F.lane + 256 * j);
                    v[j] = (v[j] - mean) * rstd * s4 + h4; hq[q][4 * j] = v[j].x; hq[q][4 * j + 1] = v[j].y; hq[q][4 * j + 2] = v[j].z; hq[q][4 * j + 3] = v[j].w; }
                store_row_fp8((unsigned char*)H + (size_t)row * DM, F.lane, v);
            }
            float ac[64];
            typedef float f32x2r __attribute__((ext_vector_type(2)));
#pragma unroll
            for (int e = 0; e < 16; ++e) {
                f32x2r a0 = {0.f, 0.f}, a1 = {0.f, 0.f}, a2 = {0.f, 0.f}, a3 = {0.f, 0.f};
#pragma unroll
                for (int j = 0; j < 4; ++j) { const f32x4 w4 = *(const LAS f32x4*)(wr + e * 1024 + 256 * j + 4 * F.lane);
                    const f32x2r wl = {w4.x, w4.y}, wh = {w4.z, w4.w};
                    a0 = (f32x2r){hq[0][4 * j], hq[0][4 * j + 1]} * wl + a0; a0 = (f32x2r){hq[0][4 * j + 2], hq[0][4 * j + 3]} * wh + a0;
                    a1 = (f32x2r){hq[1][4 * j], hq[1][4 * j + 1]} * wl + a1; a1 = (f32x2r){hq[1][4 * j + 2], hq[1][4 * j + 3]} * wh + a1;
                    a2 = (f32x2r){hq[2][4 * j], hq[2][4 * j + 1]} * wl + a2; a2 = (f32x2r){hq[2][4 * j + 2], hq[2][4 * j + 3]} * wh + a2;
                    a3 = (f32x2r){hq[3][4 * j], hq[3][4 * j + 1]} * wl + a3; a3 = (f32x2r){hq[3][4 * j + 2], hq[3][4 * j + 3]} * wh + a3; }
                ac[e] = a0.x + a0.y; ac[16 + e] = a1.x + a1.y; ac[32 + e] = a2.x + a2.y; ac[48 + e] = a3.x + a3.y;
            }
#pragma unroll
            for (int s = 5; s >= 0; --s) { const int half = 1 << s; const bool up = (F.lane >> s) & 1;
#pragma unroll
                for (int i = 0; i < half; ++i) { const float keep = up ? ac[i + half] : ac[i], send = up ? ac[i] : ac[i + half]; ac[i] = keep + __shfl_xor(send, half); } }
            {
                const int L = F.lane, rowb = L & ~15, quadb = L & ~3;
                const float score = 1.0f / (1.0f + __expf(-ac[0])), selv = score + rbl;
                const float a = __shfl(selv, quadb), bb = __shfl(selv, quadb + 1), cc = __shfl(selv, quadb + 2), d = __shfl(selv, quadb + 3);
                const float hi1 = fmaxf(a, bb), lo1 = fminf(a, bb), hi2 = fmaxf(cc, d), lo2 = fminf(cc, d);
                const float gsq = fmaxf(hi1, hi2) + fmaxf(fminf(hi1, hi2), fmaxf(lo1, lo2));
                float gs[4];
#pragma unroll
                for (int g = 0; g < 4; ++g) gs[g] = __shfl(gsq, rowb + 4 * g);
                int best = 0; float bv = gs[0];
#pragma unroll
                for (int g = 1; g < 4; ++g) if (gs[g] > bv) { bv = gs[g]; best = g; }
                float s4[4], c4[4];
#pragma unroll
                for (int k = 0; k < 4; ++k) { s4[k] = __shfl(selv, rowb + 4 * best + k); c4[k] = __shfl(score, rowb + 4 * best + k); }
                int i1 = 0; float v1 = s4[0];
#pragma unroll
                for (int k = 1; k < 4; ++k) if (s4[k] > v1) { v1 = s4[k]; i1 = k; }
                int i2 = -1; float v2 = -INFINITY;
#pragma unroll
                for (int k = 0; k < 4; ++k) if (k != i1 && s4[k] > v2) { v2 = s4[k]; i2 = k; }
                if (i2 < 0) i2 = (i1 + 1) & 3;
                const float t1 = i1 == 0 ? c4[0] : i1 == 1 ? c4[1] : i1 == 2 ? c4[2] : c4[3];
                const float t2 = i2 == 0 ? c4[0] : i2 == 1 ? c4[1] : i2 == 2 ? c4[2] : c4[3];
                const float inv = 1.0f / (t1 + t2);
                if ((L & 15) == 0 && !dry) {
                    const int rl = F.wave * 16 + it * 4 + (L >> 4), e1 = 4 * best + i1, e2 = 4 * best + i2;
                    const int p1 = atomicAdd((int*)(lcnt + e1), 1), p2 = atomicAdd((int*)(lcnt + e2), 1);
                    st_e[2 * rl] = e1 | (p1 << 8); st_g[2 * rl] = t1 * inv; st_e[2 * rl + 1] = e2 | (p2 << 8); st_g[2 * rl + 1] = t2 * inv;
                }
            }
        }
        __syncthreads();
        if (F.tid < 16 && !dry) gbase[F.tid] = (int)__hip_atomic_fetch_add(gcnt + F.tid, (unsigned)lcnt[F.tid], __ATOMIC_RELAXED, __HIP_MEMORY_SCOPE_AGENT);
        __syncthreads();
        if (F.tid < 256 && !dry) { const int ee = st_e[F.tid], e = ee & 255, lp = ee >> 8, pos = gbase[e] + lp;
            rowlist[(size_t)e * CAP + pos] = ((blk * 128 + (F.tid >> 1)) << 1) | (F.tid & 1); gatew[(size_t)e * CAP + pos] = st_g[F.tid]; }
    }
    __syncthreads();
}
template <bool XF32> struct Ln2Raw { typename std::conditional<XF32, f32x4, u32x2g>::type x[2][4]; unsigned ya[2][4], yb[2][4], gm[2][4]; float st[2][2]; };
template <bool XF32, bool OUTF32>
__device__ __forceinline__ void phase_ln2(Frame& F0, const float* xb, const pg8::bf16_t* gmix, const pg8::bf16_t* y2, const float* stats, const float* ln1_g, const float* ln1_b, const float* ln_g, const float* ln_b, const float* modl, const float* modn, pg8::bf16_t* H, float* xdst) {
    Frame F = F0;
    LAS float* const PRM = (LAS float*)(F.lds + RING_OFF);
    for (int blk = F.vcu; blk < T_TOK / 128; blk += F.G) {
        const int b = blk >> 4; const float* mb = modl + (size_t)b * 6144 + 5 * 1024;
        __syncthreads();
        { const int c4 = F.tid & 255;
          if (F.tid < 256) { *(LAS f32x4*)(PRM + 0 * 1024 + 4 * c4) = *(const f32x4*)(ln1_g + 4 * c4); *(LAS f32x4*)(PRM + 1 * 1024 + 4 * c4) = *(const f32x4*)(ln1_b + 4 * c4);
                             *(LAS f32x4*)(PRM + 2 * 1024 + 4 * c4) = *(const f32x4*)(mb + 4 * c4);    *(LAS f32x4*)(PRM + 3 * 1024 + 4 * c4) = *(const f32x4*)(ln_g + 4 * c4); }
          else { *(LAS f32x4*)(PRM + 4 * 1024 + 4 * c4) = *(const f32x4*)(ln_b + 4 * c4);
                 if (modn) { const float* mn = modn + (size_t)b * 6144; *(LAS f32x4*)(PRM + 5 * 1024 + 4 * c4) = *(const f32x4*)(mn + 1024 + 4 * c4) + 1.0f; *(LAS f32x4*)(PRM + 6 * 1024 + 4 * c4) = *(const f32x4*)(mn + 4 * c4); } } }
        __syncthreads();
#define LN2_PRM(a, j) (*(const LAS f32x4*)(PRM + (a) * 1024 + 4 * F.lane + 256 * (j)))
        const int rowb = blk * 128 + F.wave * 16;
        auto load2 = [&](Ln2Raw<XF32>& R, const int row0) __attribute__((always_inline)) {
#pragma unroll
            for (int q = 0; q < 2; ++q) { R.st[q][0] = stats[2 * (size_t)(row0 + q)]; R.st[q][1] = stats[2 * (size_t)(row0 + q) + 1]; }
#pragma unroll
            for (int q = 0; q < 2; ++q) {
                if constexpr (XF32) { const GAS f32x4* xr = (const GAS f32x4*)(xb + (size_t)(row0 + q) * DM) + F.lane;
#pragma unroll
                    for (int j = 0; j < 4; ++j) R.x[q][j] = xr[64 * j]; }
                else { const GAS u32x2g* xr = (const GAS u32x2g*)((const pg8::bf16_t*)xb + (size_t)(row0 + q) * DM) + F.lane;
#pragma unroll
                    for (int j = 0; j < 4; ++j) R.x[q][j] = xr[64 * j]; }
                const GAS unsigned* pa = (const GAS unsigned*)((const unsigned char*)y2 + (size_t)(row0 + q) * DM) + F.lane; const GAS unsigned* pb = (const GAS unsigned*)((const unsigned char*)y2 + ((size_t)T_TOK + row0 + q) * DM) + F.lane;
                const GAS unsigned* gr = (const GAS unsigned*)((const unsigned char*)gmix + (size_t)(row0 + q) * DM) + F.lane;
#pragma unroll
                for (int j = 0; j < 4; ++j) { R.ya[q][j] = pa[64 * j]; R.yb[q][j] = pb[64 * j]; R.gm[q][j] = gr[64 * j]; } } };
        auto norm2 = [&](const Ln2Raw<XF32>& R, const int row0) __attribute__((always_inline)) {
            f32x4 v[2][4];
#pragma unroll
            for (int j = 0; j < 4; ++j) { asm volatile("" ::: "memory"); const f32x4 l1g = LN2_PRM(0, j), l1b = LN2_PRM(1, j), g2 = LN2_PRM(2, j);
#pragma unroll
                for (int q = 0; q < 2; ++q) { const unsigned a = R.ya[q][j], c = R.yb[q][j];
                    typedef float f32x2v __attribute__((ext_vector_type(2)));
                    const f32x2v a0 = __builtin_amdgcn_cvt_pk_f32_fp8(a, false), a1 = __builtin_amdgcn_cvt_pk_f32_fp8(a, true), c0 = __builtin_amdgcn_cvt_pk_f32_fp8(c, false), c1 = __builtin_amdgcn_cvt_pk_f32_fp8(c, true);
                    f32x4 ff; ff.x = (a0[0] + c0[0]) * Y2_DESCALE; ff.y = (a0[1] + c0[1]) * Y2_DESCALE; ff.z = (a1[0] + c1[0]) * Y2_DESCALE; ff.w = (a1[1] + c1[1]) * Y2_DESCALE;
                    const f32x2v gg0 = __builtin_amdgcn_cvt_pk_f32_fp8(R.gm[q][j], false), gg1 = __builtin_amdgcn_cvt_pk_f32_fp8(R.gm[q][j], true);
                    f32x4 g4; g4.x = gg0[0] * GMIX_DESCALE; g4.y = gg0[1] * GMIX_DESCALE; g4.z = gg1[0] * GMIX_DESCALE; g4.w = gg1[1] * GMIX_DESCALE;
                    f32x4 xq;
                    if constexpr (XF32) xq = R.x[q][j];
                    else { const u32x2g w = R.x[q][j]; xq.x = __uint_as_float(w.x << 16); xq.y = __uint_as_float(w.x & 0xffff0000u); xq.z = __uint_as_float(w.y << 16); xq.w = __uint_as_float(w.y & 0xffff0000u); }
                    const f32x4 y1 = xq * DN_ALPHA + g4;
                    const f32x4 x1 = (y1 - R.st[q][0]) * R.st[q][1] * l1g + l1b;
                    v[q][j] = x1 * DN_ALPHA + g2 * ff; } }
            float mean[2], rstd[2];
#pragma unroll
            for (int q = 0; q < 2; ++q) row_stats(v[q], mean[q], rstd[q]);
#pragma unroll
            for (int j = 0; j < 4; ++j) { asm volatile("" ::: "memory"); const f32x4 lg = LN2_PRM(3, j), lb = LN2_PRM(4, j);
#pragma unroll
                for (int q = 0; q < 2; ++q) v[q][j] = (v[q][j] - mean[q]) * rstd[q] * lg + lb; }
#pragma unroll
            for (int q = 0; q < 2; ++q) { const int row = row0 + q;
                if constexpr (OUTF32) { GAS f32x4* xr = (GAS f32x4*)(xdst + (size_t)row * DM) + F.lane;
#pragma unroll
                    for (int j = 0; j < 4; ++j) xr[64 * j] = v[q][j]; }
                else store_row_bf16((pg8::bf16_t*)xdst + (size_t)row * DM, F.lane, v[q]); }
            if (modn) {
#pragma unroll
                for (int q = 0; q < 2; ++q) row_stats(v[q], mean[q], rstd[q]);
#pragma unroll
                for (int j = 0; j < 4; ++j) { asm volatile("" ::: "memory"); const f32x4 s4 = LN2_PRM(5, j), h4 = LN2_PRM(6, j);
#pragma unroll
                    for (int q = 0; q < 2; ++q) v[q][j] = (v[q][j] - mean[q]) * rstd[q] * s4 + h4; }
#pragma unroll
                for (int q = 0; q < 2; ++q) store_row_fp8((unsigned char*)H + (size_t)(row0 + q) * DM, F.lane, v[q]);
            } };
        Ln2Raw<XF32> RA, RB;
        load2(RA, rowb);
#pragma nounroll
        for (int k = 0; k < 16; k += 4) {
            load2(RB, rowb + k + 2);
            norm2(RA, rowb + k);
            if (k + 4 < 16) load2(RA, rowb + k + 4);
            norm2(RB, rowb + k + 2);
        }
#undef LN2_PRM
    }
    __syncthreads();
}
__device__ __forceinline__ void phase_combine(Frame& F0, const pg8::bf16_t* OD, const float* LSE, pg8::bf16_t* OUTB, gu32* pcnt) {
    Frame F = F0;
    const int hh = F.lane >> 4, d4 = (F.lane & 15) * 4;
    for (int blk = F.vcu; blk < T_TOK / 128; blk += F.G) {
        const int b = blk >> 4;
        for (int k = 0; k < 16; k += 8) {
            unsigned ov[8][3]; float ls[8][3];
#pragma unroll
            for (int q = 0; q < 8; ++q) { const int s = (blk & 15) * 128 + F.wave * 16 + k + q;
#pragma unroll
                for (int g = 0; g < 3; ++g) { const size_t rg = (size_t)(b * 12 + g * 4 + hh) * SEQ + pg8::pg_perm(g, s);
                    ls[q][g] = LSE[rg]; ov[q][g] = *(const GAS unsigned*)((const unsigned char*)OD + rg * 64 + d4); } }
#pragma unroll
            for (int q = 0; q < 8; ++q) { const int s = (blk & 15) * 128 + F.wave * 16 + k + q;
                const float m = fmaxf(fmaxf(ls[q][0], ls[q][1]), ls[q][2]);
                const float w0 = __builtin_amdgcn_exp2f(ls[q][0] - m), w1 = __builtin_amdgcn_exp2f(ls[q][1] - m), w2 = __builtin_amdgcn_exp2f(ls[q][2] - m), inv = 1.0f / (w0 + w1 + w2);
                float o[4];
                { typedef float f32x2v __attribute__((ext_vector_type(2)));
                  const f32x2v a0 = __builtin_amdgcn_cvt_pk_f32_fp8(ov[q][0], false), a1 = __builtin_amdgcn_cvt_pk_f32_fp8(ov[q][0], true), b0 = __builtin_amdgcn_cvt_pk_f32_fp8(ov[q][1], false), b1 = __builtin_amdgcn_cvt_pk_f32_fp8(ov[q][1], true),
                              c0 = __builtin_amdgcn_cvt_pk_f32_fp8(ov[q][2], false), c1 = __builtin_amdgcn_cvt_pk_f32_fp8(ov[q][2], true);
                  const float is_ = inv * (1.0f / attn_body::OUT_SCALE);
                  o[0] = (w0 * a0[0] + w1 * b0[0] + w2 * c0[0]) * is_; o[1] = (w0 * a0[1] + w1 * b0[1] + w2 * c0[1]) * is_;
                  o[2] = (w0 * a1[0] + w1 * b1[0] + w2 * c1[0]) * is_; o[3] = (w0 * a1[1] + w1 * b1[1] + w2 * c1[1]) * is_; }
                __hip_atomic_store((GAS unsigned*)((unsigned char*)OUTB + ((size_t)b * SEQ + s) * 768 + 512 + hh * 64 + d4), pk4_fp8(sat8(o[0] * PAB_ASCALE), sat8(o[1] * PAB_ASCALE), sat8(o[2] * PAB_ASCALE), sat8(o[3] * PAB_ASCALE)), __ATOMIC_RELAXED, __HIP_MEMORY_SCOPE_AGENT); }
        }
        VM_WAIT();
        if (F.lane == 0) (void)__hip_atomic_fetch_add(pcnt + 16 * (blk >> 1), 1u, __ATOMIC_RELAXED, __HIP_MEMORY_SCOPE_AGENT);
    }
}
__device__ __forceinline__ void moe_table(Frame& F, gu32* gcnt) {
    LAS int* tab = (LAS int*)(F.lds + MOETAB_OFF);
    __syncthreads();
    if (F.wave == 0) {
        const int ln = hw_lane(); int c = 0;
        if (ln < 16) { c = (int)__hip_atomic_load(gcnt + ln, __ATOMIC_RELAXED, __HIP_MEMORY_SCOPE_AGENT); if (c > CAP) c = CAP; if (c < 0) c = 0; }
        const int tiles = (c + 255) >> 8; int inc = tiles;
#pragma unroll
        for (int o = 1; o < 16; o <<= 1) { const int t = __shfl_up(inc, o); if (ln >= o) inc += t; }
        if (ln < 16) { tab[ln] = c; tab[16 + ln] = inc - tiles; }
        if (ln == 15) tab[32] = inc; }
    __syncthreads();
}
struct Args { const float* in[19]; float* out; unsigned char* ws; int ph_lo, ph_hi; };
typedef const __attribute__((address_space(4))) Args* KArgs;
__device__ __forceinline__ Weights layer_weights(KArgs ap_, int l) {
    struct { const float* in[19]; } a; a.in[4] = ap_->in[4]; a.in[7] = ap_->in[7]; a.in[8] = ap_->in[8]; a.in[9] = ap_->in[9]; a.in[14] = ap_->in[14]; a.in[15] = ap_->in[15]; a.in[16] = ap_->in[16];
    Weights W; W.w_in = a.in[4] + (size_t)l * 1024 * N_IN; W.w_pa = a.in[7] + (size_t)l * 512 * 1024; W.w_pb = a.in[8] + (size_t)l * 256 * 1024; W.w_o = a.in[9] + (size_t)l * 1024 * 1024;
    W.w_g = a.in[14] + (size_t)l * 16 * 1024 * 256; W.w_u = a.in[15] + (size_t)l * 16 * 1024 * 256; W.w_d = a.in[16] + (size_t)l * 16 * 256 * 1024; return W;
}
#ifndef SKIPMASK
#define SKIPMASK 0
#endif
#define IN(k) (lo <= (k) && (k) < hi)
#define SEAM(k) do { if (IN(k) && IN((k) + 1)) { XcdBarrier b2_ = bar; asm volatile("" : "+s"(b2_.x), "+s"(b2_.bar)); int w0_ = F.wave; asm volatile("" : "+s"(w0_)); REPS(20) xcd_barrier(b2_, w0_ == 0 && hw_lane() == 0); } } while (0)
#ifndef PROBE_DUP
#define PROBE_DUP -1
#endif
#define REPS(k) _Pragma("unroll") for (int rep_ = 0; rep_ < ((PROBE_DUP) == (k) ? 2 : 1); ++rep_)
#define PHASE_ARGS KArgs ap = kargs; int bx_ = (int)blockIdx.x; Frame FF = F; asm volatile("" : "+s"(ap), "+s"(bx_), "+s"(FF.G), "+s"(FF.vcu), "+s"(FF.wave)); FF.lane = hw_lane(); FF.tid = FF.wave * 64 + FF.lane; unsigned char* const ws = ap->ws; (void)ws; (void)bx_
template <int l>
__device__ __forceinline__ void layer_phases(Frame& F, const KArgs kargs, const int lo, const int hi, const XcdBarrier& bar, unsigned char* lds) {
    using pg8::bf16_t;
    const LAS int* tab = (const LAS int*)(F.lds + MOETAB_OFF);
    {
        const int P = 2 + PPL * l;
        if (IN(P + 0)) {
            PHASE_ARGS;
            pg8::Gemm g{(const bf16_t*)(ws + WS_H), (const bf16_t*)(ws + WS_WIN), T_TOK, N_IN, 1024}; pg8::StaticOrder S; S.init(T_TOK, N_IN, FF.G, bx_);
            pg8::EpiIn E{(bf16_t*)(ws + WS_QA), (bf16_t*)(ws + WS_KA), (bf16_t*)(ws + WS_VA), (bf16_t*)(ws + WS_QD), (bf16_t*)(ws + WS_KD), (bf16_t*)(ws + WS_VDT), (bf16_t*)(ws + WS_G),
                         ap->in[5] + l * 64, ap->in[6] + l * 64, (const float*)(ws + WS_ROPE)};
#ifdef IN_STAGGER
            { const unsigned long long t0_ = __builtin_amdgcn_s_memrealtime(), dl_ = (unsigned long long)(FF.vcu & 3) * IN_STAGGER;
              while (__builtin_amdgcn_s_memrealtime() - t0_ < dl_) __builtin_amdgcn_s_sleep(8); }
#endif
            REPS(0) { pg8::gemm_phase<pg8::EpiIn, pg8::StaticOrder, true, false, true>(F.lds + RING_OFF, g, S, E, FF.wave);
#ifdef PROBE_BAR
              if (rep_ == 0) { XcdBarrier b3_ = bar; asm volatile("" : "+s"(b3_.x), "+s"(b3_.bar)); xcd_barrier(b3_, FF.wave == 0 && hw_lane() == 0); }
#endif
            }
            SEAM(P + 0);
        }
        if (IN(P + 1)) {
            PHASE_ARGS;
            { const attn_body::AttnTensors BT{(const attn_body::bf16*)(ws + WS_QD), (const attn_body::bf16*)(ws + WS_KD), (const attn_body::bf16*)(ws + WS_VDT), (attn_body::bf16*)(ws + WS_QD), ws + WS_H + 24 * MiB};
              const attn_body::OrderB S{FF.vcu, FF.G, BT, (float*)(ws + WS_LSE)};
              attn_body::attn_phase<attn_body::CfgB, attn_body::OrderB>((char*)lds + RING_OFF, S, FF.wave); }
            { const attn_body::AttnTensors AT{(const attn_body::bf16*)(ws + WS_QA), (const attn_body::bf16*)(ws + WS_KA), (const attn_body::bf16*)(ws + WS_VA), (attn_body::bf16*)(ws + WS_QA), ws + WS_H};
              const attn_body::OrderA S{FF.vcu, FF.G, AT};
              attn_body::attn_phase<attn_body::CfgA, attn_body::OrderA>((char*)lds + RING_OFF, S, FF.wave); }
            SEAM(P + 1);
        }
        if (IN(P + 2)) {
            PHASE_ARGS;
            gu32* const pcnt = F.ctl + CW_PANEL + 2048 * l;
            phase_combine(FF, (const bf16_t*)(ws + WS_H + 24 * MiB), (const float*)(ws + WS_LSE), (bf16_t*)(ws + WS_H), pcnt);
            { pg8::StaticOrder S; S.init(T_TOK, 1024, FF.G, bx_);
              if (FF.wave == 0) {
                  pg8::Unit u; unsigned sp = 0;
                  for (int i = 0; S.next(i, u); ++i)
                      while (__builtin_amdgcn_readfirstlane((int)__hip_atomic_load(pcnt + 16 * u.pm, __ATOMIC_RELAXED, __HIP_MEMORY_SCOPE_AGENT)) < 16) { __builtin_amdgcn_s_sleep(2); if (++sp > (1u << 22)) break; } }
              VM_WAIT(); __builtin_amdgcn_fence(__ATOMIC_ACQUIRE, "agent"); VM_WAIT(); __syncthreads();
              pg8::Gemm g{(const bf16_t*)(ws + WS_H), (const bf16_t*)(ws + WS_WPA), T_TOK, 1024, 768};
              pg8::EpiMergeF E{(const bf16_t*)(ws + WS_G), (bf16_t*)(ws + WS_MERGED)};
              pg8::gemm_phase<pg8::EpiMergeF, pg8::StaticOrder, true, false, true, true>(F.lds + RING_OFF, g, S, E, FF.wave); }
            SEAM(P + 2);
        }
        if (IN(P + 4)) {
            PHASE_ARGS;
            pg8::Gemm g{(const bf16_t*)(ws + WS_MERGED), (const bf16_t*)(ws + WS_WO), T_TOK, 1024, 1024}; pg8::StaticOrder S; S.init(T_TOK, 1024, FF.G, bx_);
            REPS(3) { pg8::EpiRes E{(bf16_t*)(ws + WS_GMIX), (const float*)(ws + WS_MOD) + (size_t)l * 16 * 6144 + 2 * 1024};
            pg8::gemm_phase<pg8::EpiRes, pg8::StaticOrder, true, false, true>(F.lds + RING_OFF, g, S, E, FF.wave); }
            SEAM(P + 4);
        }
        if (IN(P + 5)) {
            PHASE_ARGS;
            if ((PROBE_DUP) == 40) { phase_ln1<l == 0>(FF, l == 0 ? ap->in[0] : (const float*)(ws + WS_XS), (const bf16_t*)(ws + WS_GMIX), ap->in[10] + l * 1024, ap->in[11] + l * 1024, (const float*)(ws + WS_MOD) + (size_t)l * 16 * 6144, ap->in[12], ap->in[13], (bf16_t*)(ws + WS_QD),
                      (int*)(ws + WS_ROWLIST), (float*)(ws + WS_GATEW), F.ctl + CW_GCNT + 64 * l, (float*)(ws + WS_LSE), true); VM_WAIT(); __syncthreads(); }
            phase_ln1<l == 0>(FF, l == 0 ? ap->in[0] : (const float*)(ws + WS_XS), (const bf16_t*)(ws + WS_GMIX), ap->in[10] + l * 1024, ap->in[11] + l * 1024, (const float*)(ws + WS_MOD) + (size_t)l * 16 * 6144, ap->in[12], ap->in[13], (bf16_t*)(ws + WS_H),
                      (int*)(ws + WS_ROWLIST), (float*)(ws + WS_GATEW), F.ctl + CW_GCNT + 64 * l, (float*)(ws + WS_STATS));
            SEAM(P + 5);
        }
        if (IN(P + 6)) {
            PHASE_ARGS;
            moe_table(FF, F.ctl + CW_GCNT + 64 * l);
            pg8::Gemm g{(const bf16_t*)(ws + WS_H), (const bf16_t*)(ws + WS_WGU), T_TOK, 512, 1024};
            pg8::MoeOrder<true> S{tab, (const int*)(ws + WS_ROWLIST), 2, FF.G, bx_};
            pg8::EpiGU E{(bf16_t*)(ws + WS_ACT), (const float*)(ws + WS_GATEW), tab};
            REPS(5) pg8::gemm_phase<pg8::EpiGU, pg8::MoeOrder<true>, true, true, true>(F.lds + RING_OFF, g, S, E, FF.wave);
            SEAM(P + 6);
        }
        if (IN(P + 7)) {
            PHASE_ARGS;
            moe_table(FF, F.ctl + CW_GCNT + 64 * l);
            pg8::Gemm g{(const bf16_t*)(ws + WS_ACT), (const bf16_t*)(ws + WS_WDN), T_TOK, 1024, 256};
            pg8::MoeOrder<false> S{tab, (const int*)(ws + WS_ROWLIST), 4, FF.G, bx_};
            pg8::EpiDown E{(bf16_t*)(ws + WS_Y2), (const int*)(ws + WS_ROWLIST), tab};
            REPS(6) { pg8::gemm_phase<pg8::EpiDown, pg8::MoeOrder<false>, true, false, true>(F.lds + RING_OFF, g, S, E, FF.wave); VM_WAIT(); __syncthreads(); }
            SEAM(P + 7);
        }
        if (IN(P + 8)) {
            PHASE_ARGS;
            const float* modl = (const float*)(ws + WS_MOD) + (size_t)l * 16 * 6144;
            if ((PROBE_DUP) == 41) { phase_ln2<l == 0, true>(FF, l == 0 ? ap->in[0] : (const float*)(ws + WS_XS), (const bf16_t*)(ws + WS_GMIX), (const bf16_t*)(ws + WS_Y2), (const float*)(ws + WS_STATS), ap->in[10] + l * 1024, ap->in[11] + l * 1024, ap->in[17] + l * 1024, ap->in[18] + l * 1024, modl, l + 1 < DEPTH ? modl + 16 * 6144 : nullptr, (bf16_t*)(ws + WS_OUTB), (float*)(ws + WS_QA)); VM_WAIT(); __syncthreads(); }
            phase_ln2<l == 0, l + 1 == DEPTH>(FF, l == 0 ? ap->in[0] : (const float*)(ws + WS_XS), (const bf16_t*)(ws + WS_GMIX), (const bf16_t*)(ws + WS_Y2), (const float*)(ws + WS_STATS), ap->in[10] + l * 1024, ap->in[11] + l * 1024, ap->in[17] + l * 1024, ap->in[18] + l * 1024, modl, l + 1 < DEPTH ? modl + 16 * 6144 : nullptr, (bf16_t*)(ws + WS_H), l + 1 == DEPTH ? ap->out : (float*)(ws + WS_XS));
            if (l + 1 < DEPTH) { __syncthreads(); const Weights Wn = layer_weights(ap, l + 1); REPS(7) convert_layer(FF, Wn, ws); }
            SEAM(P + 8);
        }
    }
}
__global__ void __launch_bounds__(NWAVES * 64, 2) fwd_kernel(Args args_unused) {
    extern __shared__ __attribute__((aligned(16))) unsigned char lds[];
    Frame F;
    F.lds = (LAS unsigned char*)lds;
    F.MISC = (volatile LAS unsigned*)(F.lds + MISC_OFF);
    F.wave = __builtin_amdgcn_readfirstlane((int)threadIdx.x >> 6); F.lane = hw_lane(); F.tid = F.wave * 64 + F.lane;
    F.G = gridDim.x; { const int bx = blockIdx.x; F.vcu = (F.G % 8 == 0) ? (bx % 8) * (F.G / 8) + bx / 8 : bx; }
    const KArgs kargs = (KArgs)__builtin_amdgcn_kernarg_segment_ptr();
    F.ctl = (gu32*)(kargs->ws + WS_CTL);
    for (int u = F.tid; u < (LDS_BYTES - LDSCTL_OFF) / 4; u += NWAVES * 64) ((LAS unsigned*)(F.lds + LDSCTL_OFF))[u] = 0u;
    __syncthreads();
    const int lo = kargs->ph_lo, hi = kargs->ph_hi;
    XcdBarrier bar; bar.bar = (unsigned*)(F.ctl + CW_BAR); bar.x = 0; bar.st = nullptr;
    if (hi - lo > 1) bar = xcd_barrier_post((unsigned*)(F.ctl + CW_BAR), F.MISC + 8);
    using pg8::bf16_t;
    const LAS int* tab = (const LAS int*)(F.lds + MOETAB_OFF);

    if (IN(0)) { PHASE_ARGS; const Weights W0 = layer_weights(ap, 0); REPS(30) { phase_pr0(FF, ap->in[1], ap->in[2], ap->in[3], (float*)(ws + WS_MOD), (float*)(ws + WS_ROPE), W0, ws); VM_WAIT(); __syncthreads(); } SEAM(0); }
    if (IN(1)) { PHASE_ARGS; REPS(31) phase_pr1(FF, ap->in[0], (const float*)(ws + WS_MOD), (bf16_t*)(ws + WS_H)); SEAM(1); }

    layer_phases<0>(F, kargs, lo, hi, bar, lds); layer_phases<1>(F, kargs, lo, hi, bar, lds); layer_phases<2>(F, kargs, lo, hi, bar, lds); layer_phases<3>(F, kargs, lo, hi, bar, lds);
#undef IN
#undef SEAM
#undef PHASE_ARGS
}

extern "C" void kernel_launch(void* const* d_in, const int* in_sizes, int n_in, void* d_out, int out_size, void* d_ws, size_t ws_size, hipStream_t stream) {
    static int grid = 0;
    if (grid == 0) {
        if (n_in != 19 || in_sizes[0] != T_TOK * DM || out_size != T_TOK * DM || ws_size < WS_END) { fprintf(stderr, "kernel_launch: unexpected shapes/workspace (n_in %d, ws %zu); nothing launched\n", n_in, ws_size); grid = -1; return; }
        int dev = 0, cus = 0, per_cu = 0;
        if (hipGetDevice(&dev) != hipSuccess || hipDeviceGetAttribute(&cus, hipDeviceAttributeMultiprocessorCount, dev) != hipSuccess) { grid = -1; return; }
        if (hipFuncSetAttribute((const void*)fwd_kernel, hipFuncAttributeMaxDynamicSharedMemorySize, LDS_BYTES) != hipSuccess) { fprintf(stderr, "kernel_launch: hipFuncSetAttribute failed\n"); grid = -1; return; }
        if (hipOccupancyMaxActiveBlocksPerMultiprocessor(&per_cu, (const void*)fwd_kernel, NWAVES * 64, LDS_BYTES) != hipSuccess || per_cu < 1) { fprintf(stderr, "kernel_launch: occupancy query reports %d\n", per_cu); }
        (void)hipGetLastError();
        grid = cus;
    }
    if (grid < 0) return;
    if (hipMemsetAsync((char*)d_ws + WS_CTL, 0, CTL_ZERO_BYTES, stream) != hipSuccess) return;
    Args a{};
    for (int i = 0; i < 19; ++i) a.in[i] = (const float*)d_in[i];
    a.out = (float*)d_out; a.ws = (unsigned char*)d_ws;
#if MK_N_LAUNCHES == 1
    a.ph_lo = 0; a.ph_hi = N_PHASES;
    hipLaunchKernelGGL(fwd_kernel, dim3(grid), dim3(NWAVES * 64), LDS_BYTES, stream, a);
#else
    for (int p = 0; p < N_PHASES; ++p) { a.ph_lo = p; a.ph_hi = p + 1; hipLaunchKernelGGL(fwd_kernel, dim3(grid), dim3(NWAVES * 64), LDS_BYTES, stream, a); }
#endif
}
```

```cpp
#include <hip/hip_runtime.h>
#include <hip/hip_bf16.h>
#include <cstdio>
#include <cstdint>
#include <cmath>
__device__ __forceinline__ int hw_lane() { int l; asm volatile("v_mbcnt_lo_u32_b32 %0, -1, 0\n\tv_mbcnt_hi_u32_b32 %0, -1, %0" : "=v"(l)); return l; }
namespace pg8 {
#define PG8_LAS __attribute__((address_space(3)))
typedef unsigned short bf16_t;
typedef short bf16x8 __attribute__((ext_vector_type(8)));
typedef float f32x4 __attribute__((ext_vector_type(4)));
typedef unsigned u32x4 __attribute__((ext_vector_type(4)));
typedef unsigned u32x2 __attribute__((ext_vector_type(2)));
typedef int i32x4 __attribute__((ext_vector_type(4)));
typedef int i32x8 __attribute__((ext_vector_type(8)));
constexpr int BM = 256, BK = 64, HALF = 128, HTB = HALF * BK * 2  , STAGE_BYTES = 8 * HTB, NXCD = 8, WGM = 8;

__host__ __device__ __forceinline__ int lds_byte(int r, int c) { const int st = (r >> 4) * 2 + (c >> 5), rr = r & 15, cc = c & 31, ob = rr * 64 + cc * 2; return st * 1024 + (ob ^ (((ob >> 9) & 1) << 5)); }
__host__ __device__ __forceinline__ void stage_rc(int b, int& R, int& C) { const int st = b / 1024, sb = b % 1024, swz = sb ^ (((sb >> 9) & 1) << 5); R = (st >> 1) * 16 + swz / 64; C = (st & 1) * 32 + (swz % 64) / 2; }

struct Unit { int pm, pn, e, lt; };
struct Gemm { const bf16_t* A; const bf16_t* Bt; int M, N, K; };

struct StaticOrder {
    int nM, nN, nwg, G, c;
    __host__ __device__ void init(int M, int N, int G_, int c_) { nM = M / BM; nN = N / BM; nwg = nM * nN; G = G_; c = c_; }
    __host__ __device__ bool next(int i, Unit& u) const {
        const long L = (long)i * G + c; if (L >= nwg) return false;
        int wgid = (int)L; { const int q = nwg / NXCD, r = nwg % NXCD, xcd = wgid % NXCD, off = wgid / NXCD; wgid = (xcd < r ? xcd * (q + 1) : r * (q + 1) + (xcd - r) * q) + off; }
        const int nig = WGM * nN, gid = wgid / nig, fm = gid * WGM, gsz = (nM - fm) < WGM ? (nM - fm) : WGM;
        u.pm = fm + ((wgid % nig) % gsz); u.pn = (wgid % nig) / gsz; u.e = 0; u.lt = 0; return true;
    }
    __device__ __forceinline__ int arow(const Unit& u, int R) const { return u.pm * BM + R; }
};

__device__ __forceinline__ unsigned cvt_pk_bf16(float lo, float hi) { unsigned r; asm volatile("v_cvt_pk_bf16_f32 %0, %1, %2" : "=v"(r) : "v"(lo), "v"(hi)); return r; }

template <class Epi, class Sched, bool ALIGN_EPI, bool GATHER = false, bool FP8 = false, bool MID = false>
__device__ __forceinline__ void gemm_phase(PG8_LAS unsigned char* lds, const Gemm g, const Sched& S, const Epi& E, const int wave) {
    const int lane = hw_lane(), wid = wave, tid = wid * 64 + lane,
              wr = wid >> 2, wc = wid & 3, fr = lane & 15, fq = lane >> 4;
    const int K = g.K, RB = FP8 ? K : 2 * K  , nt = RB / (BK * 2);
    unsigned voffB[2];
#pragma unroll
    for (int i = 0; i < 2; ++i) { int R_, C_; stage_rc(tid * 16 + i * 8192, R_, C_); voffB[i] = (unsigned)(R_ * RB + C_ * 2); }
    const size_t kstep = (size_t)(BK * 2);
    const size_t hstep = (size_t)HALF * RB;
    const size_t tstep = 2 * hstep;
    const unsigned ldsw = (unsigned)wid * 1024u;
    const int aoff = lds_byte(wr * 64 + fr, fq * 8), boff = lds_byte(wc * 32 + fr, fq * 8);
#define PG8_SA(b, h) (((b) * 2 + (h)) * HTB)
#define PG8_SB(b, h) ((4 + (b) * 2 + (h)) * HTB)
#define PG8_STAGE(bufoff, gbase, voff) do { _Pragma("unroll") for (int _i = 0; _i < 2; ++_i) \
        __builtin_amdgcn_global_load_lds((const unsigned*)((const char*)(gbase) + (voff)[_i]), (PG8_LAS unsigned*)(lds + (bufoff) + ldsw + _i * 8192), 16, 0, 0); } while (0)
#define PG8_LDA(dst, b, h) do { _Pragma("unroll") for (int m = 0; m < 4; ++m) { if constexpr (FP8) { \
            const i32x4 l0_ = *(const PG8_LAS i32x4*)(lds + PG8_SA(b, h) + aoff + m * 2048), l1_ = *(const PG8_LAS i32x4*)(lds + PG8_SA(b, h) + aoff + m * 2048 + 1024); \
            dst##8[m] = __builtin_shufflevector(l0_, l1_, 0, 1, 2, 3, 4, 5, 6, 7); } \
        else { _Pragma("unroll") for (int k = 0; k < 2; ++k) dst[m][k] = *(const PG8_LAS bf16x8*)(lds + PG8_SA(b, h) + aoff + m * 2048 + k * 1024); } } } while (0)
#define PG8_LDB(dst, b, h) do { _Pragma("unroll") for (int n = 0; n < 2; ++n) { if constexpr (FP8) { \
            const i32x4 l0_ = *(const PG8_LAS i32x4*)(lds + PG8_SB(b, h) + boff + n * 2048), l1_ = *(const PG8_LAS i32x4*)(lds + PG8_SB(b, h) + boff + n * 2048 + 1024); \
            dst##8[n] = __builtin_shufflevector(l0_, l1_, 0, 1, 2, 3, 4, 5, 6, 7); } \
        else { _Pragma("unroll") for (int k = 0; k < 2; ++k) dst[n][k] = *(const PG8_LAS bf16x8*)(lds + PG8_SB(b, h) + boff + n * 2048 + k * 1024); } } } while (0)
#define PG8_MMA(ai, bj, At, Bt) do { __builtin_amdgcn_s_setprio(1); _Pragma("unroll") for (int m = 0; m < 4; ++m) _Pragma("unroll") for (int n = 0; n < 2; ++n) { \
        if constexpr (FP8) { asm volatile("v_mfma_f32_16x16x128_f8f6f4 %0, %1, %2, %0" : "+v"(acc[ai][bj][m][n]) : "v"(Bt##8[n]), "v"(At##8[m])); }   \
        else { _Pragma("unroll") for (int k = 0; k < 2; ++k) acc[ai][bj][m][n] = __builtin_amdgcn_mfma_f32_16x16x32_bf16(Bt[n][k], At[m][k], acc[ai][bj][m][n], 0, 0, 0); } } \
        __builtin_amdgcn_s_setprio(0); } while (0)
#define PG8_WAIT_V(n) asm volatile("s_waitcnt vmcnt(" #n ")" ::: "memory")
#define PG8_WAIT_V8R(rx) do { if (rx) PG8_WAIT_V(24); else PG8_WAIT_V(8); } while (0)
#define PG8_WAIT_L(n) asm volatile("s_waitcnt lgkmcnt(" #n ")" ::: "memory")
#define PG8_BAR __builtin_amdgcn_s_barrier()
#define PG8_SCHED __builtin_amdgcn_sched_barrier(0)
#define PG8_AOFF(dst, u) do { if constexpr (GATHER) { _Pragma("unroll") for (int _h = 0; _h < 2; ++_h) _Pragma("unroll") for (int _i = 0; _i < 2; ++_i) { int R_, C_; stage_rc(tid * 16 + _i * 8192, R_, C_); \
        dst[_h][_i] = (unsigned)S.arow(u, _h * HALF + R_) * (unsigned)RB + (unsigned)(C_ * 2); } } } while (0)
#define PG8_STAGE_A(bufoff, base, h, NXT) do { if constexpr (GATHER) { if (NXT) PG8_STAGE(bufoff, base, o2[h]); else PG8_STAGE(bufoff, base, voA[h]); } else { PG8_STAGE(bufoff, (base) + (h) * hstep, voffB); } } while (0)
    Unit cur, nxt; int ui = 0; bool relax = false;
    if (!S.next(0, cur)) return;
    f32x4 acc[2][2][4][2];
#pragma unroll
    for (int a = 0; a < 2; ++a)
#pragma unroll
        for (int b = 0; b < 2; ++b)
#pragma unroll
            for (int m = 0; m < 4; ++m)
#pragma unroll
                for (int n = 0; n < 2; ++n) acc[a][b][m][n] = (f32x4){0.f, 0.f, 0.f, 0.f};
    bf16x8 At[4][2], B0[2][2], B1[2][2];
    i32x8 At8[4], B08[2], B18[2];
    unsigned voA[2][2], voN[2][2], o2[2][2];
    PG8_AOFF(voA, cur);
    const char* cA = GATHER ? (const char*)g.A : (const char*)g.A + (size_t)cur.pm * tstep;
    const char* cB = (const char*)g.Bt + (size_t)cur.pn * tstep;
    PG8_STAGE(PG8_SB(0, 0), cB, voffB); PG8_STAGE(PG8_SB(0, 1), cB + hstep, voffB); PG8_STAGE_A(PG8_SA(0, 0), cA, 0, 0); PG8_STAGE_A(PG8_SA(0, 1), cA, 1, 0);
    if (wr == 1) PG8_BAR;
    PG8_WAIT_V(2); PG8_BAR;
    PG8_STAGE(PG8_SB(1, 0), cB + kstep, voffB); PG8_STAGE_A(PG8_SA(1, 0), cA + kstep, 0, 0); PG8_STAGE(PG8_SB(1, 1), cB + hstep + kstep, voffB);
    PG8_WAIT_V(6); PG8_BAR;
    for (;;) {
        const bool has_next = S.next(ui + 1, nxt);
        if constexpr (GATHER) {
            if (has_next) { PG8_AOFF(voN, nxt); }
            else {
#pragma unroll
                for (int _h = 0; _h < 2; ++_h) { voN[_h][0] = voA[_h][0]; voN[_h][1] = voA[_h][1]; } } }
        const char* nA = (GATHER || !has_next) ? cA : (const char*)g.A + (size_t)nxt.pm * tstep;
        const char* nB = has_next ? (const char*)g.Bt + (size_t)nxt.pn * tstep : cB;
#pragma nounroll
        for (int t = 0; t < nt; t += 2) {
            const bool last = (t == nt - 2);
            const char* a1 = cA + (size_t)(t + 1) * kstep;
            const char* a2 = last ? nA : cA + (size_t)(t + 2) * kstep; const char* b2 = last ? nB : cB + (size_t)(t + 2) * kstep;
            const char* a3 = a2 + kstep; const char* b3 = b2 + kstep;
            if constexpr (GATHER) {
#pragma unroll
                for (int _h = 0; _h < 2; ++_h) { o2[_h][0] = last ? voN[_h][0] : voA[_h][0]; o2[_h][1] = last ? voN[_h][1] : voA[_h][1]; } }
            if constexpr (MID) { if (t == Epi::MID_T) { E.mid(acc, cur, wr, wc, fr, fq); PG8_SCHED; } }
            const bool rx = relax && t == 0;
            PG8_LDB(B0, 0, 0); PG8_LDB(B1, 0, 1); PG8_SCHED; PG8_LDA(At, 0, 0); PG8_STAGE_A(PG8_SA(1, 1), a1, 1, 0);
            PG8_WAIT_V8R(rx); PG8_WAIT_L(0); PG8_BAR; PG8_MMA(0, 0, At, B0); PG8_MMA(0, 1, At, B1); PG8_BAR; PG8_SCHED;
            PG8_LDA(At, 0, 1); PG8_STAGE(PG8_SB(0, 0), b2, voffB); PG8_STAGE(PG8_SB(0, 1), b2 + hstep, voffB); PG8_STAGE_A(PG8_SA(0, 0), a2, 0, 1);
            PG8_WAIT_V8R(rx); PG8_WAIT_L(0); PG8_BAR; PG8_MMA(1, 0, At, B0); PG8_MMA(1, 1, At, B1); PG8_BAR; PG8_SCHED;
            PG8_LDB(B0, 1, 0); PG8_LDB(B1, 1, 1); PG8_SCHED; PG8_LDA(At, 1, 0); PG8_STAGE_A(PG8_SA(0, 1), a2, 1, 1);
            PG8_WAIT_V(8); PG8_WAIT_L(0); PG8_BAR; PG8_MMA(0, 0, At, B0); PG8_MMA(0, 1, At, B1); PG8_BAR; PG8_SCHED;
            PG8_LDA(At, 1, 1); PG8_STAGE(PG8_SB(1, 0), b3, voffB); PG8_STAGE(PG8_SB(1, 1), b3 + hstep, voffB); PG8_STAGE_A(PG8_SA(1, 0), a3, 0, 1);
            PG8_WAIT_V(8); PG8_WAIT_L(0); PG8_BAR; PG8_MMA(1, 0, At, B0); PG8_MMA(1, 1, At, B1); PG8_BAR; PG8_SCHED;
        }
        if constexpr (ALIGN_EPI) { if (wr == 0) PG8_BAR; }
        E(acc, cur, wr, wc, fr, fq); relax = Epi::leaves16(cur);
#ifdef PROBE_EPI2
        if constexpr (Epi::PROBE_TWICE) E(acc, cur, wr, wc, fr, fq);
#endif
        if (!has_next) break;
#pragma unroll
        for (int a = 0; a < 2; ++a)
#pragma unroll
            for (int b = 0; b < 2; ++b)
#pragma unroll
                for (int m = 0; m < 4; ++m)
#pragma unroll
                    for (int n = 0; n < 2; ++n) acc[a][b][m][n] = (f32x4){0.f, 0.f, 0.f, 0.f};
        cur = nxt; cA = nA; cB = nB; ++ui;
        if constexpr (GATHER) {
#pragma unroll
            for (int _h = 0; _h < 2; ++_h) { voA[_h][0] = voN[_h][0]; voA[_h][1] = voN[_h][1]; } }
        if constexpr (ALIGN_EPI) { if (wr == 1) PG8_BAR; }
    }
    PG8_WAIT_V(0);
    if constexpr (!ALIGN_EPI) { if (wr == 0) PG8_BAR; }
    PG8_BAR;
#undef PG8_SA
#undef PG8_SB
#undef PG8_STAGE
#undef PG8_LDA
#undef PG8_LDB
#undef PG8_MMA
#undef PG8_WAIT_V
#undef PG8_WAIT_V8R
#undef PG8_WAIT_L
#undef PG8_BAR
#undef PG8_SCHED
#undef PG8_AOFF
#undef PG8_STAGE_A
}
}
constexpr int T_TOK = 32768, SEQ = 2048, DM = 1024, NB = 16, DEPTH = 4;
constexpr int N_IN = 5120, CAP = 32768;
constexpr float C2F = 0.125f * 1.4426950408889634f;
constexpr float DN_ALPHA = 1.681792830507429f;
constexpr float LN_EPS = 1e-5f, RMS_EPS = 1e-6f;
constexpr float IN_DESCALE = 1.0f / (16.0f * 256.0f);
constexpr float GU_WSCALE = 256.0f, GU_DESCALE = 1.0f / (16.0f * 256.0f), ACT_SCALE = 16.0f, DN_WSCALE = 1024.0f, DN_DESCALE = 1.0f / (16.0f * 1024.0f);
constexpr float PAB_ASCALE = 32.0f, PAB_WSCALE = 256.0f, PAB_DESCALE = 1.0f / (32.0f * 256.0f);
constexpr float GMIX_SCALE = 512.0f, GMIX_DESCALE = 1.0f / 512.0f;
constexpr float Y2_SCALE = 128.0f, Y2_DESCALE = 1.0f / 128.0f;
constexpr float GATE_SCALE = 128.0f, GATE_DESCALE = 1.0f / 128.0f;
constexpr float MERGED_SCALE = 64.0f, WO_SCALE = 2048.0f, WO_DESCALE = 1.0f / (64.0f * 2048.0f);

#ifndef PROBE_SCALE_A
#define PROBE_SCALE_A 1.0f
#endif
#ifndef PROBE_SCALE_B
#define PROBE_SCALE_B 1.0f
#endif
namespace pg8 {
__device__ __forceinline__ float bf2f(unsigned short b) { return __uint_as_float((unsigned)b << 16); }
__device__ __forceinline__ float bflo(unsigned w) { return __uint_as_float(w << 16); }
__device__ __forceinline__ float bfhi(unsigned w) { return __uint_as_float(w & 0xffff0000u); }
__device__ __forceinline__ float sat8e(float x) { return __builtin_amdgcn_fmed3f(x, -448.0f, 448.0f); }
__device__ __forceinline__ unsigned pk4_fp8e(float a, float b, float c, float d) { unsigned w = 0; w = __builtin_amdgcn_cvt_pk_fp8_f32(sat8e(a), sat8e(b), w, false); w = __builtin_amdgcn_cvt_pk_fp8_f32(sat8e(c), sat8e(d), w, true); return w; }
__device__ __forceinline__ float sigmoidf_(float x) { return __builtin_amdgcn_rcpf(1.f + __expf(-x)); }
__device__ __forceinline__ void sigmoid16(float (&v)[16]) {
#pragma unroll
    for (int q = 0; q < 4; ++q) {
        const float a = 1.f + __expf(-v[4 * q]), b = 1.f + __expf(-v[4 * q + 1]), c = 1.f + __expf(-v[4 * q + 2]), d = 1.f + __expf(-v[4 * q + 3]);
        const float ab = a * b, cd = c * d;
        if (ab * cd < 1e30f) { const float r = __builtin_amdgcn_rcpf(ab * cd) * GATE_SCALE, rcd = r * cd, rab = r * ab;
            v[4 * q] = rcd * b; v[4 * q + 1] = rcd * a; v[4 * q + 2] = rab * d; v[4 * q + 3] = rab * c; }
        else { v[4 * q] = GATE_SCALE * __builtin_amdgcn_rcpf(a); v[4 * q + 1] = GATE_SCALE * __builtin_amdgcn_rcpf(b); v[4 * q + 2] = GATE_SCALE * __builtin_amdgcn_rcpf(c); v[4 * q + 3] = GATE_SCALE * __builtin_amdgcn_rcpf(d); }
    }
}
__device__ __forceinline__ void store16(bf16_t* dst, const float (&v)[16]) {
    u32x4 w0, w1;
    w0.x = cvt_pk_bf16(v[0], v[1]); w0.y = cvt_pk_bf16(v[2], v[3]); w0.z = cvt_pk_bf16(v[4], v[5]); w0.w = cvt_pk_bf16(v[6], v[7]);
    w1.x = cvt_pk_bf16(v[8], v[9]); w1.y = cvt_pk_bf16(v[10], v[11]); w1.z = cvt_pk_bf16(v[12], v[13]); w1.w = cvt_pk_bf16(v[14], v[15]);
#ifdef NT_STORES
    __builtin_nontemporal_store(w0, (u32x4*)dst); __builtin_nontemporal_store(w1, (u32x4*)(dst + 32));
#else
    *(u32x4*)dst = w0; *(u32x4*)(dst + 32) = w1;
#endif
}
__device__ __forceinline__ void load16bf(const bf16_t* src, float (&v)[16]) {
    const u32x4 w0 = *(const u32x4*)src, w1 = *(const u32x4*)(src + 32);
    v[0] = bflo(w0.x); v[1] = bfhi(w0.x); v[2] = bflo(w0.y); v[3] = bfhi(w0.y); v[4] = bflo(w0.z); v[5] = bfhi(w0.z); v[6] = bflo(w0.w); v[7] = bfhi(w0.w);
    v[8] = bflo(w1.x); v[9] = bfhi(w1.x); v[10] = bflo(w1.y); v[11] = bfhi(w1.y); v[12] = bflo(w1.z); v[13] = bfhi(w1.z); v[14] = bflo(w1.w); v[15] = bfhi(w1.w);
}
__device__ __forceinline__ void load16f8(const unsigned char* src, float (&v)[16]) {
    const u32x2 w0 = *(const u32x2*)src, w1 = *(const u32x2*)(src + 32);
    typedef float f32x2v __attribute__((ext_vector_type(2)));
#pragma unroll
    for (int h = 0; h < 2; ++h) { const u32x2 w = h ? w1 : w0;
        const f32x2v a = __builtin_amdgcn_cvt_pk_f32_fp8(w.x, false), b = __builtin_amdgcn_cvt_pk_f32_fp8(w.x, true), c = __builtin_amdgcn_cvt_pk_f32_fp8(w.y, false), d = __builtin_amdgcn_cvt_pk_f32_fp8(w.y, true);
        v[8 * h] = a[0] * GATE_DESCALE; v[8 * h + 1] = a[1] * GATE_DESCALE; v[8 * h + 2] = b[0] * GATE_DESCALE; v[8 * h + 3] = b[1] * GATE_DESCALE;
        v[8 * h + 4] = c[0] * GATE_DESCALE; v[8 * h + 5] = c[1] * GATE_DESCALE; v[8 * h + 6] = d[0] * GATE_DESCALE; v[8 * h + 7] = d[1] * GATE_DESCALE; }
}
__device__ __forceinline__ void store16f8c(unsigned char* dst, const float (&v)[16]) {
    u32x4 w; w.x = pk4_fp8e(v[0], v[1], v[2], v[3]); w.y = pk4_fp8e(v[4], v[5], v[6], v[7]); w.z = pk4_fp8e(v[8], v[9], v[10], v[11]); w.w = pk4_fp8e(v[12], v[13], v[14], v[15]);
    *(u32x4*)dst = w;
}
__device__ __forceinline__ void load16f8c(const unsigned char* src, float (&v)[16]) {
    const u32x4 w = *(const u32x4*)src;
    typedef float f32x2v __attribute__((ext_vector_type(2)));
#pragma unroll
    for (int h = 0; h < 4; ++h) { const unsigned x = w[h];
        const f32x2v a = __builtin_amdgcn_cvt_pk_f32_fp8(x, false), b = __builtin_amdgcn_cvt_pk_f32_fp8(x, true);
        v[4 * h] = a[0] * GATE_DESCALE; v[4 * h + 1] = a[1] * GATE_DESCALE; v[4 * h + 2] = b[0] * GATE_DESCALE; v[4 * h + 3] = b[1] * GATE_DESCALE; }
}
__device__ __forceinline__ void dec16f8c(const u32x4 w, float (&v)[16]) {
    typedef float f32x2v __attribute__((ext_vector_type(2)));
#pragma unroll
    for (int h = 0; h < 4; ++h) { const unsigned x = w[h];
        const f32x2v a = __builtin_amdgcn_cvt_pk_f32_fp8(x, false), b = __builtin_amdgcn_cvt_pk_f32_fp8(x, true);
        v[4 * h] = a[0] * GATE_DESCALE; v[4 * h + 1] = a[1] * GATE_DESCALE; v[4 * h + 2] = b[0] * GATE_DESCALE; v[4 * h + 3] = b[1] * GATE_DESCALE; }
}
#define PG8_PIN8(a) asm volatile("" :: "v"(a[0]), "v"(a[1]), "v"(a[2]), "v"(a[3]), "v"(a[4]), "v"(a[5]), "v"(a[6]), "v"(a[7]))
#define PG8_GATHER16(v, acc, ai, m) do { _Pragma("unroll") for (int _bj = 0; _bj < 2; ++_bj) _Pragma("unroll") for (int _n = 0; _n < 2; ++_n) _Pragma("unroll") for (int _j = 0; _j < 4; ++_j) \
        v[8 * _bj + 4 * _n + _j] = acc[ai][_bj][m][_n][_j]; } while (0)

__device__ __forceinline__ int pg_perm(int g, int s) { return g == 0 ? s : (g == 1 ? ((s & 3) * 512 + (s >> 2)) : ((s & 15) * 128 + (s >> 4))); }

struct EpiIn {
    static constexpr bool PROBE_TWICE = true;
    static __device__ __forceinline__ bool leaves16(const Unit& u) { return u.pn < 12; }
    bf16_t *QA, *KA, *VA, *QD, *KD, *VDT, *G;
    const float* qg; const float* kg;
    const float* rope;
    __device__ __forceinline__ void rms_rope(float (&v)[16], const float* gain, int s, int fq, float scale) const {
        float ss = 0.f;
#pragma unroll
        for (int e = 0; e < 16; ++e) ss += v[e] * v[e];
        ss += __shfl_xor(ss, 16); ss += __shfl_xor(ss, 32);
        const float rinv = 1.0f / sqrtf(ss * (1.0f / 64.0f) + RMS_EPS);
#pragma unroll
        for (int hb = 0; hb < 2; ++hb) {
            const int a = hb == 0 ? (s >> 6) : (s & 63);
            const f32x4* rp = (const f32x4*)(rope + (size_t)(a * 16 + 4 * fq) * 2);
            const f32x4* gp = (const f32x4*)(gain + 32 * hb + 8 * fq);
#pragma unroll
            for (int q = 0; q < 2; ++q) {
                const f32x4 cs = rp[q], gg = gp[q];
                const int e0 = 8 * hb + 4 * q;
                const float x0 = v[e0] * rinv * gg[0], x1 = v[e0 + 1] * rinv * gg[1], x2 = v[e0 + 2] * rinv * gg[2], x3 = v[e0 + 3] * rinv * gg[3];
                v[e0] = (x0 * cs[0] - x1 * cs[1]) * scale; v[e0 + 1] = (x0 * cs[1] + x1 * cs[0]) * scale;
                v[e0 + 2] = (x2 * cs[2] - x3 * cs[3]) * scale; v[e0 + 3] = (x2 * cs[3] + x3 * cs[2]) * scale;
            }
        }
    }
    __device__ __forceinline__ void operator()(const f32x4 (&acc)[2][2][4][2], const Unit& u, int wr, int wc, int fr, int fq) const {
        const int pn = u.pn;
        const int b = (u.pm * BM) >> 11;
#pragma unroll
        for (int ai = 0; ai < 2; ++ai)
#pragma unroll
            for (int m = 0; m < 4; ++m) {
                const int row = u.pm * BM + ai * HALF + wr * 64 + m * 16 + fr, s = row & (SEQ - 1);
                float v[16]; PG8_GATHER16(v, acc, ai, m);
#pragma unroll
                for (int e = 0; e < 16; ++e) v[e] *= IN_DESCALE;
                if (pn < 2) {
                    rms_rope(v, qg, s, fq, C2F);
                    store16(QA + (size_t)row * 512 + (pn * 4 + wc) * 64 + 8 * fq, v);
                } else if (pn == 2) {
                    if (wc < 2) { rms_rope(v, kg, s, fq, 1.0f); store16(KA + (size_t)row * 128 + wc * 64 + 8 * fq, v); }
                    else store16(VA + (size_t)row * 128 + (wc - 2) * 64 + 8 * fq, v);
                } else if (pn < 12) {
                    const int kind = (pn - 3) / 3, g = (pn - 3) - 3 * kind, gh = g * 4 + wc;
                    if (kind == 0) {
#pragma unroll
                        for (int e = 0; e < 16; ++e) v[e] *= C2F; }
                    store16((kind == 0 ? QD : kind == 1 ? KD : VDT) + ((size_t)(b * 12 + gh) * SEQ + pg_perm(g, s)) * 64 + 8 * fq, v);
                } else {
#pragma unroll
                    for (int e = 0; e < 16; ++e) v[e] = sigmoidf_(v[e]) * GATE_SCALE;
                    store16f8c((unsigned char*)G + (size_t)row * 2048 + (pn - 12) * 256 + wc * 64 + 16 * fq, v);
                }
                if (m & 1) asm volatile("" ::: "memory");
            }
    }
};
struct EpiMergeF {
    static constexpr bool PROBE_TWICE = false;
    static constexpr int MID_T = 4;
    static constexpr float GB_MIN = 7.62939453125e-06f;
    static __device__ __forceinline__ bool leaves16(const Unit&) { return false; }
    const bf16_t* G; bf16_t* merged;
    __device__ __forceinline__ void mid(f32x4 (&acc)[2][2][4][2], const Unit& u, int wr, int wc, int fr, int fq) const {
        const int col0 = u.pn * BM + wc * 64 + 16 * fq;
#pragma unroll
        for (int ai = 0; ai < 2; ++ai) {
            u32x4 raw[8];
#pragma unroll
            for (int m = 0; m < 4; ++m) { const unsigned char* gp = (const unsigned char*)G + (size_t)(u.pm * BM + ai * HALF + wr * 64 + m * 16 + fr) * 2048 + col0;
                raw[2 * m] = *(const u32x4*)gp; raw[2 * m + 1] = *(const u32x4*)(gp + 1024); }
            PG8_PIN8(raw);
#pragma unroll
            for (int m = 0; m < 4; ++m) {
                float ga[16], gb[16]; dec16f8c(raw[2 * m], ga); dec16f8c(raw[2 * m + 1], gb);
#pragma unroll
                for (int e = 0; e < 16; ++e) ga[e] *= __builtin_amdgcn_rcpf(fmaxf(gb[e], GB_MIN));
#pragma unroll
                for (int bj = 0; bj < 2; ++bj)
#pragma unroll
                    for (int n = 0; n < 2; ++n)
#pragma unroll
                        for (int j = 0; j < 4; ++j) acc[ai][bj][m][n][j] *= ga[8 * bj + 4 * n + j];
            }
        }
    }
    __device__ __forceinline__ void operator()(const f32x4 (&acc)[2][2][4][2], const Unit& u, int wr, int wc, int fr, int fq) const {
        const int col0 = u.pn * BM + wc * 64 + 16 * fq;
        u32x4 raw[8];
#pragma unroll
        for (int ai = 0; ai < 2; ++ai)
#pragma unroll
            for (int m = 0; m < 4; ++m) raw[ai * 4 + m] = *(const u32x4*)((const unsigned char*)G + (size_t)(u.pm * BM + ai * HALF + wr * 64 + m * 16 + fr) * 2048 + 1024 + col0);
        PG8_PIN8(raw);
#pragma unroll
        for (int ai = 0; ai < 2; ++ai)
#pragma unroll
            for (int m = 0; m < 4; ++m) {
                const int row = u.pm * BM + ai * HALF + wr * 64 + m * 16 + fr;
                float v[16], gb[16]; PG8_GATHER16(v, acc, ai, m);
                dec16f8c(raw[ai * 4 + m], gb);
#pragma unroll
                for (int e = 0; e < 16; ++e) v[e] *= fmaxf(gb[e], GB_MIN) * (PAB_DESCALE * MERGED_SCALE);
                store16f8c((unsigned char*)merged + (size_t)row * DM + col0, v);
                if (m & 1) asm volatile("" ::: "memory");
            }
    }
};
struct EpiRes {
    static constexpr bool PROBE_TWICE = false;
    static __device__ __forceinline__ bool leaves16(const Unit&) { return false; }
    bf16_t* gmix; const float* gmod;
    __device__ __forceinline__ void operator()(const f32x4 (&acc)[2][2][4][2], const Unit& u, int wr, int wc, int fr, int fq) const {
        const int col0 = u.pn * BM + wc * 64 + 16 * fq;
        const int b = (u.pm * BM) >> 11;
        float gv[16];
#pragma unroll
        for (int q = 0; q < 4; ++q) { const f32x4 t = *(const f32x4*)(gmod + (size_t)b * 6144 + col0 + 4 * q); gv[4 * q] = t[0] * WO_DESCALE; gv[4 * q + 1] = t[1] * WO_DESCALE; gv[4 * q + 2] = t[2] * WO_DESCALE; gv[4 * q + 3] = t[3] * WO_DESCALE; }
#pragma unroll
        for (int ai = 0; ai < 2; ++ai)
#pragma unroll
            for (int m = 0; m < 4; ++m) {
                const size_t off = (size_t)(u.pm * BM + ai * HALF + wr * 64 + m * 16 + fr) * DM + col0;
                float v[16]; PG8_GATHER16(v, acc, ai, m);
#pragma unroll
                for (int e = 0; e < 16; ++e) v[e] *= gv[e] * GMIX_SCALE;
                store16f8c((unsigned char*)gmix + off, v);
                if (m & 1) asm volatile("" ::: "memory");
            }
    }
};
struct EpiGU {
    static constexpr bool PROBE_TWICE = false;
    static __device__ __forceinline__ bool leaves16(const Unit&) { return false; }
    bf16_t* act; const float* gatew; const PG8_LAS int* tab;
    __device__ __forceinline__ void operator()(const f32x4 (&acc)[2][2][4][2], const Unit& u, int wr, int wc, int fr, int fq) const {
        const int e = u.e, cnt = tab[e], f0 = (u.pn & 1) * 128 + wc * 32 + fq * 8;
        float gwa[8];
#pragma unroll
        for (int ai = 0; ai < 2; ++ai)
#pragma unroll
            for (int m = 0; m < 4; ++m) { const int li = u.lt * BM + ai * HALF + wr * 64 + m * 16 + fr; gwa[ai * 4 + m] = gatew[(size_t)e * CAP + (li < CAP ? li : CAP - 1)]; }
        PG8_PIN8(gwa);
#pragma unroll
        for (int ai = 0; ai < 2; ++ai)
#pragma unroll
            for (int m = 0; m < 4; ++m) {
                const int rit = ai * HALF + wr * 64 + m * 16 + fr, li = u.lt * BM + rit;
                const float gw = li < cnt ? gwa[ai * 4 + m] : 0.f;
                float a[8];
#pragma unroll
                for (int bj = 0; bj < 2; ++bj)
#pragma unroll
                    for (int j = 0; j < 4; ++j) { const float gt = acc[ai][bj][m][0][j] * GU_DESCALE, up = acc[ai][bj][m][1][j] * GU_DESCALE; a[4 * bj + j] = gt * sigmoidf_(gt) * up * gw * ACT_SCALE; }
                u32x2 w; w.x = pk4_fp8e(a[0], a[1], a[2], a[3]); w.y = pk4_fp8e(a[4], a[5], a[6], a[7]);
                *(u32x2*)((unsigned char*)act + (size_t)(u.pm * BM + rit) * 256 + f0) = w;
                if (m & 1) asm volatile("" ::: "memory");
            }
    }
};
struct EpiDown {
    static constexpr bool PROBE_TWICE = false;
    static __device__ __forceinline__ bool leaves16(const Unit&) { return false; }
    bf16_t* y2; const int* rowlist; const PG8_LAS int* tab;
    __device__ __forceinline__ void operator()(const f32x4 (&acc)[2][2][4][2], const Unit& u, int wr, int wc, int fr, int fq) const {
        const int e = u.e, cnt = tab[e], col0 = (u.pn & 3) * BM + wc * 64 + 16 * fq;
        int ents[8];
#pragma unroll
        for (int ai = 0; ai < 2; ++ai)
#pragma unroll
            for (int m = 0; m < 4; ++m) { const int li = u.lt * BM + ai * HALF + wr * 64 + m * 16 + fr; ents[ai * 4 + m] = rowlist[(size_t)e * CAP + (li < CAP ? li : CAP - 1)]; }
        PG8_PIN8(ents);
#pragma unroll
        for (int ai = 0; ai < 2; ++ai)
#pragma unroll
            for (int m = 0; m < 4; ++m) {
                const int li = u.lt * BM + ai * HALF + wr * 64 + m * 16 + fr;
                const int ent = ents[ai * 4 + m];
                float v[16]; PG8_GATHER16(v, acc, ai, m);
#pragma unroll
                for (int e2 = 0; e2 < 16; ++e2) v[e2] *= DN_DESCALE * Y2_SCALE;
                store16f8c((unsigned char*)y2 + (li < cnt ? ((size_t)(ent & 1) * T_TOK + (ent >> 1)) * DM : (size_t)2 * T_TOK * DM) + col0, v);
                if (m & 1) asm volatile("" ::: "memory");
            }
    }
};
template <bool GATHER> struct MoeOrder {
    const PG8_LAS int* tab; const int* rowlist; int nct, G, c;
    __device__ __forceinline__ bool next(int i, Unit& u) const {
        const int nwg = tab[32] * nct; const long L = (long)i * G + c; if (L >= nwg) return false;
        int w = (int)L; { const int q = nwg / NXCD, r = nwg % NXCD, xcd = w % NXCD, off = w / NXCD; w = (xcd < r ? xcd * (q + 1) : r * (q + 1) + (xcd - r) * q) + off; }
        const int rt = w / nct, ct = w - rt * nct; int e = 0;
        for (int k = 1; k < 16; ++k) e += (rt >= tab[16 + k]) ? 1 : 0;
        u.pm = rt; u.e = e; u.lt = rt - tab[16 + e]; u.pn = e * nct + ct; return true;
    }
    __device__ __forceinline__ int arow(const Unit& u, int R) const {
        if (GATHER) { const int li = u.lt * BM + R; const int ent = rowlist[(size_t)u.e * CAP + (li < CAP ? li : CAP - 1)]; return li < tab[u.e] ? (ent >> 1) : 0; }
        return u.pm * BM + R;
    }
};
}
namespace attn_body {
using bf16=__hip_bfloat16;
using bf16x8=__attribute__((ext_vector_type(8)))short;
using s16x4=__attribute__((ext_vector_type(4)))short;
using f32x16=__attribute__((ext_vector_type(16)))float;
using u32x4=__attribute__((ext_vector_type(4)))unsigned;
constexpr int BATCH=16,NHEAD=8,SEQ=2048,D=64;
constexpr int NW=8,QBLK=32,QB=QBLK*NW,KVBLK=64,NQB=SEQ/QB;
constexpr int ATTN_UNIT_ROWS=QB;
__device__ __forceinline__ int crow(int r,int hi){return (r&3)+8*(r>>2)+4*hi;}
#define SBAR() __builtin_amdgcn_sched_barrier(0)
__device__ __forceinline__ void cmask(f32x16&p0,f32x16&p1,int jb,int qrel,int hi){
  const float NEG=-INFINITY; int kb=64*jb+4*hi;
  #pragma unroll
  for(int r=0;r<16;++r){int kv=kb+(r&3)+8*(r>>2); if(kv>qrel)p0[r]=NEG; if(kv+32>qrel)p1[r]=NEG;}
}

constexpr int NSLOT=3, SLOTB=8192;
constexpr int LDS_K=0, LDS_V=NSLOT*SLOTB, LDS_WS=2*NSLOT*SLOTB, LDS_OST=LDS_WS+NW*64*4, LDS_BYTES=LDS_OST+NW*4096;
constexpr float C2=0.125f*1.4426950408889634f;
__device__ __forceinline__ void glds16(const void*gsrc,unsigned lds_dst){unsigned keep;
  asm volatile("s_mov_b32 %0, m0\n\ts_mov_b32 m0, %2\n\ts_nop 0\n\tglobal_load_lds_dwordx4 %1, off\n\ts_mov_b32 m0, %0":"=&s"(keep):"v"(gsrc),"s"(lds_dst):"memory");}
__device__ __forceinline__ float max3f(float a,float b,float c){float r;asm("v_max3_f32 %0, %1, %2, %3":"=v"(r):"v"(a),"v"(b),"v"(c));return r;}
__device__ __forceinline__ float max2f(float a,float b){float r;asm("v_max_f32_e32 %0, %1, %2":"=v"(r):"v"(a),"v"(b));return r;}
__device__ __forceinline__ float fadd_s(float a,float b){float r;asm("v_add_f32_e32 %0, %1, %2":"=v"(r):"v"(a),"v"(b));return r;}
__device__ __forceinline__ float fsub_s(float a,float b){float r;asm("v_sub_f32_e32 %0, %1, %2":"=v"(r):"v"(a),"v"(b));return r;}
typedef float f32x2_t __attribute__((ext_vector_type(2))); typedef __bf16 bf16x2_t __attribute__((ext_vector_type(2)));
__device__ __forceinline__ unsigned cvtpk_s(float lo,float hi){f32x2_t v={lo,hi};bf16x2_t b=__builtin_convertvector(v,bf16x2_t);return __builtin_bit_cast(unsigned,b);}
#define WAIT_BAR(N) asm volatile("s_waitcnt vmcnt(" #N ") lgkmcnt(0)\n\ts_barrier":::"memory")

__device__ __forceinline__ void qkt(f32x16&p0,f32x16&p1,const char*Kslot,const bf16x8*qr,const f32x16&negm,int r32,int hi){
  const char*kb=Kslot+hi*1024+r32*16;
  #pragma unroll
  for(int d0=0;d0<4;++d0){
    const bf16x8 b0=*reinterpret_cast<const bf16x8*>(kb+d0*2048);
    const bf16x8 b1=*reinterpret_cast<const bf16x8*>(kb+d0*2048+512);
    if(d0==0){p0=__builtin_amdgcn_mfma_f32_32x32x16_bf16(b0,qr[0],negm,0,0,0);p1=__builtin_amdgcn_mfma_f32_32x32x16_bf16(b1,qr[0],negm,0,0,0);}
    else{p0=__builtin_amdgcn_mfma_f32_32x32x16_bf16(b0,qr[d0],p0,0,0,0);p1=__builtin_amdgcn_mfma_f32_32x32x16_bf16(b1,qr[d0],p1,0,0,0);}}
}
typedef __attribute__((address_space(3))) const char* lds_cptr;
typedef short v4i16_t __attribute__((ext_vector_type(4)));
__device__ __forceinline__ void kload8(bf16x8*kf,lds_cptr kp){
  kf[0]=*(const __attribute__((address_space(3))) bf16x8*)(kp);      kf[1]=*(const __attribute__((address_space(3))) bf16x8*)(kp+512);
  kf[2]=*(const __attribute__((address_space(3))) bf16x8*)(kp+2048); kf[3]=*(const __attribute__((address_space(3))) bf16x8*)(kp+2560);
  kf[4]=*(const __attribute__((address_space(3))) bf16x8*)(kp+4096); kf[5]=*(const __attribute__((address_space(3))) bf16x8*)(kp+4608);
  kf[6]=*(const __attribute__((address_space(3))) bf16x8*)(kp+6144); kf[7]=*(const __attribute__((address_space(3))) bf16x8*)(kp+6656);
}
__device__ __forceinline__ void kload2(bf16x8*kf,lds_cptr kp,int j){ kf[2*j]=*(const __attribute__((address_space(3))) bf16x8*)(kp+j*2048); kf[2*j+1]=*(const __attribute__((address_space(3))) bf16x8*)(kp+j*2048+512); }
__device__ __forceinline__ s16x4 vtr(lds_cptr p){ return __builtin_bit_cast(s16x4,__builtin_amdgcn_ds_read_tr16_b64_v4i16((__attribute__((address_space(3))) v4i16_t*)p)); }
__device__ __forceinline__ float rowmax(const f32x16&p0,const f32x16&p1){
  float a=max3f(p0[0],p0[1],p1[0]),b=max3f(p0[2],p0[3],p1[1]);a=max3f(a,p1[2],p1[3]);
  #pragma unroll
  for(int r=4;r<16;r+=4){a=max3f(a,p0[r],p0[r+1]);b=max3f(b,p0[r+2],p0[r+3]);a=max3f(a,p1[r],p1[r+1]);b=max3f(b,p1[r+2],p1[r+3]);}
  const float m=max2f(a,b);
  auto rr=__builtin_amdgcn_permlane32_swap(__float_as_uint(m),__float_as_uint(m),false,false);
  return max2f(__uint_as_float(rr[0]),__uint_as_float(rr[1]));
}
__device__ __forceinline__ void pv(f32x16*o,int vb,bf16x8 pa0,bf16x8 pa1,bf16x8 pa2,bf16x8 pa3){
  #pragma unroll
  for(int d0=0;d0<2;++d0){s16x4 lo[4],hi[4];
    #pragma unroll
    for(int ks=0;ks<4;++ks){
      asm volatile("ds_read_b64_tr_b16 %0,%1 offset:%c2":"=&v"(lo[ks]):"v"(vb),"i"(d0*4096+ks*1024):"memory");
      asm volatile("ds_read_b64_tr_b16 %0,%1 offset:%c2":"=&v"(hi[ks]):"v"(vb),"i"(d0*4096+ks*1024+512):"memory");}
    asm volatile("s_waitcnt lgkmcnt(0)":::"memory");SBAR();
    #define PK(k) (bf16x8){lo[k][0],lo[k][1],lo[k][2],lo[k][3],hi[k][0],hi[k][1],hi[k][2],hi[k][3]}
    o[d0]=__builtin_amdgcn_mfma_f32_32x32x16_bf16(pa0,PK(0),o[d0],0,0,0);
    o[d0]=__builtin_amdgcn_mfma_f32_32x32x16_bf16(pa1,PK(1),o[d0],0,0,0);
    o[d0]=__builtin_amdgcn_mfma_f32_32x32x16_bf16(pa2,PK(2),o[d0],0,0,0);
    o[d0]=__builtin_amdgcn_mfma_f32_32x32x16_bf16(pa3,PK(3),o[d0],0,0,0);
    #undef PK
  }
}

#ifndef ATTN_STORE16
#define ATTN_STORE16(p,v) (*(u32x4*)(p)=(v))
#endif
struct UnitP { const bf16* Q; const bf16* K; const bf16* V; bf16* O; unsigned char* O8; float* lse; int NT; int qa0; int kk0; int ngmask; float sl2; int NTL, hs0, hs1; };
struct CfgA { static constexpr int QP=512,KP=128,VP=128,OP=768; static constexpr bool BAND=false,OFP8=true; };
struct CfgB { static constexpr int QP=64,KP=64,VP=64,OP=64; static constexpr bool BAND=true,OFP8=true; };
constexpr float OUT_SCALE=32.0f;
constexpr float NEGBAND=-30000.0f;
__device__ __forceinline__ void bandmask(f32x16&p0,f32x16&p1,int kt0,int qa,int hi,int ngmask,float sl2){
  const bool cls_ok=((kt0&ngmask)==(qa&ngmask));
  const float fb=(float)(kt0+4*hi-qa);
  #pragma unroll
  for(int r=0;r<16;++r){ const float f0=fb+(float)((r&3)+8*(r>>2)),f1=f0+32.0f; const float a0=__builtin_fabsf(f0),a1=__builtin_fabsf(f1);
    const float v0=__builtin_fmaf(-sl2,a0,p0[r]),v1=__builtin_fmaf(-sl2,a1,p1[r]);
    p0[r]=(cls_ok&&a0<=64.0f)?v0:NEGBAND; p1[r]=(cls_ok&&a1<=64.0f)?v1:NEGBAND; }
}
template<int THRL,class CFG> __device__ __forceinline__ void attn_unit(const int wave,const UnitP&U,char*shm,const bool pre,const bf16*nK,const bf16*nV,const int nNTL){
  constexpr int QP=CFG::QP,KP=CFG::KP,VP=CFG::VP,OP=CFG::OP;
  const int lane=hw_lane(),r32=lane&31,hi=lane>>5; const int wid=wave;
  const bf16*Qw=U.Q+(long)(wid*QBLK)*QP;
  const bf16*Kh=U.K,*Vh=U.V;
  const int qa=U.qa0+wid*QBLK+r32;
  const unsigned lds0=(unsigned)(uintptr_t)shm;
  constexpr bool AR=CFG::BAND;
  constexpr int NS=AR?6:NSLOT, LV=NS*SLOTB, LWS=2*NS*SLOTB, LOST=LWS+NW*64*4, OSTW=AR?2048:4096;
  const int hsh=AR?((wid>>2)?U.hs1:U.hs0):0, hoff=hsh*SLOTB, kk0w=U.kk0+64*hsh;
  float*wsf=(float*)(shm+LWS)+wid*64;
  const bf16*ksrc=Kh+(long)lane*KP+wid*8;
  const bf16*vsrc=Vh+(long)(16*(wid&3)+(lane>>2))*VP+(wid>>2)*32+(lane&3)*8;
  const unsigned kdst=lds0+LDS_K+wid*1024, vdst=lds0+LV+wid*1024;
  #define DMA_K(t,slot) glds16(ksrc+(long)(t)*KVBLK*KP,(unsigned)__builtin_amdgcn_readfirstlane(kdst+(slot)))
  #define DMA_V(t,slot) glds16(vsrc+(long)(t)*KVBLK*VP,(unsigned)__builtin_amdgcn_readfirstlane(vdst+(slot)))
  const int vb0=(int)(lds0+LV)+hoff+((lane>>4)&1)*32+(lane&3)*8+(4*hi+((lane&15)>>2))*64;
  const char*Kbase=shm+LDS_K+hoff; bf16x8 kf[8];
  const lds_cptr shm3=(lds_cptr)shm; const lds_cptr kp0=shm3+LDS_K+hoff+hi*1024+r32*16; const lds_cptr vp0=shm3+LV+hoff+((lane>>4)&1)*32+(lane&3)*8+(4*hi+((lane&15)>>2))*64;
  const int NT=U.NT;
  if constexpr(AR){ if(!pre){DMA_K(0,0);DMA_K(1,SLOTB);DMA_K(2,2*SLOTB);DMA_K(3,3*SLOTB);} }
  else if(!pre){DMA_K(0,0);DMA_V(0,0);DMA_K(1,SLOTB);}
  bf16x8 qr[4];
  #pragma unroll
  for(int d0=0;d0<4;++d0)qr[d0]=*reinterpret_cast<const bf16x8*>(&Qw[(long)r32*QP+d0*16+hi*8]);
  float mhat=0.f,l_reg=0.f;f32x16 o[2];o[0]=f32x16{};o[1]=f32x16{};f32x16 negm=f32x16{};asm volatile("":"+v"(negm));

  #define CMASK(P0,P1,t) do{ if constexpr(CFG::BAND) bandmask(P0,P1,kk0w+64*(t),qa,hi,U.ngmask,U.sl2); }while(0)
  bool resc=false;
  #define START(P0,P1) do{ const float rm=rowmax(P0,P1); resc=false; \
    { const float dl=rm; mhat=fadd_s(mhat,dl); \
      _Pragma("unroll") for(int r=0;r<16;++r){P0[r]=fsub_s(P0[r],dl);P1[r]=fsub_s(P1[r],dl);} \
      _Pragma("unroll") for(int r=0;r<16;++r)negm[r]=-mhat; asm volatile("":"+v"(negm)); } \
    _Pragma("unroll") for(int r=0;r<16;++r)P0[r]=__builtin_amdgcn_exp2f(P0[r]); }while(0)
  #define RESC() do{ if(resc){ asm volatile("s_waitcnt lgkmcnt(0)":::"memory"); \
      _Pragma("unroll") for(int d_=0;d_<2;++d_) _Pragma("unroll") for(int r=0;r<16;++r)o[d_][r]*=wsf[crow(r,hi)]; } }while(0)
  f32x16 pA0,pA1,pB0,pB1;
  int sl_prev=0,sl_cur=0,sl_next=SLOTB;
  #define ROT() do{sl_prev=sl_cur;sl_cur=sl_next;sl_next=(sl_next==(NS-1)*SLOTB)?0:sl_next+SLOTB;}while(0)
  if constexpr(AR){ asm volatile(""::"v"(qr[0]),"v"(qr[1]),"v"(qr[2]),"v"(qr[3]));
    DMA_V(0,0);DMA_V(1,SLOTB);DMA_V(2,2*SLOTB); if(U.NTL==6){DMA_K(4,4*SLOTB);} DMA_V(3,3*SLOTB); if(U.NTL==6){DMA_K(5,5*SLOTB);DMA_V(4,4*SLOTB);DMA_V(5,5*SLOTB);} }
  #define ARWAIT(n6) do{ if(U.NTL==6){WAIT_BAR(n6);} else {WAIT_BAR(0);} }while(0)
  if constexpr(!AR) DMA_K(2,2*SLOTB);
  if constexpr(AR){ if(U.NTL==6){WAIT_BAR(8);} else {WAIT_BAR(4);} } else
  WAIT_BAR(3);
  qkt(pA0,pA1,Kbase,qr,negm,r32,hi);asm volatile("s_nop 15\n\ts_nop 7":"+v"(pA0),"+v"(pA1));CMASK(pA0,pA1,0);
  START(pA0,pA1);
  _Pragma("unroll") for(int r=0;r<16;++r)pA1[r]=__builtin_amdgcn_exp2f(pA1[r]);
  if constexpr(AR){ARWAIT(4);} else
  WAIT_BAR(0);
  if constexpr(!AR){DMA_K(3,0);DMA_V(1,SLOTB);}
  ROT();
  kload8(kf,kp0+sl_cur);
  if constexpr(AR){ARWAIT(4);} else
  WAIT_BAR(2);
  s16x4 vlo[8],vhi[8]; u32x4 pw0,pw1,pw2,pw3;
  #define PKW(P,B) cvtpk_s(P[B],P[B+1])
  #define PAF(k) __builtin_bit_cast(bf16x8,pw##k)
  #define VFR(i) (bf16x8){vlo[i][0],vlo[i][1],vlo[i][2],vlo[i][3],vhi[i][0],vhi[i][1],vhi[i][2],vhi[i][3]}
  #define PIN(x) asm volatile("":"+v"(x))
  #define MX3(a,b,c) __builtin_fmaxf(__builtin_fmaxf((a),(b)),(c))
  #define GAPA(MF,A0,A1,A2,A3,W0,W1,PW) do{ MF; sacc+=A0; sacc+=A1; sacc+=A2; sacc+=A3; PIN(sacc); W0; W1; PIN(PW); SBAR(); }while(0)
  #define EX(v) __builtin_amdgcn_exp2f(v)
  #define GAPB(MF,X,B) do{ MF; X[B]=EX(X[B]); X[B+1]=EX(X[B+1]); X[B+2]=EX(X[B+2]); X[B+3]=EX(X[B+3]); PIN(X); SBAR(); }while(0)
  #define VRD(i) do{ vlo[i]=vtr(vp_+(((i)>>2)*4096+((i)&3)*1024)); vhi[i]=vtr(vp_+(((i)>>2)*4096+((i)&3)*1024+512)); }while(0)
  #define KRD(G,j) do{ if(G){ kload2(kf,kp0+sl_next,j); SBAR(); } }while(0)
  #define STEP(C0,C1,P0,P1,t,GK,GV,GL) do{ SBAR(); \
    const lds_cptr vp_=vp0+sl_prev; \
    VRD(0); SBAR(); float sacc=(P0[0]+P0[1]); \
    GAPA(C0=__builtin_amdgcn_mfma_f32_32x32x16_bf16(kf[0],qr[0],negm,0,0,0), P0[2],P0[3],P0[4],P0[5],     pw0[0]=PKW(P0,0), pw0[1]=PKW(P0,2), pw0); \
    VRD(4); SBAR(); GAPA(C1=__builtin_amdgcn_mfma_f32_32x32x16_bf16(kf[1],qr[0],negm,0,0,0), P0[6],P0[7],P0[8],P0[9],     pw0[2]=PKW(P0,4), pw0[3]=PKW(P0,6), pw0); \
    VRD(1); SBAR(); GAPA(C0=__builtin_amdgcn_mfma_f32_32x32x16_bf16(kf[2],qr[1],C0,0,0,0),   P0[10],P0[11],P0[12],P0[13], pw1[0]=PKW(P0,8), pw1[1]=PKW(P0,10), pw1); \
    VRD(5); SBAR(); GAPA(C1=__builtin_amdgcn_mfma_f32_32x32x16_bf16(kf[3],qr[1],C1,0,0,0),   P0[14],P0[15],P1[0],P1[1],   pw1[2]=PKW(P0,12),pw1[3]=PKW(P0,14), pw1); \
    VRD(2); SBAR(); GAPA(C0=__builtin_amdgcn_mfma_f32_32x32x16_bf16(kf[4],qr[2],C0,0,0,0),   P1[2],P1[3],P1[4],P1[5],     pw2[0]=PKW(P1,0), pw2[1]=PKW(P1,2), pw2); \
    VRD(6); SBAR(); GAPA(C1=__builtin_amdgcn_mfma_f32_32x32x16_bf16(kf[5],qr[2],C1,0,0,0),   P1[6],P1[7],P1[8],P1[9],     pw2[2]=PKW(P1,4), pw2[3]=PKW(P1,6), pw2); \
    VRD(3); SBAR(); GAPA(C0=__builtin_amdgcn_mfma_f32_32x32x16_bf16(kf[6],qr[3],C0,0,0,0),   P1[10],P1[11],P1[12],P1[13], pw3[0]=PKW(P1,8), pw3[1]=PKW(P1,10), pw3); \
    VRD(7); SBAR(); GAPA(C1=__builtin_amdgcn_mfma_f32_32x32x16_bf16(kf[7],qr[3],C1,0,0,0),   P1[14],P1[15],0.f,0.f,       pw3[2]=PKW(P1,12),pw3[3]=PKW(P1,14), pw3); \
    l_reg+=sacc; \
    if(GK){DMA_K((t)+3,sl_cur);} if(GV){DMA_V((t)+1,sl_next);} \
    CMASK(C0,C1,t); \
    { float a=MX3(C0[0],C0[1],C1[0]),b=MX3(C0[2],C0[3],C1[1]); a=MX3(a,C1[2],C1[3]); \
      _Pragma("unroll") for(int r=4;r<16;r+=4){a=MX3(a,C0[r],C0[r+1]);b=MX3(b,C0[r+2],C0[r+3]);a=MX3(a,C1[r],C1[r+1]);b=MX3(b,C1[r+2],C1[r+3]);} \
      float rm=__builtin_fmaxf(a,b); { auto rr=__builtin_amdgcn_permlane32_swap(__float_as_uint(rm),__float_as_uint(rm),false,false); rm=__builtin_fmaxf(__uint_as_float(rr[0]),__uint_as_float(rr[1])); } \
      resc=false; \
      if(__builtin_expect(__any(rm>(float)THRL),0)){ const float dl=__builtin_fmaxf(rm,0.f); mhat+=dl; \
        _Pragma("unroll") for(int r=0;r<16;++r){C0[r]-=dl;C1[r]-=dl;} \
        _Pragma("unroll") for(int r=0;r<16;++r)negm[r]=-mhat; asm volatile("":"+v"(negm)); \
        const float f=__builtin_amdgcn_exp2f(-dl); l_reg*=f; if(hi==0)wsf[r32]=f; resc=true; } } \
    SBAR(); \
    GAPB(o[0]=__builtin_amdgcn_mfma_f32_32x32x16_bf16(PAF(0),VFR(0),o[0],0,0,0), C0,0); \
    GAPB(o[1]=__builtin_amdgcn_mfma_f32_32x32x16_bf16(PAF(0),VFR(4),o[1],0,0,0), C0,4); \
    KRD(GL,0); GAPB(o[0]=__builtin_amdgcn_mfma_f32_32x32x16_bf16(PAF(1),VFR(1),o[0],0,0,0), C0,8); \
    KRD(GL,1); GAPB(o[1]=__builtin_amdgcn_mfma_f32_32x32x16_bf16(PAF(1),VFR(5),o[1],0,0,0), C0,12); \
    KRD(GL,2); GAPB(o[0]=__builtin_amdgcn_mfma_f32_32x32x16_bf16(PAF(2),VFR(2),o[0],0,0,0), C1,0); \
    KRD(GL,3); GAPB(o[1]=__builtin_amdgcn_mfma_f32_32x32x16_bf16(PAF(2),VFR(6),o[1],0,0,0), C1,4); \
    GAPB(o[0]=__builtin_amdgcn_mfma_f32_32x32x16_bf16(PAF(3),VFR(3),o[0],0,0,0), C1,8); \
    GAPB(o[1]=__builtin_amdgcn_mfma_f32_32x32x16_bf16(PAF(3),VFR(7),o[1],0,0,0), C1,12); \
    }while(0)
  int t=1;
  #undef CMASK
  #define CMASK(P0,P1,t) do{ if constexpr(CFG::BAND) bandmask(P0,P1,kk0w+64*(t),qa,hi,U.ngmask,U.sl2); }while(0)
  for(;t+5<NT;t+=2){
    STEP(pB0,pB1,pA0,pA1,t,!AR,!AR,true);     WAIT_BAR(2); RESC(); ROT();
    STEP(pA0,pA1,pB0,pB1,t+1,!AR,!AR,true);   WAIT_BAR(2); RESC(); ROT();
  }
  #undef CMASK
  #define CMASK(P0,P1,t) do{ if constexpr(CFG::BAND) bandmask(P0,P1,kk0w+64*(t),qa,hi,U.ngmask,U.sl2); }while(0)
  #define ENDW(tt) do{ if((tt)+3<NT){WAIT_BAR(2);} else if((tt)+2<NT){WAIT_BAR(1);} else {WAIT_BAR(0);} }while(0)
  for(;t+1<NT;t+=2){
    STEP(pB0,pB1,pA0,pA1,t,(!AR&&(t+3<NT)),(!AR&&(t+1<NT)),(t+1<NT));       ENDW(t);   RESC(); ROT();
    STEP(pA0,pA1,pB0,pB1,t+1,(!AR&&(t+4<NT)),(!AR&&(t+2<NT)),(t+2<NT));     ENDW(t+1); RESC(); ROT();
  }
  STEP(pB0,pB1,pA0,pA1,NT-1,false,false,false); RESC();
  { float sacc=pB0[0]+pB0[1]; _Pragma("unroll") for(int r=2;r<16;++r)sacc+=pB0[r]; _Pragma("unroll") for(int r=0;r<16;++r)sacc+=pB1[r]; l_reg+=sacc;
    pw0=(u32x4){PKW(pB0,0),PKW(pB0,2),PKW(pB0,4),PKW(pB0,6)};pw1=(u32x4){PKW(pB0,8),PKW(pB0,10),PKW(pB0,12),PKW(pB0,14)};pw2=(u32x4){PKW(pB1,0),PKW(pB1,2),PKW(pB1,4),PKW(pB1,6)};pw3=(u32x4){PKW(pB1,8),PKW(pB1,10),PKW(pB1,12),PKW(pB1,14)};
    SBAR(); pv(o,vb0+sl_cur,PAF(0),PAF(1),PAF(2),PAF(3)); }
  #undef PKW
  #undef PAF
  #undef VFR
  #undef PIN
  #undef MX3
  #undef GAPA
  #undef GAPB
  #undef EX
  #undef VRD
  #undef KRD
  #undef STEP
  #undef ENDW
  asm volatile("s_waitcnt lgkmcnt(0)\n\ts_barrier":::"memory");
  if(nK){ const bf16*ks2=nK+(long)lane*KP+wid*8; const bf16*vs2=nV+(long)(16*(wid&3)+(lane>>2))*VP+(wid>>2)*32+(lane&3)*8;
    if constexpr(AR){ (void)vs2; (void)nNTL;
      #pragma unroll
      for(int tt=0;tt<4;++tt) glds16(ks2+(long)tt*KVBLK*KP,(unsigned)__builtin_amdgcn_readfirstlane(kdst+tt*SLOTB)); }
    else { glds16(ks2,(unsigned)__builtin_amdgcn_readfirstlane(kdst)); glds16(vs2,(unsigned)__builtin_amdgcn_readfirstlane(vdst)); glds16(ks2+(long)KVBLK*KP,(unsigned)__builtin_amdgcn_readfirstlane(kdst+SLOTB)); } }
  {auto rr=__builtin_amdgcn_permlane32_swap(__float_as_uint(l_reg),__float_as_uint(l_reg),false,false);l_reg=__uint_as_float(rr[0])+__uint_as_float(rr[1]);}
  if constexpr(CFG::BAND){ if(hi==0)U.lse[wid*QBLK+r32]=mhat+__builtin_amdgcn_logf(l_reg); }
  if(hi==0)wsf[32+r32]=l_reg;asm volatile("s_waitcnt lgkmcnt(0)":::"memory");
  float rli[16];
  #pragma unroll
  for(int r=0;r<16;++r)rli[r]=__builtin_amdgcn_rcpf(wsf[32+crow(r,hi)]);
  if constexpr(CFG::OFP8){
    unsigned char*Ow8=U.O8+(long)(wid*QBLK)*OP;
    unsigned char*stg8=(unsigned char*)(shm+LOST)+wid*OSTW;
    #pragma unroll
    for(int r=0;r<16;++r){const int orow=crow(r,hi);
      #pragma unroll
      for(int d0=0;d0<2;++d0){ const float x=__builtin_amdgcn_fmed3f(o[d0][r]*rli[r]*OUT_SCALE,-448.0f,448.0f); stg8[orow*64+d0*32+r32]=(unsigned char)(__builtin_amdgcn_cvt_pk_fp8_f32(x,x,0u,false)&0xffu); } }
    asm volatile("s_waitcnt lgkmcnt(0)":::"memory");
    #pragma unroll
    for(int i=0;i<2;++i){const int row=i*16+(lane>>2),ch=lane&3; const u32x4 v=*(const u32x4*)(stg8+row*64+ch*16); ATTN_STORE16(Ow8+(long)row*OP+ch*16,v);} }
  else {
  bf16*Ow=U.O+(long)(wid*QBLK)*OP;
  { bf16*stg=(bf16*)(shm+LOST)+wid*2048;
    #pragma unroll
    for(int r=0;r<16;++r){const int orow=crow(r,hi);
      #pragma unroll
      for(int d0=0;d0<2;++d0)stg[orow*64+d0*32+r32]=__float2bfloat16(o[d0][r]*rli[r]);}
    asm volatile("s_waitcnt lgkmcnt(0)":::"memory");
    #pragma unroll
    for(int i=0;i<4;++i){const int row=i*8+(lane>>3),ch=lane&7; const u32x4 v=*(const u32x4*)(stg+row*64+ch*8); ATTN_STORE16(Ow+(long)row*OP+ch*8,v);} }
  }
  if(!nK) asm volatile("s_waitcnt lgkmcnt(0)\n\ts_barrier":::"memory");
  #undef DMA_K
  #undef DMA_V
  #undef CMASK
  #undef START
  #undef RESC
  #undef ARWAIT
  #undef ROT
}
constexpr int ATTN_LDS_BYTES=LDS_BYTES;
struct AttnTensors { const bf16* Q; const bf16* K; const bf16* V; bf16* O; unsigned char* O8; };
struct OrderA {
  int vcu, G; AttnTensors T;
  __device__ __forceinline__ bool next(int i,UnitP&u)const{ const int L=(G==256)?(vcu*4+i):(vcu+i*G); if((G==256&&i>=4)||L>=BATCH*NHEAD*NQB)return false;
    const int bh=L>>3,qb=L&7,b=bh/NHEAD,h=bh%NHEAD; const long rowbase=(long)b*SEQ;
    u.Q=T.Q+(rowbase+qb*QB)*CfgA::QP+h*D; u.K=T.K+rowbase*CfgA::KP+(h>>2)*D; u.V=T.V+rowbase*CfgA::VP+(h>>2)*D; u.O=T.O+(rowbase+qb*QB)*CfgA::OP+h*D; u.O8=T.O8+(rowbase+qb*QB)*CfgA::OP+h*D;
    u.lse=nullptr; u.NT=SEQ/KVBLK; u.qa0=0; u.kk0=0; u.ngmask=0; u.sl2=0.f; u.NTL=0; u.hs0=0; u.hs1=0; return true; }
};
struct OrderB {
  int vcu, G; AttnTensors T; float* lse;
  __device__ __forceinline__ bool next(int i,UnitP&u)const{ const int L=(G==256)?(vcu*6+i):(vcu+i*G); if((G==256&&i>=6)||L>=BATCH*12*NQB)return false;
    const int blk=L&7,bgh=L>>3,gh=bgh%12,g=gh>>2; const long hb=(long)bgh*SEQ;
    const int ng=SEQ>>(2*g),q0=blk*QB; int t_lo,nt,h0=0,h1=2;
    if(g==2){ t_lo=q0>>6; nt=4; } else { const int c_lo=(q0&~(ng-1))>>6,c_hi=c_lo+(ng>>6),t0=(q0>>6)-1; t_lo=t0; if(t_lo<c_lo)t_lo=c_lo; if(t_lo>c_hi-6)t_lo=c_hi-6; nt=6; const int d=t0-t_lo; h0=d>0?d:0; h1=2+(d<0?d:0); }
    u.Q=T.Q+(hb+q0)*D; u.K=T.K+(hb+t_lo*64)*D; u.V=T.V+(hb+t_lo*64)*D; u.O=T.O+(hb+q0)*D; u.O8=T.O8+(hb+q0)*D; u.lse=lse+hb+q0;
    u.NT=nt-2; u.NTL=nt; u.hs0=h0; u.hs1=h1; u.qa0=q0; u.kk0=t_lo*64; u.ngmask=~(ng-1); u.sl2=__builtin_amdgcn_exp2f(-8.0f*(float)(gh+1)/12.0f)*1.4426950408889634f*(float)(1<<(2*g)); return true; }
};
template<class CFG,class Sched,int THRL=8> __device__ __forceinline__ void attn_phase(char*lds,const Sched&S,const int wave){
  UnitP u;
  for(int i=0;S.next(i,u);++i){ UnitP n; const bool hn=S.next(i+1,n); const bf16*nK=hn?n.K:nullptr,*nV=hn?n.V:nullptr; const int nNTL=hn?n.NTL:0; attn_unit<THRL,CFG>(wave,u,lds,i>0,nK,nV,nNTL); }
}
#undef SBAR
#undef WAIT_BAR
}
typedef unsigned u32x2g __attribute__((ext_vector_type(2)));
#define GAS __attribute__((address_space(1)))
#define LAS __attribute__((address_space(3)))
typedef unsigned short bf16;
typedef unsigned v4u __attribute__((ext_vector_type(4)));
typedef float f32x4 __attribute__((ext_vector_type(4)));
typedef short bf16x8 __attribute__((ext_vector_type(8)));
typedef GAS unsigned gu32;
typedef GAS unsigned long long gu64;
#define RLX_AGENT __ATOMIC_RELAXED, __HIP_MEMORY_SCOPE_AGENT
#define LDS_WAIT() asm volatile("s_waitcnt lgkmcnt(0)" ::: "memory")
#define VM_WAIT() asm volatile("s_waitcnt vmcnt(0)" ::: "memory")
__device__ __forceinline__ unsigned long long rt() { return __builtin_amdgcn_s_memrealtime(); }
__device__ __forceinline__ unsigned f2bf(float f) { unsigned u = __builtin_bit_cast(unsigned, f); return (u + 0x7fffu + ((u >> 16) & 1u)) >> 16; }
__device__ __forceinline__ unsigned pk2(float lo, float hi) { return f2bf(lo) | (f2bf(hi) << 16); }

#define XB_TMO      128
#define XB_XCNT(j)  (256  + 64 * (j))
#define XB_XSUB(j)  (1280 + 64 * (j))
#define XB_XGEN(j)  (2304 + 64 * (j))
#define XB_TOP      3328
#define XB_TOPGEN   3392
#define XCD_BAR_WORDS 3456
#define XB_SPIN_CAP (1u << 18)

__device__ __forceinline__ unsigned xb_ld(unsigned* p)              { return __hip_atomic_load(p, __ATOMIC_RELAXED, __HIP_MEMORY_SCOPE_AGENT); }
__device__ __forceinline__ unsigned xb_add(unsigned* p, unsigned v) { return __hip_atomic_fetch_add(p, v, __ATOMIC_RELAXED, __HIP_MEMORY_SCOPE_AGENT); }
__device__ __forceinline__ unsigned xb_xcc_id() { return (unsigned)__builtin_amdgcn_s_getreg((3 << 11) | 20) & 0xFu; }
#define XB_SPIN(cond, bar) do { unsigned _sp = 0; while (cond) { __builtin_amdgcn_s_sleep(1); \
    if ((++_sp & 255u) == 0u) { if (xb_ld(&(bar)[XB_TMO])) break; if (_sp > XB_SPIN_CAP) { atomicAdd(&(bar)[XB_TMO], 1u); break; } } } } while (0)

struct XcdBarrier {
    unsigned* bar; unsigned x;
    volatile LAS unsigned* st;
};

__device__ __forceinline__ XcdBarrier xcd_barrier_post(unsigned* bar, volatile LAS unsigned* st) {
    XcdBarrier b; b.bar = bar; b.x = xb_xcc_id(); b.st = st;
    if (threadIdx.x == 0) (void)xb_add(&bar[XB_XCNT(b.x)], 1u);
    return b;
}
__device__ __forceinline__ void xcd_barrier_complete(unsigned* bar, unsigned x, unsigned& nloc, unsigned& nx) {
    const unsigned G = gridDim.x * gridDim.y * gridDim.z;
    unsigned sum, cnt, mine, sp = 0u;
    for (;;) {
        sum = 0u; cnt = 0u; mine = 0u;
#pragma unroll
        for (unsigned j = 0; j < 16; ++j) { const unsigned c = xb_ld(&bar[XB_XCNT(j)]); sum += c; cnt += (c > 0u) ? 1u : 0u; mine = (j == x) ? c : mine; }
        if (sum == G) break;
        __builtin_amdgcn_s_sleep(1);
        if ((++sp & 255u) == 0u) { if (xb_ld(&bar[XB_TMO])) break; if (sp > XB_SPIN_CAP) { atomicAdd(&bar[XB_TMO], 1u); break; } }
    }
    nloc = mine > 0u ? mine : 1u; nx = cnt > 0u ? cnt : 1u;
}

__device__ __forceinline__ void xcd_barrier(const XcdBarrier& b, const bool is_t0  ) {
    asm volatile("s_waitcnt vmcnt(0)" ::: "memory");
    __syncthreads();
    if (is_t0) {
        unsigned* bar = b.bar;
        __builtin_amdgcn_s_waitcnt(0);
        unsigned nloc = b.st[0], nx = b.st[1];
        if (nloc == 0u) { xcd_barrier_complete(bar, b.x, nloc, nx); b.st[0] = nloc; b.st[1] = nx; }
        const unsigned old = xb_add(&bar[XB_XSUB(b.x)], 1u);
        const unsigned gen = old / nloc;
        if (old + 1u == (gen + 1u) * nloc) {
            __builtin_amdgcn_fence(__ATOMIC_RELEASE, "agent");
            asm volatile("s_waitcnt vmcnt(0)" ::: "memory");
            const unsigned og = xb_add(&bar[XB_TOP], 1u);
            const unsigned tg = og / nx;
            if (og + 1u == (tg + 1u) * nx) xb_add(&bar[XB_TOPGEN], 1u);
            else XB_SPIN(xb_ld(&bar[XB_TOPGEN]) == tg, bar);
            __builtin_amdgcn_fence(__ATOMIC_ACQUIRE, "agent");
            xb_add(&bar[XB_XGEN(b.x)], 1u);
            asm volatile("s_waitcnt vmcnt(0)" ::: "memory");
        } else {
            XB_SPIN(xb_ld(&bar[XB_XGEN(b.x)]) == gen, bar);
            __builtin_amdgcn_fence(__ATOMIC_ACQUIRE, "agent");
            asm volatile("s_waitcnt vmcnt(0)" ::: "memory");
        }
    }
    __syncthreads();
}
#ifndef MK_N_LAUNCHES
#define MK_N_LAUNCHES 1
#endif
constexpr int NWAVES = 8;
constexpr int PPL = 9;
constexpr int N_PHASES = 2 + PPL * DEPTH;
constexpr size_t MiB = 1u << 20;
constexpr size_t WS_CTL = 0, CTL_ZERO_BYTES = 64 * 1024;
constexpr size_t WS_ROPE = 1 * MiB;
constexpr size_t WS_MOD = 2 * MiB;
constexpr size_t WS_ROWLIST = 4 * MiB, WS_GATEW = 6 * MiB;
constexpr size_t WS_WIN = 8 * MiB, WS_WPA = 18 * MiB, WS_WPB = 19 * MiB, WS_WO = 20 * MiB, WS_WGU = 22 * MiB, WS_WDN = 38 * MiB;
constexpr size_t WS_H = 48 * MiB;
constexpr size_t WS_OUTB = 112 * MiB;
constexpr size_t WS_QA = 128 * MiB, WS_KA = 160 * MiB, WS_VA = 168 * MiB, WS_QD = 176 * MiB, WS_KD = 224 * MiB, WS_VDT = 272 * MiB, WS_G = 320 * MiB;
constexpr size_t WS_MERGED = 160 * MiB;
constexpr size_t WS_TMP = 224 * MiB;
constexpr size_t WS_ACT = 224 * MiB;
constexpr size_t WS_Y2 = 320 * MiB;
constexpr size_t WS_TRASH = 448 * MiB;
constexpr size_t WS_LSE = 449 * MiB;
constexpr size_t WS_STATS = 451 * MiB;
constexpr size_t WS_XS = 385 * MiB;
constexpr size_t WS_GMIX = 452 * MiB;
constexpr size_t WS_END = 516 * MiB;
constexpr int CW_GCNT = 1024;
constexpr int CW_BAR = 4096;
constexpr int CW_PANEL = 8192;
constexpr int RING_OFF = 0, RING_BYTES = 131072;
constexpr int LDSCTL_OFF = RING_BYTES, MISC_OFF = LDSCTL_OFF + 320;
constexpr int MOETAB_OFF = LDSCTL_OFF + 512;
constexpr int LDS_BYTES = 147456;

struct Frame {
    LAS unsigned char* lds;
    volatile LAS unsigned* MISC;
    gu32* ctl;
    int tid, lane, wave, vcu, G;
};
__device__ __forceinline__ float wave_sum(float v) {
#pragma unroll
    for (int o = 1; o < 64; o <<= 1) v += __shfl_xor(v, o);
    return v;
}
__device__ __forceinline__ float bf2f_(unsigned short b) { return __uint_as_float((unsigned)b << 16); }

__device__ __forceinline__ int hpw_row(int n) { const int c = n & 255; return (n & ~255) + 128 * ((c >> 5) & 1) + 32 * (c >> 6) + 16 * ((c >> 2) & 1) + 4 * ((c >> 3) & 3) + (c & 3); }
__device__ __forceinline__ int hpw_row16(int n) { const int c = n & 255; return (n & ~255) + 128 * ((c >> 3) & 1) + 32 * (c >> 6) + 16 * ((c >> 2) & 1) + 4 * ((c >> 4) & 3) + (c & 3); }
__device__ __forceinline__ int gu_row(int f, int which) { return (f >> 7) * 256 + 128 * ((f >> 2) & 1) + 32 * ((f >> 5) & 3) + 16 * which + 4 * ((f >> 3) & 3) + (f & 3); }

constexpr float FP8_SA = 16.0f, FP8_SWIN = 256.0f;
__device__ __forceinline__ float sat8(float x) { return __builtin_amdgcn_fmed3f(x, -448.0f, 448.0f); }
__device__ __forceinline__ unsigned pk4_fp8(float a, float b, float c, float d) { unsigned w = 0; w = __builtin_amdgcn_cvt_pk_fp8_f32(sat8(a), sat8(b), w, false); w = __builtin_amdgcn_cvt_pk_fp8_f32(sat8(c), sat8(d), w, true); return w; }
template <int MODE>
__device__ __forceinline__ void transpose_item_fp8(const float* W, int K, int N, unsigned char* WT, int row_off, LAS float* scr, int item, int lane, const float FP8_SW) {
    const int nblk = N / 32, kb = item / nblk, nb = item % nblk, k0 = 64 * kb, n0 = 32 * nb;
#pragma unroll
    for (int i = 0; i < 32; ++i) { const int kk = 2 * i + (lane >> 5); scr[kk * 33 + (lane & 31)] = W[(size_t)(k0 + kk) * N + n0 + (lane & 31)]; }
    LDS_WAIT(); asm volatile("" ::: "memory");
    const int n = lane >> 1, kh = (lane & 1) * 32; const LAS float* s = scr + kh * 33 + n;
    v4u o0, o1;
    o0.x = pk4_fp8(s[0 * 33] * FP8_SW, s[1 * 33] * FP8_SW, s[2 * 33] * FP8_SW, s[3 * 33] * FP8_SW); o0.y = pk4_fp8(s[4 * 33] * FP8_SW, s[5 * 33] * FP8_SW, s[6 * 33] * FP8_SW, s[7 * 33] * FP8_SW);
    o0.z = pk4_fp8(s[8 * 33] * FP8_SW, s[9 * 33] * FP8_SW, s[10 * 33] * FP8_SW, s[11 * 33] * FP8_SW); o0.w = pk4_fp8(s[12 * 33] * FP8_SW, s[13 * 33] * FP8_SW, s[14 * 33] * FP8_SW, s[15 * 33] * FP8_SW);
    o1.x = pk4_fp8(s[16 * 33] * FP8_SW, s[17 * 33] * FP8_SW, s[18 * 33] * FP8_SW, s[19 * 33] * FP8_SW); o1.y = pk4_fp8(s[20 * 33] * FP8_SW, s[21 * 33] * FP8_SW, s[22 * 33] * FP8_SW, s[23 * 33] * FP8_SW);
    o1.z = pk4_fp8(s[24 * 33] * FP8_SW, s[25 * 33] * FP8_SW, s[26 * 33] * FP8_SW, s[27 * 33] * FP8_SW); o1.w = pk4_fp8(s[28 * 33] * FP8_SW, s[29 * 33] * FP8_SW, s[30 * 33] * FP8_SW, s[31 * 33] * FP8_SW);
    const int drow_ = MODE == 0 ? hpw_row(n0 + n) : MODE == 3 ? hpw_row16(n0 + n) : MODE == 4 ? (n0 >= 3072 ? hpw_row16(n0 + n) : hpw_row(n0 + n)) : gu_row(n0 + n, MODE - 1);
    unsigned char* dst = WT + (size_t)(row_off + drow_) * K + k0 + kh;
    *(GAS v4u*)dst = o0; *(GAS v4u*)(dst + 16) = o1;
    LDS_WAIT(); asm volatile("" ::: "memory");
}
template <int MODE>
__device__ __forceinline__ void transpose_item(const float* W, int K, int N, pg8::bf16_t* WT, int row_off, LAS float* scr, int item, int lane) {
    const int nblk = N / 32, kb = item / nblk, nb = item % nblk, k0 = 64 * kb, n0 = 32 * nb;
#pragma unroll 8
    for (int i = 0; i < 32; ++i) { const int kk = 2 * i + (lane >> 5); scr[kk * 33 + (lane & 31)] = W[(size_t)(k0 + kk) * N + n0 + (lane & 31)]; }
    LDS_WAIT(); asm volatile("" ::: "memory");
    const int c = lane & 7;
#pragma unroll
    for (int j = 0; j < 4; ++j) { const int n = (lane >> 3) + 8 * j; const LAS float* s = scr + (8 * c) * 33 + n;
        v4u o; o.x = pk2(s[0 * 33], s[1 * 33]); o.y = pk2(s[2 * 33], s[3 * 33]); o.z = pk2(s[4 * 33], s[5 * 33]); o.w = pk2(s[6 * 33], s[7 * 33]);
        const int drow = row_off + (MODE == 0 ? hpw_row(n0 + n) : gu_row(n0 + n, MODE - 1));
        *(GAS v4u*)(WT + (size_t)drow * K + k0 + 8 * c) = o; }
    LDS_WAIT(); asm volatile("" ::: "memory");
}
struct Weights { const float *w_in, *w_pa, *w_pb, *w_o, *w_g, *w_u, *w_d; };
__device__ __forceinline__ void convert_layer(Frame& F0, const Weights& W, unsigned char* ws) {
    Frame F = F0;
    LAS float* scr = (LAS float*)(F.lds + RING_OFF + F.wave * 16384);
    const int gw = F.vcu * NWAVES + F.wave, NGW = F.G * NWAVES;
    constexpr int I_IN = 16 * 160, I_PA = 8 * 32, I_PB = 4 * 32, I_O = 16 * 32, I_G = 16 * 128, I_D = 16 * 128;
    constexpr int NITEMS = I_IN + I_PA + I_PB + I_O + 2 * I_G + I_D;
    for (int it = gw; it < NITEMS; it += NGW) {
        int r = it;
        if (r < I_IN) { transpose_item_fp8<4>(W.w_in, 1024, N_IN, ws + WS_WIN, 0, scr, r, F.lane, FP8_SWIN); continue; } r -= I_IN;
        if (r < I_PA) { transpose_item_fp8<3>(W.w_pa, 768, 1024, ws + WS_WPA, 0, scr, r, F.lane, PAB_WSCALE); continue; } r -= I_PA;
        if (r < I_PB) { transpose_item_fp8<3>(W.w_pb, 768, 1024, ws + WS_WPA + 512, 0, scr, r, F.lane, PAB_WSCALE); continue; } r -= I_PB;
        if (r < I_O) { transpose_item_fp8<3>(W.w_o, 1024, 1024, ws + WS_WO, 0, scr, r, F.lane, WO_SCALE); continue; } r -= I_O;
        if (r < I_G) { const int e = r >> 7; transpose_item_fp8<1>(W.w_g + (size_t)e * 1024 * 256, 1024, 256, ws + WS_WGU, e * 512, scr, r & 127, F.lane, GU_WSCALE); continue; } r -= I_G;
        if (r < I_G) { const int e = r >> 7; transpose_item_fp8<2>(W.w_u + (size_t)e * 1024 * 256, 1024, 256, ws + WS_WGU, e * 512, scr, r & 127, F.lane, GU_WSCALE); continue; } r -= I_G;
        { const int e = r >> 7; transpose_item_fp8<3>(W.w_d + (size_t)e * 256 * 1024, 256, 1024, ws + WS_WDN, e * 1024, scr, r & 127, F.lane, DN_WSCALE); }
    }
}

__device__ __forceinline__ void row_stats(const f32x4 (&v)[4], float& mean, float& rstd) {
    float s = 0.f;
#pragma unroll
    for (int j = 0; j < 4; ++j) s += (v[j].x + v[j].y) + (v[j].z + v[j].w);
    mean = wave_sum(s) * (1.f / DM); float s2 = 0.f;
#pragma unroll
    for (int j = 0; j < 4; ++j) { const f32x4 d = v[j] - mean; s2 += (d.x * d.x + d.y * d.y) + (d.z * d.z + d.w * d.w); }
    rstd = 1.f / sqrtf(wave_sum(s2) * (1.f / DM) + LN_EPS);
}
__device__ __forceinline__ void store_row_fp8(unsigned char* orow, int lane, const f32x4 (&v)[4]) {
    GAS unsigned* o4 = (GAS unsigned*)orow + lane;
#pragma unroll
    for (int j = 0; j < 4; ++j) o4[64 * j] = pk4_fp8(sat8(v[j].x * FP8_SA), sat8(v[j].y * FP8_SA), sat8(v[j].z * FP8_SA), sat8(v[j].w * FP8_SA));
}
__device__ __forceinline__ void store_row_bf16(pg8::bf16_t* orow, int lane, const f32x4 (&v)[4]) {
    GAS unsigned long long* o8 = (GAS unsigned long long*)orow + lane;
#pragma unroll
    for (int j = 0; j < 4; ++j) o8[64 * j] = (unsigned long long)pk2(v[j].x, v[j].y) | ((unsigned long long)pk2(v[j].z, v[j].w) << 32);
}

__device__ __forceinline__ void phase_pr0(Frame& F, const float* c, const float* w_ada, const float* b_ada, float* mod, float* rope, const Weights& W0, unsigned char* ws) {
    LAS float* condT = (LAS float*)(F.lds);
    LAS float* red = (LAS float*)(F.lds + 65536);
    for (int idx = F.tid; idx < 16 * 1024; idx += NWAVES * 64) { const int b = idx >> 10, k = idx & 1023; const float x = c[idx]; condT[k * 16 + b] = x / (1.f + __expf(-x)); }
    __syncthreads();
    for (int it = F.vcu; it < 4 * 96; it += F.G) {
        const int l = it / 96, cb = it % 96, n = cb * 64 + F.lane;
        const float* wp = w_ada + ((size_t)l * 1024 + F.wave * 128) * 6144 + n;
        float a[16];
#pragma unroll
        for (int b = 0; b < 16; ++b) a[b] = 0.f;
        for (int k0 = 0; k0 < 128; k0 += 8) {
            float wv[8];
#pragma unroll
            for (int kk = 0; kk < 8; ++kk) wv[kk] = wp[(size_t)(k0 + kk) * 6144];
#pragma unroll
            for (int kk = 0; kk < 8; ++kk) {
                const LAS f32x4* cp = (const LAS f32x4*)(condT + (F.wave * 128 + k0 + kk) * 16);
#pragma unroll
                for (int q = 0; q < 4; ++q) { const f32x4 cv = cp[q]; a[4 * q] += wv[kk] * cv.x; a[4 * q + 1] += wv[kk] * cv.y; a[4 * q + 2] += wv[kk] * cv.z; a[4 * q + 3] += wv[kk] * cv.w; }
            }
        }
#pragma unroll
        for (int b = 0; b < 16; ++b) red[(F.wave * 16 + b) * 64 + F.lane] = a[b];
        __syncthreads();
        for (int o = F.tid; o < 1024; o += NWAVES * 64) { const int b = o >> 6, nn = o & 63; float s = b_ada[(size_t)l * 6144 + cb * 64 + nn];
#pragma unroll
            for (int w = 0; w < 8; ++w) s += red[(w * 16 + b) * 64 + nn];
            mod[((size_t)l * 16 + b) * 6144 + cb * 64 + nn] = s; }
        __syncthreads();
    }
    if (F.vcu == 0 && F.tid < 16) {
        const int k = F.tid; double th = 1.0; for (int i = 0; i < k; ++i) th *= 0.5623413251903491;
        double c1 = 1.0, s1 = th; { double tc = 1.0, tsn = th; const double t2 = th * th;
            for (int i = 1; i < 14; ++i) { tc *= -t2 / ((2.0 * i - 1.0) * (2.0 * i)); tsn *= -t2 / ((2.0 * i) * (2.0 * i + 1.0)); c1 += tc; s1 += tsn; } }
        double cc = 1.0, sn = 0.0;
        for (int a = 0; a < 64; ++a) { rope[(a * 16 + k) * 2] = (float)cc; rope[(a * 16 + k) * 2 + 1] = (float)sn; const double nc = cc * c1 - sn * s1, ns = sn * c1 + cc * s1; cc = nc; sn = ns; }
    }
    __syncthreads();
    convert_layer(F, W0, ws);
}
__device__ __forceinline__ void phase_pr1(Frame& F, const float* x, const float* mod0, pg8::bf16_t* H) {
    for (int blk = F.vcu; blk < T_TOK / 128; blk += F.G) {
        const int b = blk >> 4; const float* mb = mod0 + (size_t)b * 6144;
        f32x4 sh[4], sc[4];
#pragma unroll
        for (int j = 0; j < 4; ++j) { sh[j] = *(const f32x4*)(mb + 4 * F.lane + 256 * j); sc[j] = *(const f32x4*)(mb + 1024 + 4 * F.lane + 256 * j) + 1.0f; }
        for (int k = 0; k < 16; k += 4) {
            const int row0 = blk * 128 + F.wave * 16 + k;
            f32x4 v[4][4];
#pragma unroll
            for (int q = 0; q < 4; ++q) { const GAS f32x4* xr = (const GAS f32x4*)(x + (size_t)(row0 + q) * DM) + F.lane;
#pragma unroll
                for (int j = 0; j < 4; ++j) v[q][j] = xr[64 * j]; }
#pragma unroll
            for (int q = 0; q < 4; ++q) {
                float mean, rstd; row_stats(v[q], mean, rstd);
#pragma unroll
                for (int j = 0; j < 4; ++j) v[q][j] = (v[q][j] - mean) * rstd * sc[j] + sh[j];
                store_row_fp8((unsigned char*)H + (size_t)(row0 + q) * DM, F.lane, v[q]);
            }
        }
    }
}
template <bool XF32>
__device__ __forceinline__ void phase_ln1(Frame& F0, const float* xb, const pg8::bf16_t* gmix, const float* ln_g, const float* ln_b, const float* modl, const float* w_router, const float* rbias,
                                          pg8::bf16_t* H, int* rowlist, float* gatew, gu32* gcnt, float* stats, const bool dry = false) {
    Frame F = F0;
    LAS float* wr = (LAS float*)(F.lds);
    LAS float* cst = (LAS float*)(F.lds + 65536);
    LAS int* lcnt = (LAS int*)(F.lds + 81920);
    LAS int* gbase = lcnt + 16;
    LAS int* st_e = lcnt + 32;
    LAS float* st_g = (LAS float*)(lcnt + 32 + 256);
    { f32x4 t[8];
#pragma unroll
      for (int i = 0; i < 8; ++i) t[i] = ((const f32x4*)w_router)[F.tid + NWAVES * 64 * i];
#pragma unroll
      for (int i = 0; i < 8; ++i) { const int q4 = F.tid + NWAVES * 64 * i, k = q4 >> 2, e0 = (q4 & 3) * 4;
          wr[(e0 + 0) * 1024 + k] = t[i].x; wr[(e0 + 1) * 1024 + k] = t[i].y; wr[(e0 + 2) * 1024 + k] = t[i].z; wr[(e0 + 3) * 1024 + k] = t[i].w; } }
    const float rbl = rbias[F.lane & 15];
    for (int blk = F.vcu; blk < T_TOK / 128; blk += F.G) {
        const int b = blk >> 4; const float* mb = modl + (size_t)b * 6144;
        __syncthreads();
        for (int idx = F.tid; idx < 1024; idx += NWAVES * 64) { cst[idx] = ln_g[idx]; cst[1024 + idx] = ln_b[idx]; cst[2048 + idx] = 1.0f + mb[4 * 1024 + idx]; cst[3072 + idx] = mb[3 * 1024 + idx]; }
        if (F.tid < 16) lcnt[F.tid] = 0;
        __syncthreads();
        for (int it = 0; it < 4; ++it) {
            f32x4 vv[4][4]; unsigned gm[4][4];
            const int row0 = blk * 128 + F.wave * 16 + it * 4;
#pragma unroll
            for (int q = 0; q < 4; ++q) { const GAS unsigned* gr = (const GAS unsigned*)((const unsigned char*)gmix + (size_t)(row0 + q) * DM) + F.lane;
                if constexpr (XF32) { const GAS f32x4* xr = (const GAS f32x4*)(xb + (size_t)(row0 + q) * DM) + F.lane;
#pragma unroll
                    for (int j = 0; j < 4; ++j) vv[q][j] = xr[64 * j]; }
                else { const GAS u32x2g* xr = (const GAS u32x2g*)((const pg8::bf16_t*)xb + (size_t)(row0 + q) * DM) + F.lane;
#pragma unroll
                    for (int j = 0; j < 4; ++j) { const u32x2g w = xr[64 * j]; vv[q][j].x = __uint_as_float(w.x << 16); vv[q][j].y = __uint_as_float(w.x & 0xffff0000u); vv[q][j].z = __uint_as_float(w.y << 16); vv[q][j].w = __uint_as_float(w.y & 0xffff0000u); } }
#pragma unroll
                for (int j = 0; j < 4; ++j) gm[q][j] = gr[64 * j]; }
#pragma unroll
            for (int q = 0; q < 4; ++q)
#pragma unroll
                for (int j = 0; j < 4; ++j) { typedef float f32x2v __attribute__((ext_vector_type(2))); const f32x2v g0 = __builtin_amdgcn_cvt_pk_f32_fp8(gm[q][j], false), g1 = __builtin_amdgcn_cvt_pk_f32_fp8(gm[q][j], true);
                    f32x4 g4; g4.x = g0[0] * GMIX_DESCALE; g4.y = g0[1] * GMIX_DESCALE; g4.z = g1[0] * GMIX_DESCALE; g4.w = g1[1] * GMIX_DESCALE;
                    vv[q][j] = vv[q][j] * DN_ALPHA + g4; }
            float hq[4][16];
#pragma unroll
            for (int q = 0; q < 4; ++q) {
                const int row = row0 + q;
                f32x4 v[4];
#pragma unroll
                for (int j = 0; j < 4; ++j) v[j] = vv[q][j];
                float mean, rstd; row_stats(v, mean, rstd);
                if (F.lane == 0) { stats[2 * (size_t)row] = mean; stats[2 * (size_t)row + 1] = rstd; }
#pragma unroll
                for (int j = 0; j < 4; ++j) { const f32x4 g4 = *(const LAS f32x4*)(cst + 4 * F.lane + 256 * j), b4 = *(const LAS f32x4*)(cst + 1024 + 4 * F.lane + 256 * j);
                    v[j] = (v[j] - mean) * rstd * g4 + b4; }
                row_stats(v, mean, rstd);
#pragma unroll
                for (int j = 0; j < 4; ++j) { const f32x4 s4 = *(const LAS f32x4*)(cst + 2048 + 4 * F.lane + 256 * j), h4 = *(const LAS f32x4*)(cst + 3072 + 4 * F.lane + 256 * j);
                    v[j] = (v[j] - mean) * rstd * s4 + h4; hq[q][4 * j] = v[j].x; hq[q][4 * j + 1] = v[j].y; hq[q][4 * j + 2] = v[j].z; hq[q][4 * j + 3] = v[j].w; }
                store_row_fp8((unsigned char*)H + (size_t)row * DM, F.lane, v);
            }
            float ac[64];
            typedef float f32x2r __attribute__((ext_vector_type(2)));
#pragma unroll
            for (int e = 0; e < 16; ++e) {
                f32x2r a0 = {0.f, 0.f}, a1 = {0.f, 0.f}, a2 = {0.f, 0.f}, a3 = {0.f, 0.f};
#pragma unroll
                for (int j = 0; j < 4; ++j) { const f32x4 w4 = *(const LAS f32x4*)(wr + e * 1024 + 256 * j + 4 * F.lane);
                    const f32x2r wl = {w4.x, w4.y}, wh = {w4.z, w4.w};
                    a0 = (f32x2r){hq[0][4 * j], hq[0][4 * j + 1]} * wl + a0; a0 = (f32x2r){hq[0][4 * j + 2], hq[0][4 * j + 3]} * wh + a0;
                    a1 = (f32x2r){hq[1][4 * j], hq[1][4 * j + 1]} * wl + a1; a1 = (f32x2r){hq[1][4 * j + 2], hq[1][4 * j + 3]} * wh + a1;
                    a2 = (f32x2r){hq[2][4 * j], hq[2][4 * j + 1]} * wl + a2; a2 = (f32x2r){hq[2][4 * j + 2], hq[2][4 * j + 3]} * wh + a2;
                    a3 = (f32x2r){hq[3][4 * j], hq[3][4 * j + 1]} * wl + a3; a3 = (f32x2r){hq[3][4 * j + 2], hq[3][4 * j + 3]} * wh + a3; }
                ac[e] = a0.x + a0.y; ac[16 + e] = a1.x + a1.y; ac[32 + e] = a2.x + a2.y; ac[48 + e] = a3.x + a3.y;
            }
#pragma unroll
            for (int s = 5; s >= 0; --s) { const int half = 1 << s; const bool up = (F.lane >> s) & 1;
#pragma unroll
                for (int i = 0; i < half; ++i) { const float keep = up ? ac[i + half] : ac[i], send = up ? ac[i] : ac[i + half]; ac[i] = keep + __shfl_xor(send, half); } }
            {
                const int L = F.lane, rowb = L & ~15, quadb = L & ~3;
                const float score = 1.0f / (1.0f + __expf(-ac[0])), selv = score + rbl;
                const float a = __shfl(selv, quadb), bb = __shfl(selv, quadb + 1), cc = __shfl(selv, quadb + 2), d = __shfl(selv, quadb + 3);
                const float hi1 = fmaxf(a, bb), lo1 = fminf(a, bb), hi2 = fmaxf(cc, d), lo2 = fminf(cc, d);
                const float gsq = fmaxf(hi1, hi2) + fmaxf(fminf(hi1, hi2), fmaxf(lo1, lo2));
                float gs[4];
#pragma unroll
                for (int g = 0; g < 4; ++g) gs[g] = __shfl(gsq, rowb + 4 * g);
                int best = 0; float bv = gs[0];
#pragma unroll
                for (int g = 1; g < 4; ++g) if (gs[g] > bv) { bv = gs[g]; best = g; }
                float s4[4], c4[4];
#pragma unroll
                for (int k = 0; k < 4; ++k) { s4[k] = __shfl(selv, rowb + 4 * best + k); c4[k] = __shfl(score, rowb + 4 * best + k); }
                int i1 = 0; float v1 = s4[0];
#pragma unroll
                for (int k = 1; k < 4; ++k) if (s4[k] > v1) { v1 = s4[k]; i1 = k; }
                int i2 = -1; float v2 = -INFINITY;
#pragma unroll
                for (int k = 0; k < 4; ++k) if (k != i1 && s4[k] > v2) { v2 = s4[k]; i2 = k; }
                if (i2 < 0) i2 = (i1 + 1) & 3;
                const float t1 = i1 == 0 ? c4[0] : i1 == 1 ? c4[1] : i1 == 2 ? c4[2] : c4[3];
                const float t2 = i2 == 0 ? c4[0] : i2 == 1 ? c4[1] : i2 == 2 ? c4[2] : c4[3];
                const float inv = 1.0f / (t1 + t2);
                if ((L & 15) == 0 && !dry) {
                    const int rl = F.wave * 16 + it * 4 + (L >> 4), e1 = 4 * best + i1, e2 = 4 * best + i2;
                    const int p1 = atomicAdd((int*)(lcnt + e1), 1), p2 = atomicAdd((int*)(lcnt + e2), 1);
                    st_e[2 * rl] = e1 | (p1 << 8); st_g[2 * rl] = t1 * inv; st_e[2 * rl + 1] = e2 | (p2 << 8); st_g[2 * rl + 1] = t2 * inv;
                }
            }
        }
        __syncthreads();
        if (F.tid < 16 && !dry) gbase[F.tid] = (int)__hip_atomic_fetch_add(gcnt + F.tid, (unsigned)lcnt[F.tid], __ATOMIC_RELAXED, __HIP_MEMORY_SCOPE_AGENT);
        __syncthreads();
        if (F.tid < 256 && !dry) { const int ee = st_e[F.tid], e = ee & 255, lp = ee >> 8, pos = gbase[e] + lp;
            rowlist[(size_t)e * CAP + pos] = ((blk * 128 + (F.tid >> 1)) << 1) | (F.tid & 1); gatew[(size_t)e * CAP + pos] = st_g[F.tid]; }
    }
    __syncthreads();
}
template <bool XF32> struct Ln2Raw { typename std::conditional<XF32, f32x4, u32x2g>::type x[2][4]; unsigned ya[2][4], yb[2][4], gm[2][4]; float st[2][2]; };
template <bool XF32, bool OUTF32>
__device__ __forceinline__ void phase_ln2(Frame& F0, const float* xb, const pg8::bf16_t* gmix, const pg8::bf16_t* y2, const float* stats, const float* ln1_g, const float* ln1_b, const float* ln_g, const float* ln_b, const float* modl, const float* modn, pg8::bf16_t* H, float* xdst) {
    Frame F = F0;
    LAS float* const PRM = (LAS float*)(F.lds + RING_OFF);
    for (int blk = F.vcu; blk < T_TOK / 128; blk += F.G) {
        const int b = blk >> 4; const float* mb = modl + (size_t)b * 6144 + 5 * 1024;
        __syncthreads();
        { const int c4 = F.tid & 255;
          if (F.tid < 256) { *(LAS f32x4*)(PRM + 0 * 1024 + 4 * c4) = *(const f32x4*)(ln1_g + 4 * c4); *(LAS f32x4*)(PRM + 1 * 1024 + 4 * c4) = *(const f32x4*)(ln1_b + 4 * c4);
                             *(LAS f32x4*)(PRM + 2 * 1024 + 4 * c4) = *(const f32x4*)(mb + 4 * c4);    *(LAS f32x4*)(PRM + 3 * 1024 + 4 * c4) = *(const f32x4*)(ln_g + 4 * c4); }
          else { *(LAS f32x4*)(PRM + 4 * 1024 + 4 * c4) = *(const f32x4*)(ln_b + 4 * c4);
                 if (modn) { const float* mn = modn + (size_t)b * 6144; *(LAS f32x4*)(PRM + 5 * 1024 + 4 * c4) = *(const f32x4*)(mn + 1024 + 4 * c4) + 1.0f; *(LAS f32x4*)(PRM + 6 * 1024 + 4 * c4) = *(const f32x4*)(mn + 4 * c4); } } }
        __syncthreads();
#define LN2_PRM(a, j) (*(const LAS f32x4*)(PRM + (a) * 1024 + 4 * F.lane + 256 * (j)))
        const int rowb = blk * 128 + F.wave * 16;
        auto load2 = [&](Ln2Raw<XF32>& R, const int row0) __attribute__((always_inline)) {
#pragma unroll
            for (int q = 0; q < 2; ++q) { R.st[q][0] = stats[2 * (size_t)(row0 + q)]; R.st[q][1] = stats[2 * (size_t)(row0 + q) + 1]; }
#pragma unroll
            for (int q = 0; q < 2; ++q) {
                if constexpr (XF32) { const GAS f32x4* xr = (const GAS f32x4*)(xb + (size_t)(row0 + q) * DM) + F.lane;
#pragma unroll
                    for (int j = 0; j < 4; ++j) R.x[q][j] = xr[64 * j]; }
                else { const GAS u32x2g* xr = (const GAS u32x2g*)((const pg8::bf16_t*)xb + (size_t)(row0 + q) * DM) + F.lane;
#pragma unroll
                    for (int j = 0; j < 4; ++j) R.x[q][j] = xr[64 * j]; }
                const GAS unsigned* pa = (const GAS unsigned*)((const unsigned char*)y2 + (size_t)(row0 + q) * DM) + F.lane; const GAS unsigned* pb = (const GAS unsigned*)((const unsigned char*)y2 + ((size_t)T_TOK + row0 + q) * DM) + F.lane;
                const GAS unsigned* gr = (const GAS unsigned*)((const unsigned char*)gmix + (size_t)(row0 + q) * DM) + F.lane;
#pragma unroll
                for (int j = 0; j < 4; ++j) { R.ya[q][j] = pa[64 * j]; R.yb[q][j] = pb[64 * j]; R.gm[q][j] = gr[64 * j]; } } };
        auto norm2 = [&](const Ln2Raw<XF32>& R, const int row0) __attribute__((always_inline)) {
            f32x4 v[2][4];
#pragma unroll
            for (int j = 0; j < 4; ++j) { asm volatile("" ::: "memory"); const f32x4 l1g = LN2_PRM(0, j), l1b = LN2_PRM(1, j), g2 = LN2_PRM(2, j);
#pragma unroll
                for (int q = 0; q < 2; ++q) { const unsigned a = R.ya[q][j], c = R.yb[q][j];
                    typedef float f32x2v __attribute__((ext_vector_type(2)));
                    const f32x2v a0 = __builtin_amdgcn_cvt_pk_f32_fp8(a, false), a1 = __builtin_amdgcn_cvt_pk_f32_fp8(a, true), c0 = __builtin_amdgcn_cvt_pk_f32_fp8(c, false), c1 = __builtin_amdgcn_cvt_pk_f32_fp8(c, true);
                    f32x4 ff; ff.x = (a0[0] + c0[0]) * Y2_DESCALE; ff.y = (a0[1] + c0[1]) * Y2_DESCALE; ff.z = (a1[0] + c1[0]) * Y2_DESCALE; ff.w = (a1[1] + c1[1]) * Y2_DESCALE;
                    const f32x2v gg0 = __builtin_amdgcn_cvt_pk_f32_fp8(R.gm[q][j], false), gg1 = __builtin_amdgcn_cvt_pk_f32_fp8(R.gm[q][j], true);
                    f32x4 g4; g4.x = gg0[0] * GMIX_DESCALE; g4.y = gg0[1] * GMIX_DESCALE; g4.z = gg1[0] * GMIX_DESCALE; g4.w = gg1[1] * GMIX_DESCALE;
                    f32x4 xq;
                    if constexpr (XF32) xq = R.x[q][j];
                    else { const u32x2g w = R.x[q][j]; xq.x = __uint_as_float(w.x << 16); xq.y = __uint_as_float(w.x & 0xffff0000u); xq.z = __uint_as_float(w.y << 16); xq.w = __uint_as_float(w.y & 0xffff0000u); }
                    const f32x4 y1 = xq * DN_ALPHA + g4;
                    const f32x4 x1 = (y1 - R.st[q][0]) * R.st[q][1] * l1g + l1b;
                    v[q][j] = x1 * DN_ALPHA + g2 * ff; } }
            float mean[2], rstd[2];
#pragma unroll
            for (int q = 0; q < 2; ++q) row_stats(v[q], mean[q], rstd[q]);
#pragma unroll
            for (int j = 0; j < 4; ++j) { asm volatile("" ::: "memory"); const f32x4 lg = LN2_PRM(3, j), lb = LN2_PRM(4, j);
#pragma unroll
                for (int q = 0; q < 2; ++q) v[q][j] = (v[q][j] - mean[q]) * rstd[q] * lg + lb; }
#pragma unroll
            for (int q = 0; q < 2; ++q) { const int row = row0 + q;
                if constexpr (OUTF32) { GAS f32x4* xr = (GAS f32x4*)(xdst + (size_t)row * DM) + F.lane;
#pragma unroll
                    for (int j = 0; j < 4; ++j) xr[64 * j] = v[q][j]; }
                else store_row_bf16((pg8::bf16_t*)xdst + (size_t)row * DM, F.lane, v[q]); }
            if (modn) {
#pragma unroll
                for (int q = 0; q < 2; ++q) row_stats(v[q], mean[q], rstd[q]);
#pragma unroll
                for (int j = 0; j < 4; ++j) { asm volatile("" ::: "memory"); const f32x4 s4 = LN2_PRM(5, j), h4 = LN2_PRM(6, j);
#pragma unroll
                    for (int q = 0; q < 2; ++q) v[q][j] = (v[q][j] - mean[q]) * rstd[q] * s4 + h4; }
#pragma unroll
                for (int q = 0; q < 2; ++q) store_row_fp8((unsigned char*)H + (size_t)(row0 + q) * DM, F.lane, v[q]);
            } };
        Ln2Raw<XF32> RA, RB;
        load2(RA, rowb);
#pragma nounroll
        for (int k = 0; k < 16; k += 4) {
            load2(RB, rowb + k + 2);
            norm2(RA, rowb + k);
            if (k + 4 < 16) load2(RA, rowb + k + 4);
            norm2(RB, rowb + k + 2);
        }
#undef LN2_PRM
    }
    __syncthreads();
}
__device__ __forceinline__ void phase_combine(Frame& F0, const pg8::bf16_t* OD, const float* LSE, pg8::bf16_t* OUTB, gu32* pcnt) {
    Frame F = F0;
    const int hh = F.lane >> 4, d4 = (F.lane & 15) * 4;
    for (int blk = F.vcu; blk < T_TOK / 128; blk += F.G) {
        const int b = blk >> 4;
        for (int k = 0; k < 16; k += 8) {
            unsigned ov[8][3]; float ls[8][3];
#pragma unroll
            for (int q = 0; q < 8; ++q) { const int s = (blk & 15) * 128 + F.wave * 16 + k + q;
#pragma unroll
                for (int g = 0; g < 3; ++g) { const size_t rg = (size_t)(b * 12 + g * 4 + hh) * SEQ + pg8::pg_perm(g, s);
                    ls[q][g] = LSE[rg]; ov[q][g] = *(const GAS unsigned*)((const unsigned char*)OD + rg * 64 + d4); } }
#pragma unroll
            for (int q = 0; q < 8; ++q) { const int s = (blk & 15) * 128 + F.wave * 16 + k + q;
                const float m = fmaxf(fmaxf(ls[q][0], ls[q][1]), ls[q][2]);
                const float w0 = __builtin_amdgcn_exp2f(ls[q][0] - m), w1 = __builtin_amdgcn_exp2f(ls[q][1] - m), w2 = __builtin_amdgcn_exp2f(ls[q][2] - m), inv = 1.0f / (w0 + w1 + w2);
                float o[4];
                { typedef float f32x2v __attribute__((ext_vector_type(2)));
                  const f32x2v a0 = __builtin_amdgcn_cvt_pk_f32_fp8(ov[q][0], false), a1 = __builtin_amdgcn_cvt_pk_f32_fp8(ov[q][0], true), b0 = __builtin_amdgcn_cvt_pk_f32_fp8(ov[q][1], false), b1 = __builtin_amdgcn_cvt_pk_f32_fp8(ov[q][1], true),
                              c0 = __builtin_amdgcn_cvt_pk_f32_fp8(ov[q][2], false), c1 = __builtin_amdgcn_cvt_pk_f32_fp8(ov[q][2], true);
                  const float is_ = inv * (1.0f / attn_body::OUT_SCALE);
                  o[0] = (w0 * a0[0] + w1 * b0[0] + w2 * c0[0]) * is_; o[1] = (w0 * a0[1] + w1 * b0[1] + w2 * c0[1]) * is_;
                  o[2] = (w0 * a1[0] + w1 * b1[0] + w2 * c1[0]) * is_; o[3] = (w0 * a1[1] + w1 * b1[1] + w2 * c1[1]) * is_; }
                __hip_atomic_store((GAS unsigned*)((unsigned char*)OUTB + ((size_t)b * SEQ + s) * 768 + 512 + hh * 64 + d4), pk4_fp8(sat8(o[0] * PAB_ASCALE), sat8(o[1] * PAB_ASCALE), sat8(o[2] * PAB_ASCALE), sat8(o[3] * PAB_ASCALE)), __ATOMIC_RELAXED, __HIP_MEMORY_SCOPE_AGENT); }
        }
        VM_WAIT();
        if (F.lane == 0) (void)__hip_atomic_fetch_add(pcnt + 16 * (blk >> 1), 1u, __ATOMIC_RELAXED, __HIP_MEMORY_SCOPE_AGENT);
    }
}
__device__ __forceinline__ void moe_table(Frame& F, gu32* gcnt) {
    LAS int* tab = (LAS int*)(F.lds + MOETAB_OFF);
    __syncthreads();
    if (F.wave == 0) {
        const int ln = hw_lane(); int c = 0;
        if (ln < 16) { c = (int)__hip_atomic_load(gcnt + ln, __ATOMIC_RELAXED, __HIP_MEMORY_SCOPE_AGENT); if (c > CAP) c = CAP; if (c < 0) c = 0; }
        const int tiles = (c + 255) >> 8; int inc = tiles;
#pragma unroll
        for (int o = 1; o < 16; o <<= 1) { const int t = __shfl_up(inc, o); if (ln >= o) inc += t; }
        if (ln < 16) { tab[ln] = c; tab[16 + ln] = inc - tiles; }
        if (ln == 15) tab[32] = inc; }
    __syncthreads();
}
struct Args { const float* in[19]; float* out; unsigned char* ws; int ph_lo, ph_hi; };
typedef const __attribute__((address_space(4))) Args* KArgs;
__device__ __forceinline__ Weights layer_weights(KArgs ap_, int l) {
    struct { const float* in[19]; } a; a.in[4] = ap_->in[4]; a.in[7] = ap_->in[7]; a.in[8] = ap_->in[8]; a.in[9] = ap_->in[9]; a.in[14] = ap_->in[14]; a.in[15] = ap_->in[15]; a.in[16] = ap_->in[16];
    Weights W; W.w_in = a.in[4] + (size_t)l * 1024 * N_IN; W.w_pa = a.in[7] + (size_t)l * 512 * 1024; W.w_pb = a.in[8] + (size_t)l * 256 * 1024; W.w_o = a.in[9] + (size_t)l * 1024 * 1024;
    W.w_g = a.in[14] + (size_t)l * 16 * 1024 * 256; W.w_u = a.in[15] + (size_t)l * 16 * 1024 * 256; W.w_d = a.in[16] + (size_t)l * 16 * 256 * 1024; return W;
}
#ifndef SKIPMASK
#define SKIPMASK 0
#endif
#define IN(k) (lo <= (k) && (k) < hi)
#define SEAM(k) do { if (IN(k) && IN((k) + 1)) { XcdBarrier b2_ = bar; asm volatile("" : "+s"(b2_.x), "+s"(b2_.bar)); int w0_ = F.wave; asm volatile("" : "+s"(w0_)); REPS(20) xcd_barrier(b2_, w0_ == 0 && hw_lane() == 0); } } while (0)
#ifndef PROBE_DUP
#define PROBE_DUP -1
#endif
#define REPS(k) _Pragma("unroll") for (int rep_ = 0; rep_ < ((PROBE_DUP) == (k) ? 2 : 1); ++rep_)
#define PHASE_ARGS KArgs ap = kargs; int bx_ = (int)blockIdx.x; Frame FF = F; asm volatile("" : "+s"(ap), "+s"(bx_), "+s"(FF.G), "+s"(FF.vcu), "+s"(FF.wave)); FF.lane = hw_lane(); FF.tid = FF.wave * 64 + FF.lane; unsigned char* const ws = ap->ws; (void)ws; (void)bx_
template <int l>
__device__ __forceinline__ void layer_phases(Frame& F, const KArgs kargs, const int lo, const int hi, const XcdBarrier& bar, unsigned char* lds) {
    using pg8::bf16_t;
    const LAS int* tab = (const LAS int*)(F.lds + MOETAB_OFF);
    {
        const int P = 2 + PPL * l;
        if (IN(P + 0)) {
            PHASE_ARGS;
            pg8::Gemm g{(const bf16_t*)(ws + WS_H), (const bf16_t*)(ws + WS_WIN), T_TOK, N_IN, 1024}; pg8::StaticOrder S; S.init(T_TOK, N_IN, FF.G, bx_);
            pg8::EpiIn E{(bf16_t*)(ws + WS_QA), (bf16_t*)(ws + WS_KA), (bf16_t*)(ws + WS_VA), (bf16_t*)(ws + WS_QD), (bf16_t*)(ws + WS_KD), (bf16_t*)(ws + WS_VDT), (bf16_t*)(ws + WS_G),
                         ap->in[5] + l * 64, ap->in[6] + l * 64, (const float*)(ws + WS_ROPE)};
#ifdef IN_STAGGER
            { const unsigned long long t0_ = __builtin_amdgcn_s_memrealtime(), dl_ = (unsigned long long)(FF.vcu & 3) * IN_STAGGER;
              while (__builtin_amdgcn_s_memrealtime() - t0_ < dl_) __builtin_amdgcn_s_sleep(8); }
#endif
            REPS(0) { pg8::gemm_phase<pg8::EpiIn, pg8::StaticOrder, true, false, true>(F.lds + RING_OFF, g, S, E, FF.wave);
#ifdef PROBE_BAR
              if (rep_ == 0) { XcdBarrier b3_ = bar; asm volatile("" : "+s"(b3_.x), "+s"(b3_.bar)); xcd_barrier(b3_, FF.wave == 0 && hw_lane() == 0); }
#endif
            }
            SEAM(P + 0);
        }
        if (IN(P + 1)) {
            PHASE_ARGS;
            { const attn_body::AttnTensors BT{(const attn_body::bf16*)(ws + WS_QD), (const attn_body::bf16*)(ws + WS_KD), (const attn_body::bf16*)(ws + WS_VDT), (attn_body::bf16*)(ws + WS_QD), ws + WS_H + 24 * MiB};
              const attn_body::OrderB S{FF.vcu, FF.G, BT, (float*)(ws + WS_LSE)};
              attn_body::attn_phase<attn_body::CfgB, attn_body::OrderB>((char*)lds + RING_OFF, S, FF.wave); }
            { const attn_body::AttnTensors AT{(const attn_body::bf16*)(ws + WS_QA), (const attn_body::bf16*)(ws + WS_KA), (const attn_body::bf16*)(ws + WS_VA), (attn_body::bf16*)(ws + WS_QA), ws + WS_H};
              const attn_body::OrderA S{FF.vcu, FF.G, AT};
              attn_body::attn_phase<attn_body::CfgA, attn_body::OrderA>((char*)lds + RING_OFF, S, FF.wave); }
            SEAM(P + 1);
        }
        if (IN(P + 2)) {
            PHASE_ARGS;
            gu32* const pcnt = F.ctl + CW_PANEL + 2048 * l;
            phase_combine(FF, (const bf16_t*)(ws + WS_H + 24 * MiB), (const float*)(ws + WS_LSE), (bf16_t*)(ws + WS_H), pcnt);
            { pg8::StaticOrder S; S.init(T_TOK, 1024, FF.G, bx_);
              if (FF.wave == 0) {
                  pg8::Unit u; unsigned sp = 0;
                  for (int i = 0; S.next(i, u); ++i)
                      while (__builtin_amdgcn_readfirstlane((int)__hip_atomic_load(pcnt + 16 * u.pm, __ATOMIC_RELAXED, __HIP_MEMORY_SCOPE_AGENT)) < 16) { __builtin_amdgcn_s_sleep(2); if (++sp > (1u << 22)) break; } }
              VM_WAIT(); __builtin_amdgcn_fence(__ATOMIC_ACQUIRE, "agent"); VM_WAIT(); __syncthreads();
              pg8::Gemm g{(const bf16_t*)(ws + WS_H), (const bf16_t*)(ws + WS_WPA), T_TOK, 1024, 768};
              pg8::EpiMergeF E{(const bf16_t*)(ws + WS_G), (bf16_t*)(ws + WS_MERGED)};
              pg8::gemm_phase<pg8::EpiMergeF, pg8::StaticOrder, true, false, true, true>(F.lds + RING_OFF, g, S, E, FF.wave); }
            SEAM(P + 2);
        }
        if (IN(P + 4)) {
            PHASE_ARGS;
            pg8::Gemm g{(const bf16_t*)(ws + WS_MERGED), (const bf16_t*)(ws + WS_WO), T_TOK, 1024, 1024}; pg8::StaticOrder S; S.init(T_TOK, 1024, FF.G, bx_);
            REPS(3) { pg8::EpiRes E{(bf16_t*)(ws + WS_GMIX), (const float*)(ws + WS_MOD) + (size_t)l * 16 * 6144 + 2 * 1024};
            pg8::gemm_phase<pg8::EpiRes, pg8::StaticOrder, true, false, true>(F.lds + RING_OFF, g, S, E, FF.wave); }
            SEAM(P + 4);
        }
        if (IN(P + 5)) {
            PHASE_ARGS;
            if ((PROBE_DUP) == 40) { phase_ln1<l == 0>(FF, l == 0 ? ap->in[0] : (const float*)(ws + WS_XS), (const bf16_t*)(ws + WS_GMIX), ap->in[10] + l * 1024, ap->in[11] + l * 1024, (const float*)(ws + WS_MOD) + (size_t)l * 16 * 6144, ap->in[12], ap->in[13], (bf16_t*)(ws + WS_QD),
                      (int*)(ws + WS_ROWLIST), (float*)(ws + WS_GATEW), F.ctl + CW_GCNT + 64 * l, (float*)(ws + WS_LSE), true); VM_WAIT(); __syncthreads(); }
            phase_ln1<l == 0>(FF, l == 0 ? ap->in[0] : (const float*)(ws + WS_XS), (const bf16_t*)(ws + WS_GMIX), ap->in[10] + l * 1024, ap->in[11] + l * 1024, (const float*)(ws + WS_MOD) + (size_t)l * 16 * 6144, ap->in[12], ap->in[13], (bf16_t*)(ws + WS_H),
                      (int*)(ws + WS_ROWLIST), (float*)(ws + WS_GATEW), F.ctl + CW_GCNT + 64 * l, (float*)(ws + WS_STATS));
            SEAM(P + 5);
        }
        if (IN(P + 6)) {
            PHASE_ARGS;
            moe_table(FF, F.ctl + CW_GCNT + 64 * l);
            pg8::Gemm g{(const bf16_t*)(ws + WS_H), (const bf16_t*)(ws + WS_WGU), T_TOK, 512, 1024};
            pg8::MoeOrder<true> S{tab, (const int*)(ws + WS_ROWLIST), 2, FF.G, bx_};
            pg8::EpiGU E{(bf16_t*)(ws + WS_ACT), (const float*)(ws + WS_GATEW), tab};
            REPS(5) pg8::gemm_phase<pg8::EpiGU, pg8::MoeOrder<true>, true, true, true>(F.lds + RING_OFF, g, S, E, FF.wave);
            SEAM(P + 6);
        }
        if (IN(P + 7)) {
            PHASE_ARGS;
            moe_table(FF, F.ctl + CW_GCNT + 64 * l);
            pg8::Gemm g{(const bf16_t*)(ws + WS_ACT), (const bf16_t*)(ws + WS_WDN), T_TOK, 1024, 256};
            pg8::MoeOrder<false> S{tab, (const int*)(ws + WS_ROWLIST), 4, FF.G, bx_};
            pg8::EpiDown E{(bf16_t*)(ws + WS_Y2), (const int*)(ws + WS_ROWLIST), tab};
            REPS(6) { pg8::gemm_phase<pg8::EpiDown, pg8::MoeOrder<false>, true, false, true>(F.lds + RING_OFF, g, S, E, FF.wave); VM_WAIT(); __syncthreads(); }
            SEAM(P + 7);
        }
        if (IN(P + 8)) {
            PHASE_ARGS;
            const float* modl = (const float*)(ws + WS_MOD) + (size_t)l * 16 * 6144;
            if ((PROBE_DUP) == 41) { phase_ln2<l == 0, true>(FF, l == 0 ? ap->in[0] : (const float*)(ws + WS_XS), (const bf16_t*)(ws + WS_GMIX), (const bf16_t*)(ws + WS_Y2), (const float*)(ws + WS_STATS), ap->in[10] + l * 1024, ap->in[11] + l * 1024, ap->in[17] + l * 1024, ap->in[18] + l * 1024, modl, l + 1 < DEPTH ? modl + 16 * 6144 : nullptr, (bf16_t*)(ws + WS_OUTB), (float*)(ws + WS_QA)); VM_WAIT(); __syncthreads(); }
            phase_ln2<l == 0, l + 1 == DEPTH>(FF, l == 0 ? ap->in[0] : (const float*)(ws + WS_XS), (const bf16_t*)(ws + WS_GMIX), (const bf16_t*)(ws + WS_Y2), (const float*)(ws + WS_STATS), ap->in[10] + l * 1024, ap->in[11] + l * 1024, ap->in[17] + l * 1024, ap->in[18] + l * 1024, modl, l + 1 < DEPTH ? modl + 16 * 6144 : nullptr, (bf16_t*)(ws + WS_H), l + 1 == DEPTH ? ap->out : (float*)(ws + WS_XS));
            if (l + 1 < DEPTH) { __syncthreads(); const Weights Wn = layer_weights(ap, l + 1); REPS(7) convert_layer(FF, Wn, ws); }
            SEAM(P + 8);
        }
    }
}
__global__ void __launch_bounds__(NWAVES * 64, 2) fwd_kernel(Args args_unused) {
    extern __shared__ __attribute__((aligned(16))) unsigned char lds[];
    Frame F;
    F.lds = (LAS unsigned char*)lds;
    F.MISC = (volatile LAS unsigned*)(F.lds + MISC_OFF);
    F.wave = __builtin_amdgcn_readfirstlane((int)threadIdx.x >> 6); F.lane = hw_lane(); F.tid = F.wave * 64 + F.lane;
    F.G = gridDim.x; { const int bx = blockIdx.x; F.vcu = (F.G % 8 == 0) ? (bx % 8) * (F.G / 8) + bx / 8 : bx; }
    const KArgs kargs = (KArgs)__builtin_amdgcn_kernarg_segment_ptr();
    F.ctl = (gu32*)(kargs->ws + WS_CTL);
    for (int u = F.tid; u < (LDS_BYTES - LDSCTL_OFF) / 4; u += NWAVES * 64) ((LAS unsigned*)(F.lds + LDSCTL_OFF))[u] = 0u;
    __syncthreads();
    const int lo = kargs->ph_lo, hi = kargs->ph_hi;
    XcdBarrier bar; bar.bar = (unsigned*)(F.ctl + CW_BAR); bar.x = 0; bar.st = nullptr;
    if (hi - lo > 1) bar = xcd_barrier_post((unsigned*)(F.ctl + CW_BAR), F.MISC + 8);
    using pg8::bf16_t;
    const LAS int* tab = (const LAS int*)(F.lds + MOETAB_OFF);

    if (IN(0)) { PHASE_ARGS; const Weights W0 = layer_weights(ap, 0); REPS(30) { phase_pr0(FF, ap->in[1], ap->in[2], ap->in[3], (float*)(ws + WS_MOD), (float*)(ws + WS_ROPE), W0, ws); VM_WAIT(); __syncthreads(); } SEAM(0); }
    if (IN(1)) { PHASE_ARGS; REPS(31) phase_pr1(FF, ap->in[0], (const float*)(ws + WS_MOD), (bf16_t*)(ws + WS_H)); SEAM(1); }

    layer_phases<0>(F, kargs, lo, hi, bar, lds); layer_phases<1>(F, kargs, lo, hi, bar, lds); layer_phases<2>(F, kargs, lo, hi, bar, lds); layer_phases<3>(F, kargs, lo, hi, bar, lds);
#undef IN
#undef SEAM
#undef PHASE_ARGS
}

extern "C" void kernel_launch(void* const* d_in, const int* in_sizes, int n_in, void* d_out, int out_size, void* d_ws, size_t ws_size, hipStream_t stream) {
    static int grid = 0;
    if (grid == 0) {
        if (n_in != 19 || in_sizes[0] != T_TOK * DM || out_size != T_TOK * DM || ws_size < WS_END) { fprintf(stderr, "kernel_launch: unexpected shapes/workspace (n_in %d, ws %zu); nothing launched\n", n_in, ws_size); grid = -1; return; }
        int dev = 0, cus = 0, per_cu = 0;
        if (hipGetDevice(&dev) != hipSuccess || hipDeviceGetAttribute(&cus, hipDeviceAttributeMultiprocessorCount, dev) != hipSuccess) { grid = -1; return; }
        if (hipFuncSetAttribute((const void*)fwd_kernel, hipFuncAttributeMaxDynamicSharedMemorySize, LDS_BYTES) != hipSuccess) { fprintf(stderr, "kernel_launch: hipFuncSetAttribute failed\n"); grid = -1; return; }
        if (hipOccupancyMaxActiveBlocksPerMultiprocessor(&per_cu, (const void*)fwd_kernel, NWAVES * 64, LDS_BYTES) != hipSuccess || per_cu < 1) { fprintf(stderr, "kernel_launch: occupancy query reports %d\n", per_cu); }
        (void)hipGetLastError();
        grid = cus;
    }
    if (grid < 0) return;
    if (hipMemsetAsync((char*)d_ws + WS_CTL, 0, CTL_ZERO_BYTES, stream) != hipSuccess) return;
    Args a{};
    for (int i = 0; i < 19; ++i) a.in[i] = (const float*)d_in[i];
    a.out = (float*)d_out; a.ws = (unsigned char*)d_ws;
#if MK_N_LAUNCHES == 1
    a.ph_lo = 0; a.ph_hi = N_PHASES;
    hipLaunchKernelGGL(fwd_kernel, dim3(grid), dim3(NWAVES * 64), LDS_BYTES, stream, a);
#else
    for (int p = 0; p < N_PHASES; ++p) { a.ph_lo = p; a.ph_hi = p + 1; hipLaunchKernelGGL(fwd_kernel, dim3(grid), dim3(NWAVES * 64), LDS_BYTES, stream, a); }
#endif
}
```

```cpp
#include <hip/hip_runtime.h>
#include <hip/hip_bf16.h>
#include <cstdio>
#include <cstdint>
#include <cmath>
__device__ __forceinline__ int hw_lane() { int l; asm volatile("v_mbcnt_lo_u32_b32 %0, -1, 0\n\tv_mbcnt_hi_u32_b32 %0, -1, %0" : "=v"(l)); return l; }
namespace pg8 {
#define PG8_LAS __attribute__((address_space(3)))
typedef unsigned short bf16_t;
typedef short bf16x8 __attribute__((ext_vector_type(8)));
typedef float f32x4 __attribute__((ext_vector_type(4)));
typedef unsigned u32x4 __attribute__((ext_vector_type(4)));
typedef unsigned u32x2 __attribute__((ext_vector_type(2)));
typedef int i32x4 __attribute__((ext_vector_type(4)));
typedef int i32x8 __attribute__((ext_vector_type(8)));
constexpr int BM = 256, BK = 64, HALF = 128, HTB = HALF * BK * 2  , STAGE_BYTES = 8 * HTB, NXCD = 8, WGM = 8;

__host__ __device__ __forceinline__ int lds_byte(int r, int c) { const int st = (r >> 4) * 2 + (c >> 5), rr = r & 15, cc = c & 31, ob = rr * 64 + cc * 2; return st * 1024 + (ob ^ (((ob >> 9) & 1) << 5)); }
__host__ __device__ __forceinline__ void stage_rc(int b, int& R, int& C) { const int st = b / 1024, sb = b % 1024, swz = sb ^ (((sb >> 9) & 1) << 5); R = (st >> 1) * 16 + swz / 64; C = (st & 1) * 32 + (swz % 64) / 2; }

struct Unit { int pm, pn, e, lt; };
struct Gemm { const bf16_t* A; const bf16_t* Bt; int M, N, K; };

struct StaticOrder {
    int nM, nN, nwg, G, c, rot;
    __host__ __device__ void init(int M, int N, int G_, int c_) { nM = M / BM; nN = N / BM; nwg = nM * nN; G = G_; c = c_; rot = 0; }
    __host__ __device__ bool next(int i, Unit& u) const {
        const long L = (long)i * G + c; if (L >= nwg) return false;
        int wgid = (int)L; { const int q = nwg / NXCD, r = nwg % NXCD, xcd = wgid % NXCD, off = wgid / NXCD; wgid = (xcd < r ? xcd * (q + 1) : r * (q + 1) + (xcd - r) * q) + off; }
        const int nig = WGM * nN, gid = wgid / nig, fm = gid * WGM, gsz = (nM - fm) < WGM ? (nM - fm) : WGM;
        u.pm = fm + ((wgid % nig) % gsz); u.pn = (wgid % nig) / gsz + rot; if (u.pn >= nN) u.pn -= nN; u.e = 0; u.lt = 0; return true;
    }
    __device__ __forceinline__ int arow(const Unit& u, int R) const { return u.pm * BM + R; }
};

__device__ __forceinline__ unsigned cvt_pk_bf16(float lo, float hi) { unsigned r; asm volatile("v_cvt_pk_bf16_f32 %0, %1, %2" : "=v"(r) : "v"(lo), "v"(hi)); return r; }

template <class Epi, class Sched, bool ALIGN_EPI, bool GATHER = false, bool FP8 = false, bool MID = false>
__device__ __forceinline__ void gemm_phase(PG8_LAS unsigned char* lds, const Gemm g, const Sched& S, const Epi& E, const int wave) {
    const int lane = hw_lane(), wid = wave, tid = wid * 64 + lane,
              wr = wid >> 2, wc = wid & 3, fr = lane & 15, fq = lane >> 4;
    const int K = g.K, RB = FP8 ? K : 2 * K  , nt = RB / (BK * 2);
    unsigned voffB[2];
#pragma unroll
    for (int i = 0; i < 2; ++i) { int R_, C_; stage_rc(tid * 16 + i * 8192, R_, C_); voffB[i] = (unsigned)(R_ * RB + C_ * 2); }
    const size_t kstep = (size_t)(BK * 2);
    const size_t hstep = (size_t)HALF * RB;
    const size_t tstep = 2 * hstep;
    const unsigned ldsw = (unsigned)wid * 1024u;
    const int aoff = lds_byte(wr * 64 + fr, fq * 8), boff = lds_byte(wc * 32 + fr, fq * 8);
#define PG8_SA(b, h) (((b) * 2 + (h)) * HTB)
#define PG8_SB(b, h) ((4 + (b) * 2 + (h)) * HTB)
#define PG8_STAGE(bufoff, gbase, voff) do { _Pragma("unroll") for (int _i = 0; _i < 2; ++_i) \
        __builtin_amdgcn_global_load_lds((const unsigned*)((const char*)(gbase) + (voff)[_i]), (PG8_LAS unsigned*)(lds + (bufoff) + ldsw + _i * 8192), 16, 0, 0); } while (0)
#define PG8_LDA(dst, b, h) do { _Pragma("unroll") for (int m = 0; m < 4; ++m) { if constexpr (FP8) { \
            const i32x4 l0_ = *(const PG8_LAS i32x4*)(lds + PG8_SA(b, h) + aoff + m * 2048), l1_ = *(const PG8_LAS i32x4*)(lds + PG8_SA(b, h) + aoff + m * 2048 + 1024); \
            dst##8[m] = __builtin_shufflevector(l0_, l1_, 0, 1, 2, 3, 4, 5, 6, 7); } \
        else { _Pragma("unroll") for (int k = 0; k < 2; ++k) dst[m][k] = *(const PG8_LAS bf16x8*)(lds + PG8_SA(b, h) + aoff + m * 2048 + k * 1024); } } } while (0)
#define PG8_LDB(dst, b, h) do { _Pragma("unroll") for (int n = 0; n < 2; ++n) { if constexpr (FP8) { \
            const i32x4 l0_ = *(const PG8_LAS i32x4*)(lds + PG8_SB(b, h) + boff + n * 2048), l1_ = *(const PG8_LAS i32x4*)(lds + PG8_SB(b, h) + boff + n * 2048 + 1024); \
            dst##8[n] = __builtin_shufflevector(l0_, l1_, 0, 1, 2, 3, 4, 5, 6, 7); } \
        else { _Pragma("unroll") for (int k = 0; k < 2; ++k) dst[n][k] = *(const PG8_LAS bf16x8*)(lds + PG8_SB(b, h) + boff + n * 2048 + k * 1024); } } } while (0)
#define PG8_MMA(ai, bj, At, Bt) do { __builtin_amdgcn_s_setprio(1); _Pragma("unroll") for (int m = 0; m < 4; ++m) _Pragma("unroll") for (int n = 0; n < 2; ++n) { \
        if constexpr (FP8) { asm volatile("v_mfma_f32_16x16x128_f8f6f4 %0, %1, %2, %0" : "+v"(acc[ai][bj][m][n]) : "v"(Bt##8[n]), "v"(At##8[m])); }   \
        else { _Pragma("unroll") for (int k = 0; k < 2; ++k) acc[ai][bj][m][n] = __builtin_amdgcn_mfma_f32_16x16x32_bf16(Bt[n][k], At[m][k], acc[ai][bj][m][n], 0, 0, 0); } } \
        __builtin_amdgcn_s_setprio(0); } while (0)
#define PG8_WAIT_V(n) asm volatile("s_waitcnt vmcnt(" #n ")" ::: "memory")
#define PG8_WAIT_V8R(rx) do { if (rx) PG8_WAIT_V(24); else PG8_WAIT_V(8); } while (0)
#define PG8_WAIT_L(n) asm volatile("s_waitcnt lgkmcnt(" #n ")" ::: "memory")
#define PG8_BAR __builtin_amdgcn_s_barrier()
#define PG8_SCHED __builtin_amdgcn_sched_barrier(0)
#define PG8_AOFF(dst, u) do { if constexpr (GATHER) { _Pragma("unroll") for (int _h = 0; _h < 2; ++_h) _Pragma("unroll") for (int _i = 0; _i < 2; ++_i) { int R_, C_; stage_rc(tid * 16 + _i * 8192, R_, C_); \
        dst[_h][_i] = (unsigned)S.arow(u, _h * HALF + R_) * (unsigned)RB + (unsigned)(C_ * 2); } } } while (0)
#define PG8_STAGE_A(bufoff, base, h, NXT) do { if constexpr (GATHER) { if (NXT) PG8_STAGE(bufoff, base, o2[h]); else PG8_STAGE(bufoff, base, voA[h]); } else { PG8_STAGE(bufoff, (base) + (h) * hstep, voffB); } } while (0)
    Unit cur, nxt; int ui = 0; bool relax = false;
    if (!S.next(0, cur)) return;
    f32x4 acc[2][2][4][2];
#pragma unroll
    for (int a = 0; a < 2; ++a)
#pragma unroll
        for (int b = 0; b < 2; ++b)
#pragma unroll
            for (int m = 0; m < 4; ++m)
#pragma unroll
                for (int n = 0; n < 2; ++n) acc[a][b][m][n] = (f32x4){0.f, 0.f, 0.f, 0.f};
    bf16x8 At[4][2], B0[2][2], B1[2][2];
    i32x8 At8[4], B08[2], B18[2];
    unsigned voA[2][2], voN[2][2], o2[2][2];
    PG8_AOFF(voA, cur);
    const char* cA = GATHER ? (const char*)g.A : (const char*)g.A + (size_t)cur.pm * tstep;
    const char* cB = (const char*)g.Bt + (size_t)cur.pn * tstep;
    PG8_STAGE(PG8_SB(0, 0), cB, voffB); PG8_STAGE(PG8_SB(0, 1), cB + hstep, voffB); PG8_STAGE_A(PG8_SA(0, 0), cA, 0, 0); PG8_STAGE_A(PG8_SA(0, 1), cA, 1, 0);
    if (wr == 1) PG8_BAR;
    PG8_WAIT_V(2); PG8_BAR;
    PG8_STAGE(PG8_SB(1, 0), cB + kstep, voffB); PG8_STAGE_A(PG8_SA(1, 0), cA + kstep, 0, 0); PG8_STAGE(PG8_SB(1, 1), cB + hstep + kstep, voffB);
    PG8_WAIT_V(6); PG8_BAR;
    for (;;) {
        const bool has_next = S.next(ui + 1, nxt);
        if constexpr (GATHER) {
            if (has_next) { PG8_AOFF(voN, nxt); }
            else {
#pragma unroll
                for (int _h = 0; _h < 2; ++_h) { voN[_h][0] = voA[_h][0]; voN[_h][1] = voA[_h][1]; } } }
        const char* nA = (GATHER || !has_next) ? cA : (const char*)g.A + (size_t)nxt.pm * tstep;
        const char* nB = has_next ? (const char*)g.Bt + (size_t)nxt.pn * tstep : cB;
#pragma nounroll
        for (int t = 0; t < nt; t += 2) {
            const bool last = (t == nt - 2);
            const char* a1 = cA + (size_t)(t + 1) * kstep;
            const char* a2 = last ? nA : cA + (size_t)(t + 2) * kstep; const char* b2 = last ? nB : cB + (size_t)(t + 2) * kstep;
            const char* a3 = a2 + kstep; const char* b3 = b2 + kstep;
            if constexpr (GATHER) {
#pragma unroll
                for (int _h = 0; _h < 2; ++_h) { o2[_h][0] = last ? voN[_h][0] : voA[_h][0]; o2[_h][1] = last ? voN[_h][1] : voA[_h][1]; } }
            if constexpr (MID) { if (t == Epi::MID_T) { E.mid(acc, cur, wr, wc, fr, fq); PG8_SCHED; } }
            const bool rx = relax && t == 0;
            PG8_LDB(B0, 0, 0); PG8_LDB(B1, 0, 1); PG8_SCHED; PG8_LDA(At, 0, 0); PG8_STAGE_A(PG8_SA(1, 1), a1, 1, 0);
            PG8_WAIT_V8R(rx); PG8_WAIT_L(0); PG8_BAR; PG8_MMA(0, 0, At, B0); PG8_MMA(0, 1, At, B1); PG8_BAR; PG8_SCHED;
            PG8_LDA(At, 0, 1); PG8_STAGE(PG8_SB(0, 0), b2, voffB); PG8_STAGE(PG8_SB(0, 1), b2 + hstep, voffB); PG8_STAGE_A(PG8_SA(0, 0), a2, 0, 1);
            PG8_WAIT_V8R(rx); PG8_WAIT_L(0); PG8_BAR; PG8_MMA(1, 0, At, B0); PG8_MMA(1, 1, At, B1); PG8_BAR; PG8_SCHED;
            PG8_LDB(B0, 1, 0); PG8_LDB(B1, 1, 1); PG8_SCHED; PG8_LDA(At, 1, 0); PG8_STAGE_A(PG8_SA(0, 1), a2, 1, 1);
            PG8_WAIT_V(8); PG8_WAIT_L(0); PG8_BAR; PG8_MMA(0, 0, At, B0); PG8_MMA(0, 1, At, B1); PG8_BAR; PG8_SCHED;
            PG8_LDA(At, 1, 1); PG8_STAGE(PG8_SB(1, 0), b3, voffB); PG8_STAGE(PG8_SB(1, 1), b3 + hstep, voffB); PG8_STAGE_A(PG8_SA(1, 0), a3, 0, 1);
            PG8_WAIT_V(8); PG8_WAIT_L(0); PG8_BAR; PG8_MMA(1, 0, At, B0); PG8_MMA(1, 1, At, B1); PG8_BAR; PG8_SCHED;
        }
        if constexpr (ALIGN_EPI) { if (wr == 0) PG8_BAR; }
        E(acc, cur, wr, wc, fr, fq); relax = Epi::leaves16(cur);
#ifdef PROBE_EPI2
        if constexpr (Epi::PROBE_TWICE) E(acc, cur, wr, wc, fr, fq);
#endif
        if (!has_next) break;
#pragma unroll
        for (int a = 0; a < 2; ++a)
#pragma unroll
            for (int b = 0; b < 2; ++b)
#pragma unroll
                for (int m = 0; m < 4; ++m)
#pragma unroll
                    for (int n = 0; n < 2; ++n) acc[a][b][m][n] = (f32x4){0.f, 0.f, 0.f, 0.f};
        cur = nxt; cA = nA; cB = nB; ++ui;
        if constexpr (GATHER) {
#pragma unroll
            for (int _h = 0; _h < 2; ++_h) { voA[_h][0] = voN[_h][0]; voA[_h][1] = voN[_h][1]; } }
        if constexpr (ALIGN_EPI) { if (wr == 1) PG8_BAR; }
    }
    PG8_WAIT_V(0);
    if constexpr (!ALIGN_EPI) { if (wr == 0) PG8_BAR; }
    PG8_BAR;
#undef PG8_SA
#undef PG8_SB
#undef PG8_STAGE
#undef PG8_LDA
#undef PG8_LDB
#undef PG8_MMA
#undef PG8_WAIT_V
#undef PG8_WAIT_V8R
#undef PG8_WAIT_L
#undef PG8_BAR
#undef PG8_SCHED
#undef PG8_AOFF
#undef PG8_STAGE_A
}
}
constexpr int T_TOK = 32768, SEQ = 2048, DM = 1024, NB = 16, DEPTH = 4;
constexpr int N_IN = 5120, CAP = 32768;
constexpr float C2F = 0.125f * 1.4426950408889634f;
constexpr float DN_ALPHA = 1.681792830507429f;
constexpr float LN_EPS = 1e-5f, RMS_EPS = 1e-6f;
constexpr float IN_DESCALE = 1.0f / (16.0f * 256.0f);
constexpr float GU_WSCALE = 256.0f, GU_DESCALE = 1.0f / (16.0f * 256.0f), ACT_SCALE = 16.0f, DN_WSCALE = 1024.0f, DN_DESCALE = 1.0f / (16.0f * 1024.0f);
constexpr float PAB_ASCALE = 32.0f, PAB_WSCALE = 256.0f, PAB_DESCALE = 1.0f / (32.0f * 256.0f);
constexpr float GMIX_SCALE = 512.0f, GMIX_DESCALE = 1.0f / 512.0f;
constexpr float Y2_SCALE = 128.0f, Y2_DESCALE = 1.0f / 128.0f;
constexpr float GATE_SCALE = 128.0f, GATE_DESCALE = 1.0f / 128.0f;
constexpr float MERGED_SCALE = 64.0f, WO_SCALE = 2048.0f, WO_DESCALE = 1.0f / (64.0f * 2048.0f);

#ifndef PROBE_SCALE_A
#define PROBE_SCALE_A 1.0f
#endif
#ifndef PROBE_SCALE_B
#define PROBE_SCALE_B 1.0f
#endif
namespace pg8 {
__device__ __forceinline__ float bf2f(unsigned short b) { return __uint_as_float((unsigned)b << 16); }
__device__ __forceinline__ float bflo(unsigned w) { return __uint_as_float(w << 16); }
__device__ __forceinline__ float bfhi(unsigned w) { return __uint_as_float(w & 0xffff0000u); }
__device__ __forceinline__ float sat8e(float x) { return __builtin_amdgcn_fmed3f(x, -448.0f, 448.0f); }
__device__ __forceinline__ unsigned pk4_fp8e(float a, float b, float c, float d) { unsigned w = 0; w = __builtin_amdgcn_cvt_pk_fp8_f32(sat8e(a), sat8e(b), w, false); w = __builtin_amdgcn_cvt_pk_fp8_f32(sat8e(c), sat8e(d), w, true); return w; }
__device__ __forceinline__ float sigmoidf_(float x) { return __builtin_amdgcn_rcpf(1.f + __expf(-x)); }
__device__ __forceinline__ void sigmoid16(float (&v)[16]) {
#pragma unroll
    for (int q = 0; q < 4; ++q) {
        const float a = 1.f + __expf(-v[4 * q]), b = 1.f + __expf(-v[4 * q + 1]), c = 1.f + __expf(-v[4 * q + 2]), d = 1.f + __expf(-v[4 * q + 3]);
        const float ab = a * b, cd = c * d;
        if (ab * cd < 1e30f) { const float r = __builtin_amdgcn_rcpf(ab * cd) * GATE_SCALE, rcd = r * cd, rab = r * ab;
            v[4 * q] = rcd * b; v[4 * q + 1] = rcd * a; v[4 * q + 2] = rab * d; v[4 * q + 3] = rab * c; }
        else { v[4 * q] = GATE_SCALE * __builtin_amdgcn_rcpf(a); v[4 * q + 1] = GATE_SCALE * __builtin_amdgcn_rcpf(b); v[4 * q + 2] = GATE_SCALE * __builtin_amdgcn_rcpf(c); v[4 * q + 3] = GATE_SCALE * __builtin_amdgcn_rcpf(d); }
    }
}
__device__ __forceinline__ void store16(bf16_t* dst, const float (&v)[16]) {
    u32x4 w0, w1;
    w0.x = cvt_pk_bf16(v[0], v[1]); w0.y = cvt_pk_bf16(v[2], v[3]); w0.z = cvt_pk_bf16(v[4], v[5]); w0.w = cvt_pk_bf16(v[6], v[7]);
    w1.x = cvt_pk_bf16(v[8], v[9]); w1.y = cvt_pk_bf16(v[10], v[11]); w1.z = cvt_pk_bf16(v[12], v[13]); w1.w = cvt_pk_bf16(v[14], v[15]);
#ifdef NT_STORES
    __builtin_nontemporal_store(w0, (u32x4*)dst); __builtin_nontemporal_store(w1, (u32x4*)(dst + 32));
#else
    *(u32x4*)dst = w0; *(u32x4*)(dst + 32) = w1;
#endif
}
__device__ __forceinline__ void load16bf(const bf16_t* src, float (&v)[16]) {
    const u32x4 w0 = *(const u32x4*)src, w1 = *(const u32x4*)(src + 32);
    v[0] = bflo(w0.x); v[1] = bfhi(w0.x); v[2] = bflo(w0.y); v[3] = bfhi(w0.y); v[4] = bflo(w0.z); v[5] = bfhi(w0.z); v[6] = bflo(w0.w); v[7] = bfhi(w0.w);
    v[8] = bflo(w1.x); v[9] = bfhi(w1.x); v[10] = bflo(w1.y); v[11] = bfhi(w1.y); v[12] = bflo(w1.z); v[13] = bfhi(w1.z); v[14] = bflo(w1.w); v[15] = bfhi(w1.w);
}
__device__ __forceinline__ void load16f8(const unsigned char* src, float (&v)[16]) {
    const u32x2 w0 = *(const u32x2*)src, w1 = *(const u32x2*)(src + 32);
    typedef float f32x2v __attribute__((ext_vector_type(2)));
#pragma unroll
    for (int h = 0; h < 2; ++h) { const u32x2 w = h ? w1 : w0;
        const f32x2v a = __builtin_amdgcn_cvt_pk_f32_fp8(w.x, false), b = __builtin_amdgcn_cvt_pk_f32_fp8(w.x, true), c = __builtin_amdgcn_cvt_pk_f32_fp8(w.y, false), d = __builtin_amdgcn_cvt_pk_f32_fp8(w.y, true);
        v[8 * h] = a[0] * GATE_DESCALE; v[8 * h + 1] = a[1] * GATE_DESCALE; v[8 * h + 2] = b[0] * GATE_DESCALE; v[8 * h + 3] = b[1] * GATE_DESCALE;
        v[8 * h + 4] = c[0] * GATE_DESCALE; v[8 * h + 5] = c[1] * GATE_DESCALE; v[8 * h + 6] = d[0] * GATE_DESCALE; v[8 * h + 7] = d[1] * GATE_DESCALE; }
}
__device__ __forceinline__ void store16f8c(unsigned char* dst, const float (&v)[16]) {
    u32x4 w; w.x = pk4_fp8e(v[0], v[1], v[2], v[3]); w.y = pk4_fp8e(v[4], v[5], v[6], v[7]); w.z = pk4_fp8e(v[8], v[9], v[10], v[11]); w.w = pk4_fp8e(v[12], v[13], v[14], v[15]);
    *(u32x4*)dst = w;
}
__device__ __forceinline__ void load16f8c(const unsigned char* src, float (&v)[16]) {
    const u32x4 w = *(const u32x4*)src;
    typedef float f32x2v __attribute__((ext_vector_type(2)));
#pragma unroll
    for (int h = 0; h < 4; ++h) { const unsigned x = w[h];
        const f32x2v a = __builtin_amdgcn_cvt_pk_f32_fp8(x, false), b = __builtin_amdgcn_cvt_pk_f32_fp8(x, true);
        v[4 * h] = a[0] * GATE_DESCALE; v[4 * h + 1] = a[1] * GATE_DESCALE; v[4 * h + 2] = b[0] * GATE_DESCALE; v[4 * h + 3] = b[1] * GATE_DESCALE; }
}
__device__ __forceinline__ void dec16f8c(const u32x4 w, float (&v)[16]) {
    typedef float f32x2v __attribute__((ext_vector_type(2)));
#pragma unroll
    for (int h = 0; h < 4; ++h) { const unsigned x = w[h];
        const f32x2v a = __builtin_amdgcn_cvt_pk_f32_fp8(x, false), b = __builtin_amdgcn_cvt_pk_f32_fp8(x, true);
        v[4 * h] = a[0] * GATE_DESCALE; v[4 * h + 1] = a[1] * GATE_DESCALE; v[4 * h + 2] = b[0] * GATE_DESCALE; v[4 * h + 3] = b[1] * GATE_DESCALE; }
}
#define PG8_PIN8(a) asm volatile("" :: "v"(a[0]), "v"(a[1]), "v"(a[2]), "v"(a[3]), "v"(a[4]), "v"(a[5]), "v"(a[6]), "v"(a[7]))
#define PG8_GATHER16(v, acc, ai, m) do { _Pragma("unroll") for (int _bj = 0; _bj < 2; ++_bj) _Pragma("unroll") for (int _n = 0; _n < 2; ++_n) _Pragma("unroll") for (int _j = 0; _j < 4; ++_j) \
        v[8 * _bj + 4 * _n + _j] = acc[ai][_bj][m][_n][_j]; } while (0)

__device__ __forceinline__ int pg_perm(int g, int s) { return g == 0 ? s : (g == 1 ? ((s & 3) * 512 + (s >> 2)) : ((s & 15) * 128 + (s >> 4))); }

struct EpiIn {
    static constexpr bool PROBE_TWICE = true;
    static __device__ __forceinline__ bool leaves16(const Unit& u) { return u.pn < 12; }
    bf16_t *QA, *KA, *VA, *QD, *KD, *VDT, *G;
    const float* qg; const float* kg;
    const float* rope;
    __device__ __forceinline__ void rms_rope(float (&v)[16], const float* gain, int s, int fq, float scale) const {
        float ss = 0.f;
#pragma unroll
        for (int e = 0; e < 16; ++e) ss += v[e] * v[e];
        ss += __shfl_xor(ss, 16); ss += __shfl_xor(ss, 32);
        const float rinv = 1.0f / sqrtf(ss * (1.0f / 64.0f) + RMS_EPS);
#pragma unroll
        for (int hb = 0; hb < 2; ++hb) {
            const int a = hb == 0 ? (s >> 6) : (s & 63);
            const f32x4* rp = (const f32x4*)(rope + (size_t)(a * 16 + 4 * fq) * 2);
            const f32x4* gp = (const f32x4*)(gain + 32 * hb + 8 * fq);
#pragma unroll
            for (int q = 0; q < 2; ++q) {
                const f32x4 cs = rp[q], gg = gp[q];
                const int e0 = 8 * hb + 4 * q;
                const float x0 = v[e0] * rinv * gg[0], x1 = v[e0 + 1] * rinv * gg[1], x2 = v[e0 + 2] * rinv * gg[2], x3 = v[e0 + 3] * rinv * gg[3];
                v[e0] = (x0 * cs[0] - x1 * cs[1]) * scale; v[e0 + 1] = (x0 * cs[1] + x1 * cs[0]) * scale;
                v[e0 + 2] = (x2 * cs[2] - x3 * cs[3]) * scale; v[e0 + 3] = (x2 * cs[3] + x3 * cs[2]) * scale;
            }
        }
    }
    __device__ __forceinline__ void operator()(const f32x4 (&acc)[2][2][4][2], const Unit& u, int wr, int wc, int fr, int fq) const {
        const int pn = u.pn;
        const int b = (u.pm * BM) >> 11;
#pragma unroll
        for (int ai = 0; ai < 2; ++ai)
#pragma unroll
            for (int m = 0; m < 4; ++m) {
                const int row = u.pm * BM + ai * HALF + wr * 64 + m * 16 + fr, s = row & (SEQ - 1);
                float v[16]; PG8_GATHER16(v, acc, ai, m);
#pragma unroll
                for (int e = 0; e < 16; ++e) v[e] *= IN_DESCALE;
                if (pn < 2) {
                    rms_rope(v, qg, s, fq, C2F);
                    store16(QA + (size_t)row * 512 + (pn * 4 + wc) * 64 + 8 * fq, v);
                } else if (pn == 2) {
                    if (wc < 2) { rms_rope(v, kg, s, fq, 1.0f); store16(KA + (size_t)row * 128 + wc * 64 + 8 * fq, v); }
                    else store16(VA + (size_t)row * 128 + (wc - 2) * 64 + 8 * fq, v);
                } else if (pn < 12) {
                    const int kind = (pn - 3) / 3, g = (pn - 3) - 3 * kind, gh = g * 4 + wc;
                    if (kind == 0) {
#pragma unroll
                        for (int e = 0; e < 16; ++e) v[e] *= C2F; }
                    store16((kind == 0 ? QD : kind == 1 ? KD : VDT) + ((size_t)(b * 12 + gh) * SEQ + pg_perm(g, s)) * 64 + 8 * fq, v);
                } else {
#pragma unroll
                    for (int e = 0; e < 16; ++e) v[e] = sigmoidf_(v[e]) * GATE_SCALE;
                    store16f8c((unsigned char*)G + (size_t)row * 2048 + (pn - 12) * 256 + wc * 64 + 16 * fq, v);
                }
                if (m & 1) asm volatile("" ::: "memory");
            }
    }
};
struct EpiMergeF {
    static constexpr bool PROBE_TWICE = false;
    static constexpr int MID_T = 4;
    static constexpr float GB_MIN = 7.62939453125e-06f;
    static __device__ __forceinline__ bool leaves16(const Unit&) { return false; }
    const bf16_t* G; bf16_t* merged;
    __device__ __forceinline__ void mid(f32x4 (&acc)[2][2][4][2], const Unit& u, int wr, int wc, int fr, int fq) const {
        const int col0 = u.pn * BM + wc * 64 + 16 * fq;
#pragma unroll
        for (int ai = 0; ai < 2; ++ai) {
            u32x4 raw[8];
#pragma unroll
            for (int m = 0; m < 4; ++m) { const unsigned char* gp = (const unsigned char*)G + (size_t)(u.pm * BM + ai * HALF + wr * 64 + m * 16 + fr) * 2048 + col0;
                raw[2 * m] = *(const u32x4*)gp; raw[2 * m + 1] = *(const u32x4*)(gp + 1024); }
            PG8_PIN8(raw);
#pragma unroll
            for (int m = 0; m < 4; ++m) {
                float ga[16], gb[16]; dec16f8c(raw[2 * m], ga); dec16f8c(raw[2 * m + 1], gb);
#pragma unroll
                for (int e = 0; e < 16; ++e) ga[e] *= __builtin_amdgcn_rcpf(fmaxf(gb[e], GB_MIN));
#pragma unroll
                for (int bj = 0; bj < 2; ++bj)
#pragma unroll
                    for (int n = 0; n < 2; ++n)
#pragma unroll
                        for (int j = 0; j < 4; ++j) acc[ai][bj][m][n][j] *= ga[8 * bj + 4 * n + j];
            }
        }
    }
    __device__ __forceinline__ void operator()(const f32x4 (&acc)[2][2][4][2], const Unit& u, int wr, int wc, int fr, int fq) const {
        const int col0 = u.pn * BM + wc * 64 + 16 * fq;
        u32x4 raw[8];
#pragma unroll
        for (int ai = 0; ai < 2; ++ai)
#pragma unroll
            for (int m = 0; m < 4; ++m) raw[ai * 4 + m] = *(const u32x4*)((const unsigned char*)G + (size_t)(u.pm * BM + ai * HALF + wr * 64 + m * 16 + fr) * 2048 + 1024 + col0);
        PG8_PIN8(raw);
#pragma unroll
        for (int ai = 0; ai < 2; ++ai)
#pragma unroll
            for (int m = 0; m < 4; ++m) {
                const int row = u.pm * BM + ai * HALF + wr * 64 + m * 16 + fr;
                float v[16], gb[16]; PG8_GATHER16(v, acc, ai, m);
                dec16f8c(raw[ai * 4 + m], gb);
#pragma unroll
                for (int e = 0; e < 16; ++e) v[e] *= fmaxf(gb[e], GB_MIN) * (PAB_DESCALE * MERGED_SCALE);
                store16f8c((unsigned char*)merged + (size_t)row * DM + col0, v);
                if (m & 1) asm volatile("" ::: "memory");
            }
    }
};
struct EpiRes {
    static constexpr bool PROBE_TWICE = false;
    static __device__ __forceinline__ bool leaves16(const Unit&) { return false; }
    bf16_t* gmix; const float* gmod;
    __device__ __forceinline__ void operator()(const f32x4 (&acc)[2][2][4][2], const Unit& u, int wr, int wc, int fr, int fq) const {
        const int col0 = u.pn * BM + wc * 64 + 16 * fq;
        const int b = (u.pm * BM) >> 11;
        float gv[16];
#pragma unroll
        for (int q = 0; q < 4; ++q) { const f32x4 t = *(const f32x4*)(gmod + (size_t)b * 6144 + col0 + 4 * q); gv[4 * q] = t[0] * WO_DESCALE; gv[4 * q + 1] = t[1] * WO_DESCALE; gv[4 * q + 2] = t[2] * WO_DESCALE; gv[4 * q + 3] = t[3] * WO_DESCALE; }
#pragma unroll
        for (int ai = 0; ai < 2; ++ai)
#pragma unroll
            for (int m = 0; m < 4; ++m) {
                const size_t off = (size_t)(u.pm * BM + ai * HALF + wr * 64 + m * 16 + fr) * DM + col0;
                float v[16]; PG8_GATHER16(v, acc, ai, m);
#pragma unroll
                for (int e = 0; e < 16; ++e) v[e] *= gv[e] * GMIX_SCALE;
                store16f8c((unsigned char*)gmix + off, v);
                if (m & 1) asm volatile("" ::: "memory");
            }
    }
};
struct EpiGU {
    static constexpr bool PROBE_TWICE = false;
    static __device__ __forceinline__ bool leaves16(const Unit&) { return false; }
    bf16_t* act; const float* gatew; const PG8_LAS int* tab;
    __device__ __forceinline__ void operator()(const f32x4 (&acc)[2][2][4][2], const Unit& u, int wr, int wc, int fr, int fq) const {
        const int e = u.e, cnt = tab[e], f0 = (u.pn & 1) * 128 + wc * 32 + fq * 8;
        float gwa[8];
#pragma unroll
        for (int ai = 0; ai < 2; ++ai)
#pragma unroll
            for (int m = 0; m < 4; ++m) { const int li = u.lt * BM + ai * HALF + wr * 64 + m * 16 + fr; gwa[ai * 4 + m] = gatew[(size_t)e * CAP + (li < CAP ? li : CAP - 1)]; }
        PG8_PIN8(gwa);
#pragma unroll
        for (int ai = 0; ai < 2; ++ai)
#pragma unroll
            for (int m = 0; m < 4; ++m) {
                const int rit = ai * HALF + wr * 64 + m * 16 + fr, li = u.lt * BM + rit;
                const float gw = li < cnt ? gwa[ai * 4 + m] : 0.f;
                float a[8];
#pragma unroll
                for (int bj = 0; bj < 2; ++bj)
#pragma unroll
                    for (int j = 0; j < 4; ++j) { const float gt = acc[ai][bj][m][0][j] * GU_DESCALE, up = acc[ai][bj][m][1][j] * GU_DESCALE; a[4 * bj + j] = gt * sigmoidf_(gt) * up * gw * ACT_SCALE; }
                u32x2 w; w.x = pk4_fp8e(a[0], a[1], a[2], a[3]); w.y = pk4_fp8e(a[4], a[5], a[6], a[7]);
                *(u32x2*)((unsigned char*)act + (size_t)(u.pm * BM + rit) * 256 + f0) = w;
                if (m & 1) asm volatile("" ::: "memory");
            }
    }
};
struct EpiDown {
    static constexpr bool PROBE_TWICE = false;
    static __device__ __forceinline__ bool leaves16(const Unit&) { return false; }
    bf16_t* y2; const int* rowlist; const PG8_LAS int* tab;
    __device__ __forceinline__ void operator()(const f32x4 (&acc)[2][2][4][2], const Unit& u, int wr, int wc, int fr, int fq) const {
        const int e = u.e, cnt = tab[e], col0 = (u.pn & 3) * BM + wc * 64 + 16 * fq;
        int ents[8];
#pragma unroll
        for (int ai = 0; ai < 2; ++ai)
#pragma unroll
            for (int m = 0; m < 4; ++m) { const int li = u.lt * BM + ai * HALF + wr * 64 + m * 16 + fr; ents[ai * 4 + m] = rowlist[(size_t)e * CAP + (li < CAP ? li : CAP - 1)]; }
        PG8_PIN8(ents);
#pragma unroll
        for (int ai = 0; ai < 2; ++ai)
#pragma unroll
            for (int m = 0; m < 4; ++m) {
                const int li = u.lt * BM + ai * HALF + wr * 64 + m * 16 + fr;
                const int ent = ents[ai * 4 + m];
                float v[16]; PG8_GATHER16(v, acc, ai, m);
#pragma unroll
                for (int e2 = 0; e2 < 16; ++e2) v[e2] *= DN_DESCALE * Y2_SCALE;
                store16f8c((unsigned char*)y2 + (li < cnt ? ((size_t)(ent & 1) * T_TOK + (ent >> 1)) * DM : (size_t)2 * T_TOK * DM) + col0, v);
                if (m & 1) asm volatile("" ::: "memory");
            }
    }
};
template <bool GATHER> struct MoeOrder {
    const PG8_LAS int* tab; const int* rowlist; int nct, G, c;
    __device__ __forceinline__ bool next(int i, Unit& u) const {
        const int nwg = tab[32] * nct; const long L = (long)i * G + c; if (L >= nwg) return false;
        int w = (int)L; { const int q = nwg / NXCD, r = nwg % NXCD, xcd = w % NXCD, off = w / NXCD; w = (xcd < r ? xcd * (q + 1) : r * (q + 1) + (xcd - r) * q) + off; }
        const int rt = w / nct, ct = w - rt * nct; int e = 0;
        for (int k = 1; k < 16; ++k) e += (rt >= tab[16 + k]) ? 1 : 0;
        u.pm = rt; u.e = e; u.lt = rt - tab[16 + e]; u.pn = e * nct + ct; return true;
    }
    __device__ __forceinline__ int arow(const Unit& u, int R) const {
        if (GATHER) { const int li = u.lt * BM + R; const int ent = rowlist[(size_t)u.e * CAP + (li < CAP ? li : CAP - 1)]; return li < tab[u.e] ? (ent >> 1) : 0; }
        return u.pm * BM + R;
    }
};
}
namespace attn_body {
using bf16=__hip_bfloat16;
using bf16x8=__attribute__((ext_vector_type(8)))short;
using s16x4=__attribute__((ext_vector_type(4)))short;
using f32x16=__attribute__((ext_vector_type(16)))float;
using u32x4=__attribute__((ext_vector_type(4)))unsigned;
constexpr int BATCH=16,NHEAD=8,SEQ=2048,D=64;
constexpr int NW=8,QBLK=32,QB=QBLK*NW,KVBLK=64,NQB=SEQ/QB;
constexpr int ATTN_UNIT_ROWS=QB;
__device__ __forceinline__ int crow(int r,int hi){return (r&3)+8*(r>>2)+4*hi;}
#define SBAR() __builtin_amdgcn_sched_barrier(0)
__device__ __forceinline__ void cmask(f32x16&p0,f32x16&p1,int jb,int qrel,int hi){
  const float NEG=-INFINITY; int kb=64*jb+4*hi;
  #pragma unroll
  for(int r=0;r<16;++r){int kv=kb+(r&3)+8*(r>>2); if(kv>qrel)p0[r]=NEG; if(kv+32>qrel)p1[r]=NEG;}
}

constexpr int NSLOT=3, SLOTB=8192;
constexpr int LDS_K=0, LDS_V=NSLOT*SLOTB, LDS_WS=2*NSLOT*SLOTB, LDS_OST=LDS_WS+NW*64*4, LDS_BYTES=LDS_OST+NW*4096;
constexpr float C2=0.125f*1.4426950408889634f;
__device__ __forceinline__ void glds16(const void*gsrc,unsigned lds_dst){unsigned keep;
  asm volatile("s_mov_b32 %0, m0\n\ts_mov_b32 m0, %2\n\ts_nop 0\n\tglobal_load_lds_dwordx4 %1, off\n\ts_mov_b32 m0, %0":"=&s"(keep):"v"(gsrc),"s"(lds_dst):"memory");}
__device__ __forceinline__ float max3f(float a,float b,float c){float r;asm("v_max3_f32 %0, %1, %2, %3":"=v"(r):"v"(a),"v"(b),"v"(c));return r;}
__device__ __forceinline__ float max2f(float a,float b){float r;asm("v_max_f32_e32 %0, %1, %2":"=v"(r):"v"(a),"v"(b));return r;}
__device__ __forceinline__ float fadd_s(float a,float b){float r;asm("v_add_f32_e32 %0, %1, %2":"=v"(r):"v"(a),"v"(b));return r;}
__device__ __forceinline__ float fsub_s(float a,float b){float r;asm("v_sub_f32_e32 %0, %1, %2":"=v"(r):"v"(a),"v"(b));return r;}
typedef float f32x2_t __attribute__((ext_vector_type(2))); typedef __bf16 bf16x2_t __attribute__((ext_vector_type(2)));
__device__ __forceinline__ unsigned cvtpk_s(float lo,float hi){f32x2_t v={lo,hi};bf16x2_t b=__builtin_convertvector(v,bf16x2_t);return __builtin_bit_cast(unsigned,b);}
#define WAIT_BAR(N) asm volatile("s_waitcnt vmcnt(" #N ") lgkmcnt(0)\n\ts_barrier":::"memory")

__device__ __forceinline__ void qkt(f32x16&p0,f32x16&p1,const char*Kslot,const bf16x8*qr,const f32x16&negm,int r32,int hi){
  const char*kb=Kslot+hi*1024+r32*16;
  #pragma unroll
  for(int d0=0;d0<4;++d0){
    const bf16x8 b0=*reinterpret_cast<const bf16x8*>(kb+d0*2048);
    const bf16x8 b1=*reinterpret_cast<const bf16x8*>(kb+d0*2048+512);
    if(d0==0){p0=__builtin_amdgcn_mfma_f32_32x32x16_bf16(b0,qr[0],negm,0,0,0);p1=__builtin_amdgcn_mfma_f32_32x32x16_bf16(b1,qr[0],negm,0,0,0);}
    else{p0=__builtin_amdgcn_mfma_f32_32x32x16_bf16(b0,qr[d0],p0,0,0,0);p1=__builtin_amdgcn_mfma_f32_32x32x16_bf16(b1,qr[d0],p1,0,0,0);}}
}
typedef __attribute__((address_space(3))) const char* lds_cptr;
typedef short v4i16_t __attribute__((ext_vector_type(4)));
__device__ __forceinline__ void kload8(bf16x8*kf,lds_cptr kp){
  kf[0]=*(const __attribute__((address_space(3))) bf16x8*)(kp);      kf[1]=*(const __attribute__((address_space(3))) bf16x8*)(kp+512);
  kf[2]=*(const __attribute__((address_space(3))) bf16x8*)(kp+2048); kf[3]=*(const __attribute__((address_space(3))) bf16x8*)(kp+2560);
  kf[4]=*(const __attribute__((address_space(3))) bf16x8*)(kp+4096); kf[5]=*(const __attribute__((address_space(3))) bf16x8*)(kp+4608);
  kf[6]=*(const __attribute__((address_space(3))) bf16x8*)(kp+6144); kf[7]=*(const __attribute__((address_space(3))) bf16x8*)(kp+6656);
}
__device__ __forceinline__ void kload2(bf16x8*kf,lds_cptr kp,int j){ kf[2*j]=*(const __attribute__((address_space(3))) bf16x8*)(kp+j*2048); kf[2*j+1]=*(const __attribute__((address_space(3))) bf16x8*)(kp+j*2048+512); }
__device__ __forceinline__ s16x4 vtr(lds_cptr p){ return __builtin_bit_cast(s16x4,__builtin_amdgcn_ds_read_tr16_b64_v4i16((__attribute__((address_space(3))) v4i16_t*)p)); }
__device__ __forceinline__ float rowmax(const f32x16&p0,const f32x16&p1){
  float a=max3f(p0[0],p0[1],p1[0]),b=max3f(p0[2],p0[3],p1[1]);a=max3f(a,p1[2],p1[3]);
  #pragma unroll
  for(int r=4;r<16;r+=4){a=max3f(a,p0[r],p0[r+1]);b=max3f(b,p0[r+2],p0[r+3]);a=max3f(a,p1[r],p1[r+1]);b=max3f(b,p1[r+2],p1[r+3]);}
  const float m=max2f(a,b);
  auto rr=__builtin_amdgcn_permlane32_swap(__float_as_uint(m),__float_as_uint(m),false,false);
  return max2f(__uint_as_float(rr[0]),__uint_as_float(rr[1]));
}
__device__ __forceinline__ void pv(f32x16*o,int vb,bf16x8 pa0,bf16x8 pa1,bf16x8 pa2,bf16x8 pa3){
  #pragma unroll
  for(int d0=0;d0<2;++d0){s16x4 lo[4],hi[4];
    #pragma unroll
    for(int ks=0;ks<4;++ks){
      asm volatile("ds_read_b64_tr_b16 %0,%1 offset:%c2":"=&v"(lo[ks]):"v"(vb),"i"(d0*4096+ks*1024):"memory");
      asm volatile("ds_read_b64_tr_b16 %0,%1 offset:%c2":"=&v"(hi[ks]):"v"(vb),"i"(d0*4096+ks*1024+512):"memory");}
    asm volatile("s_waitcnt lgkmcnt(0)":::"memory");SBAR();
    #define PK(k) (bf16x8){lo[k][0],lo[k][1],lo[k][2],lo[k][3],hi[k][0],hi[k][1],hi[k][2],hi[k][3]}
    o[d0]=__builtin_amdgcn_mfma_f32_32x32x16_bf16(pa0,PK(0),o[d0],0,0,0);
    o[d0]=__builtin_amdgcn_mfma_f32_32x32x16_bf16(pa1,PK(1),o[d0],0,0,0);
    o[d0]=__builtin_amdgcn_mfma_f32_32x32x16_bf16(pa2,PK(2),o[d0],0,0,0);
    o[d0]=__builtin_amdgcn_mfma_f32_32x32x16_bf16(pa3,PK(3),o[d0],0,0,0);
    #undef PK
  }
}

#ifndef ATTN_STORE16
#define ATTN_STORE16(p,v) (*(u32x4*)(p)=(v))
#endif
struct UnitP { const bf16* Q; const bf16* K; const bf16* V; bf16* O; unsigned char* O8; float* lse; int NT; int qa0; int kk0; int ngmask; float sl2; int NTL, hs0, hs1; };
struct CfgA { static constexpr int QP=512,KP=128,VP=128,OP=768; static constexpr bool BAND=false,OFP8=true; };
struct CfgB { static constexpr int QP=64,KP=64,VP=64,OP=64; static constexpr bool BAND=true,OFP8=true; };
constexpr float OUT_SCALE=32.0f;
constexpr float NEGBAND=-30000.0f;
__device__ __forceinline__ void bandmask(f32x16&p0,f32x16&p1,int kt0,int qa,int hi,int ngmask,float sl2){
  const bool cls_ok=((kt0&ngmask)==(qa&ngmask));
  const float fb=(float)(kt0+4*hi-qa);
  #pragma unroll
  for(int r=0;r<16;++r){ const float f0=fb+(float)((r&3)+8*(r>>2)),f1=f0+32.0f; const float a0=__builtin_fabsf(f0),a1=__builtin_fabsf(f1);
    const float v0=__builtin_fmaf(-sl2,a0,p0[r]),v1=__builtin_fmaf(-sl2,a1,p1[r]);
    p0[r]=(cls_ok&&a0<=64.0f)?v0:NEGBAND; p1[r]=(cls_ok&&a1<=64.0f)?v1:NEGBAND; }
}
template<int THRL,class CFG> __device__ __forceinline__ void attn_unit(const int wave,const UnitP&U,char*shm,const bool pre,const bf16*nK,const bf16*nV,const int nNTL){
  constexpr int QP=CFG::QP,KP=CFG::KP,VP=CFG::VP,OP=CFG::OP;
  const int lane=hw_lane(),r32=lane&31,hi=lane>>5; const int wid=wave;
  const bf16*Qw=U.Q+(long)(wid*QBLK)*QP;
  const bf16*Kh=U.K,*Vh=U.V;
  const int qa=U.qa0+wid*QBLK+r32;
  const unsigned lds0=(unsigned)(uintptr_t)shm;
  constexpr bool AR=CFG::BAND;
  constexpr int NS=AR?6:NSLOT, LV=NS*SLOTB, LWS=2*NS*SLOTB, LOST=LWS+NW*64*4, OSTW=AR?2048:4096;
  const int hsh=AR?((wid>>2)?U.hs1:U.hs0):0, hoff=hsh*SLOTB, kk0w=U.kk0+64*hsh;
  float*wsf=(float*)(shm+LWS)+wid*64;
  const bf16*ksrc=Kh+(long)lane*KP+wid*8;
  const bf16*vsrc=Vh+(long)(16*(wid&3)+(lane>>2))*VP+(wid>>2)*32+(lane&3)*8;
  const unsigned kdst=lds0+LDS_K+wid*1024, vdst=lds0+LV+wid*1024;
  #define DMA_K(t,slot) glds16(ksrc+(long)(t)*KVBLK*KP,(unsigned)__builtin_amdgcn_readfirstlane(kdst+(slot)))
  #define DMA_V(t,slot) glds16(vsrc+(long)(t)*KVBLK*VP,(unsigned)__builtin_amdgcn_readfirstlane(vdst+(slot)))
  const int vb0=(int)(lds0+LV)+hoff+((lane>>4)&1)*32+(lane&3)*8+(4*hi+((lane&15)>>2))*64;
  const char*Kbase=shm+LDS_K+hoff; bf16x8 kf[8];
  const lds_cptr shm3=(lds_cptr)shm; const lds_cptr kp0=shm3+LDS_K+hoff+hi*1024+r32*16; const lds_cptr vp0=shm3+LV+hoff+((lane>>4)&1)*32+(lane&3)*8+(4*hi+((lane&15)>>2))*64;
  const int NT=U.NT;
  if constexpr(AR){ if(!pre){DMA_K(0,0);DMA_K(1,SLOTB);DMA_K(2,2*SLOTB);DMA_K(3,3*SLOTB);} }
  else if(!pre){DMA_K(0,0);DMA_V(0,0);DMA_K(1,SLOTB);}
  bf16x8 qr[4];
  #pragma unroll
  for(int d0=0;d0<4;++d0)qr[d0]=*reinterpret_cast<const bf16x8*>(&Qw[(long)r32*QP+d0*16+hi*8]);
  float mhat=0.f,l_reg=0.f;f32x16 o[2];o[0]=f32x16{};o[1]=f32x16{};f32x16 negm=f32x16{};asm volatile("":"+v"(negm));

  #define CMASK(P0,P1,t) do{ if constexpr(CFG::BAND) bandmask(P0,P1,kk0w+64*(t),qa,hi,U.ngmask,U.sl2); }while(0)
  bool resc=false;
  #define START(P0,P1) do{ const float rm=rowmax(P0,P1); resc=false; \
    { const float dl=rm; mhat=fadd_s(mhat,dl); \
      _Pragma("unroll") for(int r=0;r<16;++r){P0[r]=fsub_s(P0[r],dl);P1[r]=fsub_s(P1[r],dl);} \
      _Pragma("unroll") for(int r=0;r<16;++r)negm[r]=-mhat; asm volatile("":"+v"(negm)); } \
    _Pragma("unroll") for(int r=0;r<16;++r)P0[r]=__builtin_amdgcn_exp2f(P0[r]); }while(0)
  #define RESC() do{ if(resc){ asm volatile("s_waitcnt lgkmcnt(0)":::"memory"); \
      _Pragma("unroll") for(int d_=0;d_<2;++d_) _Pragma("unroll") for(int r=0;r<16;++r)o[d_][r]*=wsf[crow(r,hi)]; } }while(0)
  f32x16 pA0,pA1,pB0,pB1;
  int sl_prev=0,sl_cur=0,sl_next=SLOTB;
  #define ROT() do{sl_prev=sl_cur;sl_cur=sl_next;sl_next=(sl_next==(NS-1)*SLOTB)?0:sl_next+SLOTB;}while(0)
  if constexpr(AR){ asm volatile(""::"v"(qr[0]),"v"(qr[1]),"v"(qr[2]),"v"(qr[3]));
    DMA_V(0,0);DMA_V(1,SLOTB);DMA_V(2,2*SLOTB); if(U.NTL==6){DMA_K(4,4*SLOTB);} DMA_V(3,3*SLOTB); if(U.NTL==6){DMA_K(5,5*SLOTB);DMA_V(4,4*SLOTB);DMA_V(5,5*SLOTB);} }
  #define ARWAIT(n6) do{ if(U.NTL==6){WAIT_BAR(n6);} else {WAIT_BAR(0);} }while(0)
  if constexpr(!AR) DMA_K(2,2*SLOTB);
  if constexpr(AR){ if(U.NTL==6){WAIT_BAR(8);} else {WAIT_BAR(4);} } else
  WAIT_BAR(3);
  qkt(pA0,pA1,Kbase,qr,negm,r32,hi);asm volatile("s_nop 15\n\ts_nop 7":"+v"(pA0),"+v"(pA1));CMASK(pA0,pA1,0);
  START(pA0,pA1);
  _Pragma("unroll") for(int r=0;r<16;++r)pA1[r]=__builtin_amdgcn_exp2f(pA1[r]);
  if constexpr(AR){ARWAIT(4);} else
  WAIT_BAR(0);
  if constexpr(!AR){DMA_K(3,0);DMA_V(1,SLOTB);}
  ROT();
  kload8(kf,kp0+sl_cur);
  if constexpr(AR){ARWAIT(4);} else
  WAIT_BAR(2);
  s16x4 vlo[8],vhi[8]; u32x4 pw0,pw1,pw2,pw3;
  #define PKW(P,B) cvtpk_s(P[B],P[B+1])
  #define PAF(k) __builtin_bit_cast(bf16x8,pw##k)
  #define VFR(i) (bf16x8){vlo[i][0],vlo[i][1],vlo[i][2],vlo[i][3],vhi[i][0],vhi[i][1],vhi[i][2],vhi[i][3]}
  #define PIN(x) asm volatile("":"+v"(x))
  #define MX3(a,b,c) __builtin_fmaxf(__builtin_fmaxf((a),(b)),(c))
  #define GAPA(MF,A0,A1,A2,A3,W0,W1,PW) do{ MF; sacc+=A0; sacc+=A1; sacc+=A2; sacc+=A3; PIN(sacc); W0; W1; PIN(PW); SBAR(); }while(0)
  #define EX(v) __builtin_amdgcn_exp2f(v)
  #define GAPB(MF,X,B) do{ MF; X[B]=EX(X[B]); X[B+1]=EX(X[B+1]); X[B+2]=EX(X[B+2]); X[B+3]=EX(X[B+3]); PIN(X); SBAR(); }while(0)
  #define VRD(i) do{ vlo[i]=vtr(vp_+(((i)>>2)*4096+((i)&3)*1024)); vhi[i]=vtr(vp_+(((i)>>2)*4096+((i)&3)*1024+512)); }while(0)
  #define KRD(G,j) do{ if(G){ kload2(kf,kp0+sl_next,j); SBAR(); } }while(0)
  #define STEP(C0,C1,P0,P1,t,GK,GV,GL) do{ SBAR(); \
    const lds_cptr vp_=vp0+sl_prev; \
    VRD(0); SBAR(); float sacc=(P0[0]+P0[1]); \
    GAPA(C0=__builtin_amdgcn_mfma_f32_32x32x16_bf16(kf[0],qr[0],negm,0,0,0), P0[2],P0[3],P0[4],P0[5],     pw0[0]=PKW(P0,0), pw0[1]=PKW(P0,2), pw0); \
    VRD(4); SBAR(); GAPA(C1=__builtin_amdgcn_mfma_f32_32x32x16_bf16(kf[1],qr[0],negm,0,0,0), P0[6],P0[7],P0[8],P0[9],     pw0[2]=PKW(P0,4), pw0[3]=PKW(P0,6), pw0); \
    VRD(1); SBAR(); GAPA(C0=__builtin_amdgcn_mfma_f32_32x32x16_bf16(kf[2],qr[1],C0,0,0,0),   P0[10],P0[11],P0[12],P0[13], pw1[0]=PKW(P0,8), pw1[1]=PKW(P0,10), pw1); \
    VRD(5); SBAR(); GAPA(C1=__builtin_amdgcn_mfma_f32_32x32x16_bf16(kf[3],qr[1],C1,0,0,0),   P0[14],P0[15],P1[0],P1[1],   pw1[2]=PKW(P0,12),pw1[3]=PKW(P0,14), pw1); \
    VRD(2); SBAR(); GAPA(C0=__builtin_amdgcn_mfma_f32_32x32x16_bf16(kf[4],qr[2],C0,0,0,0),   P1[2],P1[3],P1[4],P1[5],     pw2[0]=PKW(P1,0), pw2[1]=PKW(P1,2), pw2); \
    VRD(6); SBAR(); GAPA(C1=__builtin_amdgcn_mfma_f32_32x32x16_bf16(kf[5],qr[2],C1,0,0,0),   P1[6],P1[7],P1[8],P1[9],     pw2[2]=PKW(P1,4), pw2[3]=PKW(P1,6), pw2); \
    VRD(3); SBAR(); GAPA(C0=__builtin_amdgcn_mfma_f32_32x32x16_bf16(kf[6],qr[3],C0,0,0,0),   P1[10],P1[11],P1[12],P1[13], pw3[0]=PKW(P1,8), pw3[1]=PKW(P1,10), pw3); \
    VRD(7); SBAR(); GAPA(C1=__builtin_amdgcn_mfma_f32_32x32x16_bf16(kf[7],qr[3],C1,0,0,0),   P1[14],P1[15],0.f,0.f,       pw3[2]=PKW(P1,12),pw3[3]=PKW(P1,14), pw3); \
    l_reg+=sacc; \
    if(GK){DMA_K((t)+3,sl_cur);} if(GV){DMA_V((t)+1,sl_next);} \
    CMASK(C0,C1,t); \
    { float a=MX3(C0[0],C0[1],C1[0]),b=MX3(C0[2],C0[3],C1[1]); a=MX3(a,C1[2],C1[3]); \
      _Pragma("unroll") for(int r=4;r<16;r+=4){a=MX3(a,C0[r],C0[r+1]);b=MX3(b,C0[r+2],C0[r+3]);a=MX3(a,C1[r],C1[r+1]);b=MX3(b,C1[r+2],C1[r+3]);} \
      float rm=__builtin_fmaxf(a,b); { auto rr=__builtin_amdgcn_permlane32_swap(__float_as_uint(rm),__float_as_uint(rm),false,false); rm=__builtin_fmaxf(__uint_as_float(rr[0]),__uint_as_float(rr[1])); } \
      resc=false; \
      if(__builtin_expect(__any(rm>(float)THRL),0)){ const float dl=__builtin_fmaxf(rm,0.f); mhat+=dl; \
        _Pragma("unroll") for(int r=0;r<16;++r){C0[r]-=dl;C1[r]-=dl;} \
        _Pragma("unroll") for(int r=0;r<16;++r)negm[r]=-mhat; asm volatile("":"+v"(negm)); \
        const float f=__builtin_amdgcn_exp2f(-dl); l_reg*=f; if(hi==0)wsf[r32]=f; resc=true; } } \
    SBAR(); \
    GAPB(o[0]=__builtin_amdgcn_mfma_f32_32x32x16_bf16(PAF(0),VFR(0),o[0],0,0,0), C0,0); \
    GAPB(o[1]=__builtin_amdgcn_mfma_f32_32x32x16_bf16(PAF(0),VFR(4),o[1],0,0,0), C0,4); \
    KRD(GL,0); GAPB(o[0]=__builtin_amdgcn_mfma_f32_32x32x16_bf16(PAF(1),VFR(1),o[0],0,0,0), C0,8); \
    KRD(GL,1); GAPB(o[1]=__builtin_amdgcn_mfma_f32_32x32x16_bf16(PAF(1),VFR(5),o[1],0,0,0), C0,12); \
    KRD(GL,2); GAPB(o[0]=__builtin_amdgcn_mfma_f32_32x32x16_bf16(PAF(2),VFR(2),o[0],0,0,0), C1,0); \
    KRD(GL,3); GAPB(o[1]=__builtin_amdgcn_mfma_f32_32x32x16_bf16(PAF(2),VFR(6),o[1],0,0,0), C1,4); \
    GAPB(o[0]=__builtin_amdgcn_mfma_f32_32x32x16_bf16(PAF(3),VFR(3),o[0],0,0,0), C1,8); \
    GAPB(o[1]=__builtin_amdgcn_mfma_f32_32x32x16_bf16(PAF(3),VFR(7),o[1],0,0,0), C1,12); \
    }while(0)
  int t=1;
  #undef CMASK
  #define CMASK(P0,P1,t) do{ if constexpr(CFG::BAND) bandmask(P0,P1,kk0w+64*(t),qa,hi,U.ngmask,U.sl2); }while(0)
  for(;t+5<NT;t+=2){
    STEP(pB0,pB1,pA0,pA1,t,!AR,!AR,true);     WAIT_BAR(2); RESC(); ROT();
    STEP(pA0,pA1,pB0,pB1,t+1,!AR,!AR,true);   WAIT_BAR(2); RESC(); ROT();
  }
  #undef CMASK
  #define CMASK(P0,P1,t) do{ if constexpr(CFG::BAND) bandmask(P0,P1,kk0w+64*(t),qa,hi,U.ngmask,U.sl2); }while(0)
  #define ENDW(tt) do{ if((tt)+3<NT){WAIT_BAR(2);} else if((tt)+2<NT){WAIT_BAR(1);} else {WAIT_BAR(0);} }while(0)
  for(;t+1<NT;t+=2){
    STEP(pB0,pB1,pA0,pA1,t,(!AR&&(t+3<NT)),(!AR&&(t+1<NT)),(t+1<NT));       ENDW(t);   RESC(); ROT();
    STEP(pA0,pA1,pB0,pB1,t+1,(!AR&&(t+4<NT)),(!AR&&(t+2<NT)),(t+2<NT));     ENDW(t+1); RESC(); ROT();
  }
  STEP(pB0,pB1,pA0,pA1,NT-1,false,false,false); RESC();
  { float sacc=pB0[0]+pB0[1]; _Pragma("unroll") for(int r=2;r<16;++r)sacc+=pB0[r]; _Pragma("unroll") for(int r=0;r<16;++r)sacc+=pB1[r]; l_reg+=sacc;
    pw0=(u32x4){PKW(pB0,0),PKW(pB0,2),PKW(pB0,4),PKW(pB0,6)};pw1=(u32x4){PKW(pB0,8),PKW(pB0,10),PKW(pB0,12),PKW(pB0,14)};pw2=(u32x4){PKW(pB1,0),PKW(pB1,2),PKW(pB1,4),PKW(pB1,6)};pw3=(u32x4){PKW(pB1,8),PKW(pB1,10),PKW(pB1,12),PKW(pB1,14)};
    SBAR(); pv(o,vb0+sl_cur,PAF(0),PAF(1),PAF(2),PAF(3)); }
  #undef PKW
  #undef PAF
  #undef VFR
  #undef PIN
  #undef MX3
  #undef GAPA
  #undef GAPB
  #undef EX
  #undef VRD
  #undef KRD
  #undef STEP
  #undef ENDW
  asm volatile("s_waitcnt lgkmcnt(0)\n\ts_barrier":::"memory");
  if(nK){ const bf16*ks2=nK+(long)lane*KP+wid*8; const bf16*vs2=nV+(long)(16*(wid&3)+(lane>>2))*VP+(wid>>2)*32+(lane&3)*8;
    if constexpr(AR){ (void)vs2; (void)nNTL;
      #pragma unroll
      for(int tt=0;tt<4;++tt) glds16(ks2+(long)tt*KVBLK*KP,(unsigned)__builtin_amdgcn_readfirstlane(kdst+tt*SLOTB)); }
    else { glds16(ks2,(unsigned)__builtin_amdgcn_readfirstlane(kdst)); glds16(vs2,(unsigned)__builtin_amdgcn_readfirstlane(vdst)); glds16(ks2+(long)KVBLK*KP,(unsigned)__builtin_amdgcn_readfirstlane(kdst+SLOTB)); } }
  {auto rr=__builtin_amdgcn_permlane32_swap(__float_as_uint(l_reg),__float_as_uint(l_reg),false,false);l_reg=__uint_as_float(rr[0])+__uint_as_float(rr[1]);}
  if constexpr(CFG::BAND){ if(hi==0)U.lse[wid*QBLK+r32]=mhat+__builtin_amdgcn_logf(l_reg); }
  if(hi==0)wsf[32+r32]=l_reg;asm volatile("s_waitcnt lgkmcnt(0)":::"memory");
  float rli[16];
  #pragma unroll
  for(int r=0;r<16;++r)rli[r]=__builtin_amdgcn_rcpf(wsf[32+crow(r,hi)]);
  if constexpr(CFG::OFP8){
    unsigned char*Ow8=U.O8+(long)(wid*QBLK)*OP;
    unsigned char*stg8=(unsigned char*)(shm+LOST)+wid*OSTW;
    #pragma unroll
    for(int r=0;r<16;++r){const int orow=crow(r,hi);
      #pragma unroll
      for(int d0=0;d0<2;++d0){ const float x=__builtin_amdgcn_fmed3f(o[d0][r]*rli[r]*OUT_SCALE,-448.0f,448.0f); stg8[orow*64+d0*32+r32]=(unsigned char)(__builtin_amdgcn_cvt_pk_fp8_f32(x,x,0u,false)&0xffu); } }
    asm volatile("s_waitcnt lgkmcnt(0)":::"memory");
    #pragma unroll
    for(int i=0;i<2;++i){const int row=i*16+(lane>>2),ch=lane&3; const u32x4 v=*(const u32x4*)(stg8+row*64+ch*16); ATTN_STORE16(Ow8+(long)row*OP+ch*16,v);} }
  else {
  bf16*Ow=U.O+(long)(wid*QBLK)*OP;
  { bf16*stg=(bf16*)(shm+LOST)+wid*2048;
    #pragma unroll
    for(int r=0;r<16;++r){const int orow=crow(r,hi);
      #pragma unroll
      for(int d0=0;d0<2;++d0)stg[orow*64+d0*32+r32]=__float2bfloat16(o[d0][r]*rli[r]);}
    asm volatile("s_waitcnt lgkmcnt(0)":::"memory");
    #pragma unroll
    for(int i=0;i<4;++i){const int row=i*8+(lane>>3),ch=lane&7; const u32x4 v=*(const u32x4*)(stg+row*64+ch*8); ATTN_STORE16(Ow+(long)row*OP+ch*8,v);} }
  }
  if(!nK) asm volatile("s_waitcnt lgkmcnt(0)\n\ts_barrier":::"memory");
  #undef DMA_K
  #undef DMA_V
  #undef CMASK
  #undef START
  #undef RESC
  #undef ARWAIT
  #undef ROT
}
constexpr int ATTN_LDS_BYTES=LDS_BYTES;
struct AttnTensors { const bf16* Q; const bf16* K; const bf16* V; bf16* O; unsigned char* O8; };
struct OrderA {
  int vcu, G; AttnTensors T;
  __device__ __forceinline__ bool next(int i,UnitP&u)const{ const int L=(G==256)?(vcu*4+i):(vcu+i*G); if((G==256&&i>=4)||L>=BATCH*NHEAD*NQB)return false;
    const int bh=L>>3,qb=L&7,b=bh/NHEAD,h=bh%NHEAD; const long rowbase=(long)b*SEQ;
    u.Q=T.Q+(rowbase+qb*QB)*CfgA::QP+h*D; u.K=T.K+rowbase*CfgA::KP+(h>>2)*D; u.V=T.V+rowbase*CfgA::VP+(h>>2)*D; u.O=T.O+(rowbase+qb*QB)*CfgA::OP+h*D; u.O8=T.O8+(rowbase+qb*QB)*CfgA::OP+h*D;
    u.lse=nullptr; u.NT=SEQ/KVBLK; u.qa0=0; u.kk0=0; u.ngmask=0; u.sl2=0.f; u.NTL=0; u.hs0=0; u.hs1=0; return true; }
};
struct OrderB {
  int vcu, G; AttnTensors T; float* lse;
  __device__ __forceinline__ bool next(int i,UnitP&u)const{ const int L=(G==256)?(vcu*6+i):(vcu+i*G); if((G==256&&i>=6)||L>=BATCH*12*NQB)return false;
    const int blk=L&7,bgh=L>>3,gh=bgh%12,g=gh>>2; const long hb=(long)bgh*SEQ;
    const int ng=SEQ>>(2*g),q0=blk*QB; int t_lo,nt,h0=0,h1=2;
    if(g==2){ t_lo=q0>>6; nt=4; } else { const int c_lo=(q0&~(ng-1))>>6,c_hi=c_lo+(ng>>6),t0=(q0>>6)-1; t_lo=t0; if(t_lo<c_lo)t_lo=c_lo; if(t_lo>c_hi-6)t_lo=c_hi-6; nt=6; const int d=t0-t_lo; h0=d>0?d:0; h1=2+(d<0?d:0); }
    u.Q=T.Q+(hb+q0)*D; u.K=T.K+(hb+t_lo*64)*D; u.V=T.V+(hb+t_lo*64)*D; u.O=T.O+(hb+q0)*D; u.O8=T.O8+(hb+q0)*D; u.lse=lse+hb+q0;
    u.NT=nt-2; u.NTL=nt; u.hs0=h0; u.hs1=h1; u.qa0=q0; u.kk0=t_lo*64; u.ngmask=~(ng-1); u.sl2=__builtin_amdgcn_exp2f(-8.0f*(float)(gh+1)/12.0f)*1.4426950408889634f*(float)(1<<(2*g)); return true; }
};
template<class CFG,class Sched,int THRL=8> __device__ __forceinline__ void attn_phase(char*lds,const Sched&S,const int wave){
  UnitP u;
  for(int i=0;S.next(i,u);++i){ UnitP n; const bool hn=S.next(i+1,n); const bf16*nK=hn?n.K:nullptr,*nV=hn?n.V:nullptr; const int nNTL=hn?n.NTL:0; attn_unit<THRL,CFG>(wave,u,lds,i>0,nK,nV,nNTL); }
}
#undef SBAR
#undef WAIT_BAR
}
typedef unsigned u32x2g __attribute__((ext_vector_type(2)));
#define GAS __attribute__((address_space(1)))
#define LAS __attribute__((address_space(3)))
typedef unsigned short bf16;
typedef unsigned v4u __attribute__((ext_vector_type(4)));
typedef float f32x4 __attribute__((ext_vector_type(4)));
typedef short bf16x8 __attribute__((ext_vector_type(8)));
typedef GAS unsigned gu32;
typedef GAS unsigned long long gu64;
#define RLX_AGENT __ATOMIC_RELAXED, __HIP_MEMORY_SCOPE_AGENT
#define LDS_WAIT() asm volatile("s_waitcnt lgkmcnt(0)" ::: "memory")
#define VM_WAIT() asm volatile("s_waitcnt vmcnt(0)" ::: "memory")
__device__ __forceinline__ unsigned long long rt() { return __builtin_amdgcn_s_memrealtime(); }
__device__ __forceinline__ unsigned f2bf(float f) { unsigned u = __builtin_bit_cast(unsigned, f); return (u + 0x7fffu + ((u >> 16) & 1u)) >> 16; }
__device__ __forceinline__ unsigned pk2(float lo, float hi) { return f2bf(lo) | (f2bf(hi) << 16); }

#define XB_TMO      128
#define XB_XCNT(j)  (256  + 64 * (j))
#define XB_XSUB(j)  (1280 + 64 * (j))
#define XB_XGEN(j)  (2304 + 64 * (j))
#define XB_TOP      3328
#define XB_TOPGEN   3392
#define XCD_BAR_WORDS 3456
#define XB_SPIN_CAP (1u << 18)

__device__ __forceinline__ unsigned xb_ld(unsigned* p)              { return __hip_atomic_load(p, __ATOMIC_RELAXED, __HIP_MEMORY_SCOPE_AGENT); }
__device__ __forceinline__ unsigned xb_add(unsigned* p, unsigned v) { return __hip_atomic_fetch_add(p, v, __ATOMIC_RELAXED, __HIP_MEMORY_SCOPE_AGENT); }
__device__ __forceinline__ unsigned xb_xcc_id() { return (unsigned)__builtin_amdgcn_s_getreg((3 << 11) | 20) & 0xFu; }
#define XB_SPIN(cond, bar) do { unsigned _sp = 0; while (cond) { __builtin_amdgcn_s_sleep(1); \
    if ((++_sp & 255u) == 0u) { if (xb_ld(&(bar)[XB_TMO])) break; if (_sp > XB_SPIN_CAP) { atomicAdd(&(bar)[XB_TMO], 1u); break; } } } } while (0)

struct XcdBarrier {
    unsigned* bar; unsigned x;
    volatile LAS unsigned* st;
};

__device__ __forceinline__ XcdBarrier xcd_barrier_post(unsigned* bar, volatile LAS unsigned* st) {
    XcdBarrier b; b.bar = bar; b.x = xb_xcc_id(); b.st = st;
    if (threadIdx.x == 0) (void)xb_add(&bar[XB_XCNT(b.x)], 1u);
    return b;
}
__device__ __forceinline__ void xcd_barrier_complete(unsigned* bar, unsigned x, unsigned& nloc, unsigned& nx) {
    const unsigned G = gridDim.x * gridDim.y * gridDim.z;
    unsigned sum, cnt, mine, sp = 0u;
    for (;;) {
        sum = 0u; cnt = 0u; mine = 0u;
#pragma unroll
        for (unsigned j = 0; j < 16; ++j) { const unsigned c = xb_ld(&bar[XB_XCNT(j)]); sum += c; cnt += (c > 0u) ? 1u : 0u; mine = (j == x) ? c : mine; }
        if (sum == G) break;
        __builtin_amdgcn_s_sleep(1);
        if ((++sp & 255u) == 0u) { if (xb_ld(&bar[XB_TMO])) break; if (sp > XB_SPIN_CAP) { atomicAdd(&bar[XB_TMO], 1u); break; } }
    }
    nloc = mine > 0u ? mine : 1u; nx = cnt > 0u ? cnt : 1u;
}

__device__ __forceinline__ void xcd_barrier(const XcdBarrier& b, const bool is_t0  ) {
    asm volatile("s_waitcnt vmcnt(0)" ::: "memory");
    __syncthreads();
    if (is_t0) {
        unsigned* bar = b.bar;
        __builtin_amdgcn_s_waitcnt(0);
        unsigned nloc = b.st[0], nx = b.st[1];
        if (nloc == 0u) { xcd_barrier_complete(bar, b.x, nloc, nx); b.st[0] = nloc; b.st[1] = nx; }
        const unsigned old = xb_add(&bar[XB_XSUB(b.x)], 1u);
        const unsigned gen = old / nloc;
        if (old + 1u == (gen + 1u) * nloc) {
            __builtin_amdgcn_fence(__ATOMIC_RELEASE, "agent");
            asm volatile("s_waitcnt vmcnt(0)" ::: "memory");
            const unsigned og = xb_add(&bar[XB_TOP], 1u);
            const unsigned tg = og / nx;
            if (og + 1u == (tg + 1u) * nx) xb_add(&bar[XB_TOPGEN], 1u);
            else XB_SPIN(xb_ld(&bar[XB_TOPGEN]) == tg, bar);
            __builtin_amdgcn_fence(__ATOMIC_ACQUIRE, "agent");
            xb_add(&bar[XB_XGEN(b.x)], 1u);
            asm volatile("s_waitcnt vmcnt(0)" ::: "memory");
        } else {
            XB_SPIN(xb_ld(&bar[XB_XGEN(b.x)]) == gen, bar);
            __builtin_amdgcn_fence(__ATOMIC_ACQUIRE, "agent");
            asm volatile("s_waitcnt vmcnt(0)" ::: "memory");
        }
    }
    __syncthreads();
}
#ifndef MK_N_LAUNCHES
#define MK_N_LAUNCHES 1
#endif
constexpr int NWAVES = 8;
constexpr int PPL = 9;
constexpr int N_PHASES = 2 + PPL * DEPTH;
constexpr size_t MiB = 1u << 20;
constexpr size_t WS_CTL = 0, CTL_ZERO_BYTES = 64 * 1024;
constexpr size_t WS_ROPE = 1 * MiB;
constexpr size_t WS_MOD = 2 * MiB;
constexpr size_t WS_ROWLIST = 4 * MiB, WS_GATEW = 6 * MiB;
constexpr size_t WS_WIN = 8 * MiB, WS_WPA = 18 * MiB, WS_WPB = 19 * MiB, WS_WO = 20 * MiB, WS_WGU = 22 * MiB, WS_WDN = 38 * MiB;
constexpr size_t WS_H = 48 * MiB;
constexpr size_t WS_OUTB = 112 * MiB;
constexpr size_t WS_QA = 128 * MiB, WS_KA = 160 * MiB, WS_VA = 168 * MiB, WS_QD = 176 * MiB, WS_KD = 224 * MiB, WS_VDT = 272 * MiB, WS_G = 320 * MiB;
constexpr size_t WS_MERGED = 160 * MiB;
constexpr size_t WS_TMP = 224 * MiB;
constexpr size_t WS_ACT = 224 * MiB;
constexpr size_t WS_Y2 = 320 * MiB;
constexpr size_t WS_TRASH = 448 * MiB;
constexpr size_t WS_LSE = 449 * MiB;
constexpr size_t WS_STATS = 451 * MiB;
constexpr size_t WS_XS = 385 * MiB;
constexpr size_t WS_GMIX = 452 * MiB;
constexpr size_t WS_END = 516 * MiB;
constexpr int CW_GCNT = 1024;
constexpr int CW_BAR = 4096;
constexpr int CW_PANEL = 8192;
constexpr int RING_OFF = 0, RING_BYTES = 131072;
constexpr int LDSCTL_OFF = RING_BYTES, MISC_OFF = LDSCTL_OFF + 320;
constexpr int MOETAB_OFF = LDSCTL_OFF + 512;
constexpr int LDS_BYTES = 147456;

struct Frame {
    LAS unsigned char* lds;
    volatile LAS unsigned* MISC;
    gu32* ctl;
    int tid, lane, wave, vcu, G;
};
__device__ __forceinline__ float wave_sum(float v) {
#pragma unroll
    for (int o = 1; o < 64; o <<= 1) v += __shfl_xor(v, o);
    return v;
}
__device__ __forceinline__ float bf2f_(unsigned short b) { return __uint_as_float((unsigned)b << 16); }

__device__ __forceinline__ int hpw_row(int n) { const int c = n & 255; return (n & ~255) + 128 * ((c >> 5) & 1) + 32 * (c >> 6) + 16 * ((c >> 2) & 1) + 4 * ((c >> 3) & 3) + (c & 3); }
__device__ __forceinline__ int hpw_row16(int n) { const int c = n & 255; return (n & ~255) + 128 * ((c >> 3) & 1) + 32 * (c >> 6) + 16 * ((c >> 2) & 1) + 4 * ((c >> 4) & 3) + (c & 3); }
__device__ __forceinline__ int gu_row(int f, int which) { return (f >> 7) * 256 + 128 * ((f >> 2) & 1) + 32 * ((f >> 5) & 3) + 16 * which + 4 * ((f >> 3) & 3) + (f & 3); }

constexpr float FP8_SA = 16.0f, FP8_SWIN = 256.0f;
__device__ __forceinline__ float sat8(float x) { return __builtin_amdgcn_fmed3f(x, -448.0f, 448.0f); }
__device__ __forceinline__ unsigned pk4_fp8(float a, float b, float c, float d) { unsigned w = 0; w = __builtin_amdgcn_cvt_pk_fp8_f32(sat8(a), sat8(b), w, false); w = __builtin_amdgcn_cvt_pk_fp8_f32(sat8(c), sat8(d), w, true); return w; }
template <int MODE>
__device__ __forceinline__ void transpose_item_fp8(const float* W, int K, int N, unsigned char* WT, int row_off, LAS float* scr, int item, int lane, const float FP8_SW) {
    const int nblk = N / 32, kb = item / nblk, nb = item % nblk, k0 = 64 * kb, n0 = 32 * nb;
#pragma unroll
    for (int i = 0; i < 32; ++i) { const int kk = 2 * i + (lane >> 5); scr[kk * 33 + (lane & 31)] = W[(size_t)(k0 + kk) * N + n0 + (lane & 31)]; }
    LDS_WAIT(); asm volatile("" ::: "memory");
    const int n = lane >> 1, kh = (lane & 1) * 32; const LAS float* s = scr + kh * 33 + n;
    v4u o0, o1;
    o0.x = pk4_fp8(s[0 * 33] * FP8_SW, s[1 * 33] * FP8_SW, s[2 * 33] * FP8_SW, s[3 * 33] * FP8_SW); o0.y = pk4_fp8(s[4 * 33] * FP8_SW, s[5 * 33] * FP8_SW, s[6 * 33] * FP8_SW, s[7 * 33] * FP8_SW);
    o0.z = pk4_fp8(s[8 * 33] * FP8_SW, s[9 * 33] * FP8_SW, s[10 * 33] * FP8_SW, s[11 * 33] * FP8_SW); o0.w = pk4_fp8(s[12 * 33] * FP8_SW, s[13 * 33] * FP8_SW, s[14 * 33] * FP8_SW, s[15 * 33] * FP8_SW);
    o1.x = pk4_fp8(s[16 * 33] * FP8_SW, s[17 * 33] * FP8_SW, s[18 * 33] * FP8_SW, s[19 * 33] * FP8_SW); o1.y = pk4_fp8(s[20 * 33] * FP8_SW, s[21 * 33] * FP8_SW, s[22 * 33] * FP8_SW, s[23 * 33] * FP8_SW);
    o1.z = pk4_fp8(s[24 * 33] * FP8_SW, s[25 * 33] * FP8_SW, s[26 * 33] * FP8_SW, s[27 * 33] * FP8_SW); o1.w = pk4_fp8(s[28 * 33] * FP8_SW, s[29 * 33] * FP8_SW, s[30 * 33] * FP8_SW, s[31 * 33] * FP8_SW);
    const int drow_ = MODE == 0 ? hpw_row(n0 + n) : MODE == 3 ? hpw_row16(n0 + n) : MODE == 4 ? (n0 >= 3072 ? hpw_row16(n0 + n) : hpw_row(n0 + n)) : gu_row(n0 + n, MODE - 1);
    unsigned char* dst = WT + (size_t)(row_off + drow_) * K + k0 + kh;
    *(GAS v4u*)dst = o0; *(GAS v4u*)(dst + 16) = o1;
    LDS_WAIT(); asm volatile("" ::: "memory");
}
template <int MODE>
__device__ __forceinline__ void transpose_item(const float* W, int K, int N, pg8::bf16_t* WT, int row_off, LAS float* scr, int item, int lane) {
    const int nblk = N / 32, kb = item / nblk, nb = item % nblk, k0 = 64 * kb, n0 = 32 * nb;
#pragma unroll 8
    for (int i = 0; i < 32; ++i) { const int kk = 2 * i + (lane >> 5); scr[kk * 33 + (lane & 31)] = W[(size_t)(k0 + kk) * N + n0 + (lane & 31)]; }
    LDS_WAIT(); asm volatile("" ::: "memory");
    const int c = lane & 7;
#pragma unroll
    for (int j = 0; j < 4; ++j) { const int n = (lane >> 3) + 8 * j; const LAS float* s = scr + (8 * c) * 33 + n;
        v4u o; o.x = pk2(s[0 * 33], s[1 * 33]); o.y = pk2(s[2 * 33], s[3 * 33]); o.z = pk2(s[4 * 33], s[5 * 33]); o.w = pk2(s[6 * 33], s[7 * 33]);
        const int drow = row_off + (MODE == 0 ? hpw_row(n0 + n) : gu_row(n0 + n, MODE - 1));
        *(GAS v4u*)(WT + (size_t)drow * K + k0 + 8 * c) = o; }
    LDS_WAIT(); asm volatile("" ::: "memory");
}
struct Weights { const float *w_in, *w_pa, *w_pb, *w_o, *w_g, *w_u, *w_d; };
__device__ __forceinline__ void convert_layer(Frame& F0, const Weights& W, unsigned char* ws) {
    Frame F = F0;
    LAS float* scr = (LAS float*)(F.lds + RING_OFF + F.wave * 16384);
    const int gw = F.vcu * NWAVES + F.wave, NGW = F.G * NWAVES;
    constexpr int I_IN = 16 * 160, I_PA = 8 * 32, I_PB = 4 * 32, I_O = 16 * 32, I_G = 16 * 128, I_D = 16 * 128;
    constexpr int NITEMS = I_IN + I_PA + I_PB + I_O + 2 * I_G + I_D;
    for (int it = gw; it < NITEMS; it += NGW) {
        int r = it;
        if (r < I_IN) { transpose_item_fp8<4>(W.w_in, 1024, N_IN, ws + WS_WIN, 0, scr, r, F.lane, FP8_SWIN); continue; } r -= I_IN;
        if (r < I_PA) { transpose_item_fp8<3>(W.w_pa, 768, 1024, ws + WS_WPA, 0, scr, r, F.lane, PAB_WSCALE); continue; } r -= I_PA;
        if (r < I_PB) { transpose_item_fp8<3>(W.w_pb, 768, 1024, ws + WS_WPA + 512, 0, scr, r, F.lane, PAB_WSCALE); continue; } r -= I_PB;
        if (r < I_O) { transpose_item_fp8<3>(W.w_o, 1024, 1024, ws + WS_WO, 0, scr, r, F.lane, WO_SCALE); continue; } r -= I_O;
        if (r < I_G) { const int e = r >> 7; transpose_item_fp8<1>(W.w_g + (size_t)e * 1024 * 256, 1024, 256, ws + WS_WGU, e * 512, scr, r & 127, F.lane, GU_WSCALE); continue; } r -= I_G;
        if (r < I_G) { const int e = r >> 7; transpose_item_fp8<2>(W.w_u + (size_t)e * 1024 * 256, 1024, 256, ws + WS_WGU, e * 512, scr, r & 127, F.lane, GU_WSCALE); continue; } r -= I_G;
        { const int e = r >> 7; transpose_item_fp8<3>(W.w_d + (size_t)e * 256 * 1024, 256, 1024, ws + WS_WDN, e * 1024, scr, r & 127, F.lane, DN_WSCALE); }
    }
}

__device__ __forceinline__ void row_stats(const f32x4 (&v)[4], float& mean, float& rstd) {
    float s = 0.f;
#pragma unroll
    for (int j = 0; j < 4; ++j) s += (v[j].x + v[j].y) + (v[j].z + v[j].w);
    mean = wave_sum(s) * (1.f / DM); float s2 = 0.f;
#pragma unroll
    for (int j = 0; j < 4; ++j) { const f32x4 d = v[j] - mean; s2 += (d.x * d.x + d.y * d.y) + (d.z * d.z + d.w * d.w); }
    rstd = 1.f / sqrtf(wave_sum(s2) * (1.f / DM) + LN_EPS);
}
__device__ __forceinline__ void store_row_fp8(unsigned char* orow, int lane, const f32x4 (&v)[4]) {
    GAS unsigned* o4 = (GAS unsigned*)orow + lane;
#pragma unroll
    for (int j = 0; j < 4; ++j) o4[64 * j] = pk4_fp8(sat8(v[j].x * FP8_SA), sat8(v[j].y * FP8_SA), sat8(v[j].z * FP8_SA), sat8(v[j].w * FP8_SA));
}
__device__ __forceinline__ void store_row_bf16(pg8::bf16_t* orow, int lane, const f32x4 (&v)[4]) {
    GAS unsigned long long* o8 = (GAS unsigned long long*)orow + lane;
#pragma unroll
    for (int j = 0; j < 4; ++j) o8[64 * j] = (unsigned long long)pk2(v[j].x, v[j].y) | ((unsigned long long)pk2(v[j].z, v[j].w) << 32);
}

__device__ __forceinline__ void phase_pr0(Frame& F, const float* c, const float* w_ada, const float* b_ada, float* mod, float* rope, const Weights& W0, unsigned char* ws) {
    LAS float* condT = (LAS float*)(F.lds);
    LAS float* red = (LAS float*)(F.lds + 65536);
    for (int idx = F.tid; idx < 16 * 1024; idx += NWAVES * 64) { const int b = idx >> 10, k = idx & 1023; const float x = c[idx]; condT[k * 16 + b] = x / (1.f + __expf(-x)); }
    __syncthreads();
    for (int it = F.vcu; it < 4 * 96; it += F.G) {
        const int l = it / 96, cb = it % 96, n = cb * 64 + F.lane;
        const float* wp = w_ada + ((size_t)l * 1024 + F.wave * 128) * 6144 + n;
        float a[16];
#pragma unroll
        for (int b = 0; b < 16; ++b) a[b] = 0.f;
        for (int k0 = 0; k0 < 128; k0 += 8) {
            float wv[8];
#pragma unroll
            for (int kk = 0; kk < 8; ++kk) wv[kk] = wp[(size_t)(k0 + kk) * 6144];
#pragma unroll
            for (int kk = 0; kk < 8; ++kk) {
                const LAS f32x4* cp = (const LAS f32x4*)(condT + (F.wave * 128 + k0 + kk) * 16);
#pragma unroll
                for (int q = 0; q < 4; ++q) { const f32x4 cv = cp[q]; a[4 * q] += wv[kk] * cv.x; a[4 * q + 1] += wv[kk] * cv.y; a[4 * q + 2] += wv[kk] * cv.z; a[4 * q + 3] += wv[kk] * cv.w; }
            }
        }
#pragma unroll
        for (int b = 0; b < 16; ++b) red[(F.wave * 16 + b) * 64 + F.lane] = a[b];
        __syncthreads();
        for (int o = F.tid; o < 1024; o += NWAVES * 64) { const int b = o >> 6, nn = o & 63; float s = b_ada[(size_t)l * 6144 + cb * 64 + nn];
#pragma unroll
            for (int w = 0; w < 8; ++w) s += red[(w * 16 + b) * 64 + nn];
            mod[((size_t)l * 16 + b) * 6144 + cb * 64 + nn] = s; }
        __syncthreads();
    }
    if (F.vcu == 0 && F.tid < 16) {
        const int k = F.tid; double th = 1.0; for (int i = 0; i < k; ++i) th *= 0.5623413251903491;
        double c1 = 1.0, s1 = th; { double tc = 1.0, tsn = th; const double t2 = th * th;
            for (int i = 1; i < 14; ++i) { tc *= -t2 / ((2.0 * i - 1.0) * (2.0 * i)); tsn *= -t2 / ((2.0 * i) * (2.0 * i + 1.0)); c1 += tc; s1 += tsn; } }
        double cc = 1.0, sn = 0.0;
        for (int a = 0; a < 64; ++a) { rope[(a * 16 + k) * 2] = (float)cc; rope[(a * 16 + k) * 2 + 1] = (float)sn; const double nc = cc * c1 - sn * s1, ns = sn * c1 + cc * s1; cc = nc; sn = ns; }
    }
    __syncthreads();
    convert_layer(F, W0, ws);
}
__device__ __forceinline__ void phase_pr1(Frame& F, const float* x, const float* mod0, pg8::bf16_t* H) {
    for (int blk = F.vcu; blk < T_TOK / 128; blk += F.G) {
        const int b = blk >> 4; const float* mb = mod0 + (size_t)b * 6144;
        f32x4 sh[4], sc[4];
#pragma unroll
        for (int j = 0; j < 4; ++j) { sh[j] = *(const f32x4*)(mb + 4 * F.lane + 256 * j); sc[j] = *(const f32x4*)(mb + 1024 + 4 * F.lane + 256 * j) + 1.0f; }
        for (int k = 0; k < 16; k += 4) {
            const int row0 = blk * 128 + F.wave * 16 + k;
            f32x4 v[4][4];
#pragma unroll
            for (int q = 0; q < 4; ++q) { const GAS f32x4* xr = (const GAS f32x4*)(x + (size_t)(row0 + q) * DM) + F.lane;
#pragma unroll
                for (int j = 0; j < 4; ++j) v[q][j] = xr[64 * j]; }
#pragma unroll
            for (int q = 0; q < 4; ++q) {
                float mean, rstd; row_stats(v[q], mean, rstd);
#pragma unroll
                for (int j = 0; j < 4; ++j) v[q][j] = (v[q][j] - mean) * rstd * sc[j] + sh[j];
                store_row_fp8((unsigned char*)H + (size_t)(row0 + q) * DM, F.lane, v[q]);
            }
        }
    }
}
template <bool XF32>
__device__ __forceinline__ void phase_ln1(Frame& F0, const float* xb, const pg8::bf16_t* gmix, const float* ln_g, const float* ln_b, const float* modl, const float* w_router, const float* rbias,
                                          pg8::bf16_t* H, int* rowlist, float* gatew, gu32* gcnt, float* stats, const bool dry = false) {
    Frame F = F0;
    LAS float* wr = (LAS float*)(F.lds);
    LAS float* cst = (LAS float*)(F.lds + 65536);
    LAS int* lcnt = (LAS int*)(F.lds + 81920);
    LAS int* gbase = lcnt + 16;
    LAS int* st_e = lcnt + 32;
    LAS float* st_g = (LAS float*)(lcnt + 32 + 256);
    { f32x4 t[8];
#pragma unroll
      for (int i = 0; i < 8; ++i) t[i] = ((const f32x4*)w_router)[F.tid + NWAVES * 64 * i];
#pragma unroll
      for (int i = 0; i < 8; ++i) { const int q4 = F.tid + NWAVES * 64 * i, k = q4 >> 2, e0 = (q4 & 3) * 4;
          wr[(e0 + 0) * 1024 + k] = t[i].x; wr[(e0 + 1) * 1024 + k] = t[i].y; wr[(e0 + 2) * 1024 + k] = t[i].z; wr[(e0 + 3) * 1024 + k] = t[i].w; } }
    const float rbl = rbias[F.lane & 15];
    for (int blk = F.vcu; blk < T_TOK / 128; blk += F.G) {
        const int b = blk >> 4; const float* mb = modl + (size_t)b * 6144;
        __syncthreads();
        for (int idx = F.tid; idx < 1024; idx += NWAVES * 64) { cst[idx] = ln_g[idx]; cst[1024 + idx] = ln_b[idx]; cst[2048 + idx] = 1.0f + mb[4 * 1024 + idx]; cst[3072 + idx] = mb[3 * 1024 + idx]; }
        if (F.tid < 16) lcnt[F.tid] = 0;
        __syncthreads();
        for (int it = 0; it < 4; ++it) {
            f32x4 vv[4][4]; unsigned gm[4][4];
            const int row0 = blk * 128 + F.wave * 16 + it * 4;
#pragma unroll
            for (int q = 0; q < 4; ++q) { const GAS unsigned* gr = (const GAS unsigned*)((const unsigned char*)gmix + (size_t)(row0 + q) * DM) + F.lane;
                if constexpr (XF32) { const GAS f32x4* xr = (const GAS f32x4*)(xb + (size_t)(row0 + q) * DM) + F.lane;
#pragma unroll
                    for (int j = 0; j < 4; ++j) vv[q][j] = xr[64 * j]; }
                else { const GAS u32x2g* xr = (const GAS u32x2g*)((const pg8::bf16_t*)xb + (size_t)(row0 + q) * DM) + F.lane;
#pragma unroll
                    for (int j = 0; j < 4; ++j) { const u32x2g w = xr[64 * j]; vv[q][j].x = __uint_as_float(w.x << 16); vv[q][j].y = __uint_as_float(w.x & 0xffff0000u); vv[q][j].z = __uint_as_float(w.y << 16); vv[q][j].w = __uint_as_float(w.y & 0xffff0000u); } }
#pragma unroll
                for (int j = 0; j < 4; ++j) gm[q][j] = gr[64 * j]; }
#pragma unroll
            for (int q = 0; q < 4; ++q)
#pragma unroll
                for (int j = 0; j < 4; ++j) { typedef float f32x2v __attribute__((ext_vector_type(2))); const f32x2v g0 = __builtin_amdgcn_cvt_pk_f32_fp8(gm[q][j], false), g1 = __builtin_amdgcn_cvt_pk_f32_fp8(gm[q][j], true);
                    f32x4 g4; g4.x = g0[0] * GMIX_DESCALE; g4.y = g0[1] * GMIX_DESCALE; g4.z = g1[0] * GMIX_DESCALE; g4.w = g1[1] * GMIX_DESCALE;
                    vv[q][j] = vv[q][j] * DN_ALPHA + g4; }
            float hq[4][16];
#pragma unroll
            for (int q = 0; q < 4; ++q) {
                const int row = row0 + q;
                f32x4 v[4];
#pragma unroll
                for (int j = 0; j < 4; ++j) v[j] = vv[q][j];
                float mean, rstd; row_stats(v, mean, rstd);
                if (F.lane == 0) { stats[2 * (size_t)row] = mean; stats[2 * (size_t)row + 1] = rstd; }
#pragma unroll
                for (int j = 0; j < 4; ++j) { const f32x4 g4 = *(const LAS f32x4*)(cst + 4 * F.lane + 256 * j), b4 = *(const LAS f32x4*)(cst + 1024 + 4 * F.lane + 256 * j);
                    v[j] = (v[j] - mean) * rstd * g4 + b4; }
                row_stats(v, mean, rstd);
#pragma unroll
                for (int j = 0; j < 4; ++j) { const f32x4 s4 = *(const LAS f32x4*)(cst + 2048 + 4 * F.lane + 256 * j), h4 = *(const LAS f32x4*)(cst + 3072 + 4 * F.lane + 256 * j);
                    v[j] = (v[j] - mean) * rstd * s4 + h4; hq[q][4 * j] = v[j].x; hq[q][4 * j + 1] = v[j].y; hq[q][4 * j + 2] = v[j].z; hq[q][4 * j + 3] = v[j].w; }
                store_row_fp8((unsigned char*)H + (size_t)row * DM, F.lane, v);
            }
            float ac[64];
            typedef float f32x2r __attribute__((ext_vector_type(2)));
#pragma unroll
            for (int e = 0; e < 16; ++e) {
                f32x2r a0 = {0.f, 0.f}, a1 = {0.f, 0.f}, a2 = {0.f, 0.f}, a3 = {0.f, 0.f};
#pragma unroll
                for (int j = 0; j < 4; ++j) { const f32x4 w4 = *(const LAS f32x4*)(wr + e * 1024 + 256 * j + 4 * F.lane);
                    const f32x2r wl = {w4.x, w4.y}, wh = {w4.z, w4.w};
                    a0 = (f32x2r){hq[0][4 * j], hq[0][4 * j + 1]} * wl + a0; a0 = (f32x2r){hq[0][4 * j + 2], hq[0][4 * j + 3]} * wh + a0;
                    a1 = (f32x2r){hq[1][4 * j], hq[1][4 * j + 1]} * wl + a1; a1 = (f32x2r){hq[1][4 * j + 2], hq[1][4 * j + 3]} * wh + a1;
                    a2 = (f32x2r){hq[2][4 * j], hq[2][4 * j + 1]} * wl + a2; a2 = (f32x2r){hq[2][4 * j + 2], hq[2][4 * j + 3]} * wh + a2;
                    a3 = (f32x2r){hq[3][4 * j], hq[3][4 * j + 1]} * wl + a3; a3 = (f32x2r){hq[3][4 * j + 2], hq[3][4 * j + 3]} * wh + a3; }
                ac[e] = a0.x + a0.y; ac[16 + e] = a1.x + a1.y; ac[32 + e] = a2.x + a2.y; ac[48 + e] = a3.x + a3.y;
            }
#pragma unroll
            for (int s = 5; s >= 0; --s) { const int half = 1 << s; const bool up = (F.lane >> s) & 1;
#pragma unroll
                for (int i = 0; i < half; ++i) { const float keep = up ? ac[i + half] : ac[i], send = up ? ac[i] : ac[i + half]; ac[i] = keep + __shfl_xor(send, half); } }
            {
                const int L = F.lane, rowb = L & ~15, quadb = L & ~3;
                const float score = 1.0f / (1.0f + __expf(-ac[0])), selv = score + rbl;
                const float a = __shfl(selv, quadb), bb = __shfl(selv, quadb + 1), cc = __shfl(selv, quadb + 2), d = __shfl(selv, quadb + 3);
                const float hi1 = fmaxf(a, bb), lo1 = fminf(a, bb), hi2 = fmaxf(cc, d), lo2 = fminf(cc, d);
                const float gsq = fmaxf(hi1, hi2) + fmaxf(fminf(hi1, hi2), fmaxf(lo1, lo2));
                float gs[4];
#pragma unroll
                for (int g = 0; g < 4; ++g) gs[g] = __shfl(gsq, rowb + 4 * g);
                int best = 0; float bv = gs[0];
#pragma unroll
                for (int g = 1; g < 4; ++g) if (gs[g] > bv) { bv = gs[g]; best = g; }
                float s4[4], c4[4];
#pragma unroll
                for (int k = 0; k < 4; ++k) { s4[k] = __shfl(selv, rowb + 4 * best + k); c4[k] = __shfl(score, rowb + 4 * best + k); }
                int i1 = 0; float v1 = s4[0];
#pragma unroll
                for (int k = 1; k < 4; ++k) if (s4[k] > v1) { v1 = s4[k]; i1 = k; }
                int i2 = -1; float v2 = -INFINITY;
#pragma unroll
                for (int k = 0; k < 4; ++k) if (k != i1 && s4[k] > v2) { v2 = s4[k]; i2 = k; }
                if (i2 < 0) i2 = (i1 + 1) & 3;
                const float t1 = i1 == 0 ? c4[0] : i1 == 1 ? c4[1] : i1 == 2 ? c4[2] : c4[3];
                const float t2 = i2 == 0 ? c4[0] : i2 == 1 ? c4[1] : i2 == 2 ? c4[2] : c4[3];
                const float inv = 1.0f / (t1 + t2);
                if ((L & 15) == 0 && !dry) {
                    const int rl = F.wave * 16 + it * 4 + (L >> 4), e1 = 4 * best + i1, e2 = 4 * best + i2;
                    const int p1 = atomicAdd((int*)(lcnt + e1), 1), p2 = atomicAdd((int*)(lcnt + e2), 1);
                    st_e[2 * rl] = e1 | (p1 << 8); st_g[2 * rl] = t1 * inv; st_e[2 * rl + 1] = e2 | (p2 << 8); st_g[2 * rl + 1] = t2 * inv;
                }
            }
        }
        __syncthreads();
        if (F.tid < 16 && !dry) gbase[F.tid] = (int)__hip_atomic_fetch_add(gcnt + F.tid, (unsigned)lcnt[F.tid], __ATOMIC_RELAXED, __HIP_MEMORY_SCOPE_AGENT);
        __syncthreads();
        if (F.tid < 256 && !dry) { const int ee = st_e[F.tid], e = ee & 255, lp = ee >> 8, pos = gbase[e] + lp;
            rowlist[(size_t)e * CAP + pos] = ((blk * 128 + (F.tid >> 1)) << 1) | (F.tid & 1); gatew[(size_t)e * CAP + pos] = st_g[F.tid]; }
    }
    __syncthreads();
}
template <bool XF32> struct Ln2Raw { typename std::conditional<XF32, f32x4, u32x2g>::type x[2][4]; unsigned ya[2][4], yb[2][4], gm[2][4]; float st[2][2]; };
template <bool XF32, bool OUTF32>
__device__ __forceinline__ void phase_ln2(Frame& F0, const float* xb, const pg8::bf16_t* gmix, const pg8::bf16_t* y2, const float* stats, const float* ln1_g, const float* ln1_b, const float* ln_g, const float* ln_b, const float* modl, const float* modn, pg8::bf16_t* H, float* xdst) {
    Frame F = F0;
    LAS float* const PRM = (LAS float*)(F.lds + RING_OFF);
    for (int blk = F.vcu; blk < T_TOK / 128; blk += F.G) {
        const int b = blk >> 4; const float* mb = modl + (size_t)b * 6144 + 5 * 1024;
        __syncthreads();
        { const int c4 = F.tid & 255;
          if (F.tid < 256) { *(LAS f32x4*)(PRM + 0 * 1024 + 4 * c4) = *(const f32x4*)(ln1_g + 4 * c4); *(LAS f32x4*)(PRM + 1 * 1024 + 4 * c4) = *(const f32x4*)(ln1_b + 4 * c4);
                             *(LAS f32x4*)(PRM + 2 * 1024 + 4 * c4) = *(const f32x4*)(mb + 4 * c4);    *(LAS f32x4*)(PRM + 3 * 1024 + 4 * c4) = *(const f32x4*)(ln_g + 4 * c4); }
          else { *(LAS f32x4*)(PRM + 4 * 1024 + 4 * c4) = *(const f32x4*)(ln_b + 4 * c4);
                 if (modn) { const float* mn = modn + (size_t)b * 6144; *(LAS f32x4*)(PRM + 5 * 1024 + 4 * c4) = *(const f32x4*)(mn + 1024 + 4 * c4) + 1.0f; *(LAS f32x4*)(PRM + 6 * 1024 + 4 * c4) = *(const f32x4*)(mn + 4 * c4); } } }
        __syncthreads();
#define LN2_PRM(a, j) (*(const LAS f32x4*)(PRM + (a) * 1024 + 4 * F.lane + 256 * (j)))
        const int rowb = blk * 128 + F.wave * 16;
        auto load2 = [&](Ln2Raw<XF32>& R, const int row0) __attribute__((always_inline)) {
#pragma unroll
            for (int q = 0; q < 2; ++q) { R.st[q][0] = stats[2 * (size_t)(row0 + q)]; R.st[q][1] = stats[2 * (size_t)(row0 + q) + 1]; }
#pragma unroll
            for (int q = 0; q < 2; ++q) {
                if constexpr (XF32) { const GAS f32x4* xr = (const GAS f32x4*)(xb + (size_t)(row0 + q) * DM) + F.lane;
#pragma unroll
                    for (int j = 0; j < 4; ++j) R.x[q][j] = xr[64 * j]; }
                else { const GAS u32x2g* xr = (const GAS u32x2g*)((const pg8::bf16_t*)xb + (size_t)(row0 + q) * DM) + F.lane;
#pragma unroll
                    for (int j = 0; j < 4; ++j) R.x[q][j] = xr[64 * j]; }
                const GAS unsigned* pa = (const GAS unsigned*)((const unsigned char*)y2 + (size_t)(row0 + q) * DM) + F.lane; const GAS unsigned* pb = (const GAS unsigned*)((const unsigned char*)y2 + ((size_t)T_TOK + row0 + q) * DM) + F.lane;
                const GAS unsigned* gr = (const GAS unsigned*)((const unsigned char*)gmix + (size_t)(row0 + q) * DM) + F.lane;
#pragma unroll
                for (int j = 0; j < 4; ++j) { R.ya[q][j] = pa[64 * j]; R.yb[q][j] = pb[64 * j]; R.gm[q][j] = gr[64 * j]; } } };
        auto norm2 = [&](const Ln2Raw<XF32>& R, const int row0) __attribute__((always_inline)) {
            f32x4 v[2][4];
#pragma unroll
            for (int j = 0; j < 4; ++j) { asm volatile("" ::: "memory"); const f32x4 l1g = LN2_PRM(0, j), l1b = LN2_PRM(1, j), g2 = LN2_PRM(2, j);
#pragma unroll
                for (int q = 0; q < 2; ++q) { const unsigned a = R.ya[q][j], c = R.yb[q][j];
                    typedef float f32x2v __attribute__((ext_vector_type(2)));
                    const f32x2v a0 = __builtin_amdgcn_cvt_pk_f32_fp8(a, false), a1 = __builtin_amdgcn_cvt_pk_f32_fp8(a, true), c0 = __builtin_amdgcn_cvt_pk_f32_fp8(c, false), c1 = __builtin_amdgcn_cvt_pk_f32_fp8(c, true);
                    f32x4 ff; ff.x = (a0[0] + c0[0]) * Y2_DESCALE; ff.y = (a0[1] + c0[1]) * Y2_DESCALE; ff.z = (a1[0] + c1[0]) * Y2_DESCALE; ff.w = (a1[1] + c1[1]) * Y2_DESCALE;
                    const f32x2v gg0 = __builtin_amdgcn_cvt_pk_f32_fp8(R.gm[q][j], false), gg1 = __builtin_amdgcn_cvt_pk_f32_fp8(R.gm[q][j], true);
                    f32x4 g4; g4.x = gg0[0] * GMIX_DESCALE; g4.y = gg0[1] * GMIX_DESCALE; g4.z = gg1[0] * GMIX_DESCALE; g4.w = gg1[1] * GMIX_DESCALE;
                    f32x4 xq;
                    if constexpr (XF32) xq = R.x[q][j];
                    else { const u32x2g w = R.x[q][j]; xq.x = __uint_as_float(w.x << 16); xq.y = __uint_as_float(w.x & 0xffff0000u); xq.z = __uint_as_float(w.y << 16); xq.w = __uint_as_float(w.y & 0xffff0000u); }
                    const f32x4 y1 = xq * DN_ALPHA + g4;
                    const f32x4 x1 = (y1 - R.st[q][0]) * R.st[q][1] * l1g + l1b;
                    v[q][j] = x1 * DN_ALPHA + g2 * ff; } }
            float mean[2], rstd[2];
#pragma unroll
            for (int q = 0; q < 2; ++q) row_stats(v[q], mean[q], rstd[q]);
#pragma unroll
            for (int j = 0; j < 4; ++j) { asm volatile("" ::: "memory"); const f32x4 lg = LN2_PRM(3, j), lb = LN2_PRM(4, j);
#pragma unroll
                for (int q = 0; q < 2; ++q) v[q][j] = (v[q][j] - mean[q]) * rstd[q] * lg + lb; }
#pragma unroll
            for (int q = 0; q < 2; ++q) { const int row = row0 + q;
                if constexpr (OUTF32) { GAS f32x4* xr = (GAS f32x4*)(xdst + (size_t)row * DM) + F.lane;
#pragma unroll
                    for (int j = 0; j < 4; ++j) xr[64 * j] = v[q][j]; }
                else store_row_bf16((pg8::bf16_t*)xdst + (size_t)row * DM, F.lane, v[q]); }
            if (modn) {
#pragma unroll
                for (int q = 0; q < 2; ++q) row_stats(v[q], mean[q], rstd[q]);
#pragma unroll
                for (int j = 0; j < 4; ++j) { asm volatile("" ::: "memory"); const f32x4 s4 = LN2_PRM(5, j), h4 = LN2_PRM(6, j);
#pragma unroll
                    for (int q = 0; q < 2; ++q) v[q][j] = (v[q][j] - mean[q]) * rstd[q] * s4 + h4; }
#pragma unroll
                for (int q = 0; q < 2; ++q) store_row_fp8((unsigned char*)H + (size_t)(row0 + q) * DM, F.lane, v[q]);
            } };
        Ln2Raw<XF32> RA, RB;
        load2(RA, rowb);
#pragma nounroll
        for (int k = 0; k < 16; k += 4) {
            load2(RB, rowb + k + 2);
            norm2(RA, rowb + k);
            if (k + 4 < 16) load2(RA, rowb + k + 4);
            norm2(RB, rowb + k + 2);
        }
#undef LN2_PRM
    }
    __syncthreads();
}
__device__ __forceinline__ void phase_combine(Frame& F0, const pg8::bf16_t* OD, const float* LSE, pg8::bf16_t* OUTB, gu32* pcnt) {
    Frame F = F0;
    const int hh = F.lane >> 4, d4 = (F.lane & 15) * 4;
    for (int blk = F.vcu; blk < T_TOK / 128; blk += F.G) {
        const int b = blk >> 4;
        for (int k = 0; k < 16; k += 8) {
            unsigned ov[8][3]; float ls[8][3];
#pragma unroll
            for (int q = 0; q < 8; ++q) { const int s = (blk & 15) * 128 + F.wave * 16 + k + q;
#pragma unroll
                for (int g = 0; g < 3; ++g) { const size_t rg = (size_t)(b * 12 + g * 4 + hh) * SEQ + pg8::pg_perm(g, s);
                    ls[q][g] = LSE[rg]; ov[q][g] = *(const GAS unsigned*)((const unsigned char*)OD + rg * 64 + d4); } }
#pragma unroll
            for (int q = 0; q < 8; ++q) { const int s = (blk & 15) * 128 + F.wave * 16 + k + q;
                const float m = fmaxf(fmaxf(ls[q][0], ls[q][1]), ls[q][2]);
                const float w0 = __builtin_amdgcn_exp2f(ls[q][0] - m), w1 = __builtin_amdgcn_exp2f(ls[q][1] - m), w2 = __builtin_amdgcn_exp2f(ls[q][2] - m), inv = 1.0f / (w0 + w1 + w2);
                float o[4];
                { typedef float f32x2v __attribute__((ext_vector_type(2)));
                  const f32x2v a0 = __builtin_amdgcn_cvt_pk_f32_fp8(ov[q][0], false), a1 = __builtin_amdgcn_cvt_pk_f32_fp8(ov[q][0], true), b0 = __builtin_amdgcn_cvt_pk_f32_fp8(ov[q][1], false), b1 = __builtin_amdgcn_cvt_pk_f32_fp8(ov[q][1], true),
                              c0 = __builtin_amdgcn_cvt_pk_f32_fp8(ov[q][2], false), c1 = __builtin_amdgcn_cvt_pk_f32_fp8(ov[q][2], true);
                  const float is_ = inv * (1.0f / attn_body::OUT_SCALE);
                  o[0] = (w0 * a0[0] + w1 * b0[0] + w2 * c0[0]) * is_; o[1] = (w0 * a0[1] + w1 * b0[1] + w2 * c0[1]) * is_;
                  o[2] = (w0 * a1[0] + w1 * b1[0] + w2 * c1[0]) * is_; o[3] = (w0 * a1[1] + w1 * b1[1] + w2 * c1[1]) * is_; }
                __hip_atomic_store((GAS unsigned*)((unsigned char*)OUTB + ((size_t)b * SEQ + s) * 768 + 512 + hh * 64 + d4), pk4_fp8(sat8(o[0] * PAB_ASCALE), sat8(o[1] * PAB_ASCALE), sat8(o[2] * PAB_ASCALE), sat8(o[3] * PAB_ASCALE)), __ATOMIC_RELAXED, __HIP_MEMORY_SCOPE_AGENT); }
        }
        VM_WAIT();
        if (F.lane == 0) (void)__hip_atomic_fetch_add(pcnt + 16 * (blk >> 1), 1u, __ATOMIC_RELAXED, __HIP_MEMORY_SCOPE_AGENT);
    }
}
__device__ __forceinline__ void moe_table(Frame& F, gu32* gcnt) {
    LAS int* tab = (LAS int*)(F.lds + MOETAB_OFF);
    __syncthreads();
    if (F.wave == 0) {
        const int ln = hw_lane(); int c = 0;
        if (ln < 16) { c = (int)__hip_atomic_load(gcnt + ln, __ATOMIC_RELAXED, __HIP_MEMORY_SCOPE_AGENT); if (c > CAP) c = CAP; if (c < 0) c = 0; }
        const int tiles = (c + 255) >> 8; int inc = tiles;
#pragma unroll
        for (int o = 1; o < 16; o <<= 1) { const int t = __shfl_up(inc, o); if (ln >= o) inc += t; }
        if (ln < 16) { tab[ln] = c; tab[16 + ln] = inc - tiles; }
        if (ln == 15) tab[32] = inc; }
    __syncthreads();
}
struct Args { const float* in[19]; float* out; unsigned char* ws; int ph_lo, ph_hi; };
typedef const __attribute__((address_space(4))) Args* KArgs;
__device__ __forceinline__ Weights layer_weights(KArgs ap_, int l) {
    struct { const float* in[19]; } a; a.in[4] = ap_->in[4]; a.in[7] = ap_->in[7]; a.in[8] = ap_->in[8]; a.in[9] = ap_->in[9]; a.in[14] = ap_->in[14]; a.in[15] = ap_->in[15]; a.in[16] = ap_->in[16];
    Weights W; W.w_in = a.in[4] + (size_t)l * 1024 * N_IN; W.w_pa = a.in[7] + (size_t)l * 512 * 1024; W.w_pb = a.in[8] + (size_t)l * 256 * 1024; W.w_o = a.in[9] + (size_t)l * 1024 * 1024;
    W.w_g = a.in[14] + (size_t)l * 16 * 1024 * 256; W.w_u = a.in[15] + (size_t)l * 16 * 1024 * 256; W.w_d = a.in[16] + (size_t)l * 16 * 256 * 1024; return W;
}
#ifndef SKIPMASK
#define SKIPMASK 0
#endif
#define IN(k) (lo <= (k) && (k) < hi)
#define SEAM(k) do { if (IN(k) && IN((k) + 1)) { XcdBarrier b2_ = bar; asm volatile("" : "+s"(b2_.x), "+s"(b2_.bar)); int w0_ = F.wave; asm volatile("" : "+s"(w0_)); REPS(20) xcd_barrier(b2_, w0_ == 0 && hw_lane() == 0); } } while (0)
#ifndef PROBE_DUP
#define PROBE_DUP -1
#endif
#define REPS(k) _Pragma("unroll") for (int rep_ = 0; rep_ < ((PROBE_DUP) == (k) ? 2 : 1); ++rep_)
#define PHASE_ARGS KArgs ap = kargs; int bx_ = (int)blockIdx.x; Frame FF = F; asm volatile("" : "+s"(ap), "+s"(bx_), "+s"(FF.G), "+s"(FF.vcu), "+s"(FF.wave)); FF.lane = hw_lane(); FF.tid = FF.wave * 64 + FF.lane; unsigned char* const ws = ap->ws; (void)ws; (void)bx_
template <int l>
__device__ __forceinline__ void layer_phases(Frame& F, const KArgs kargs, const int lo, const int hi, const XcdBarrier& bar, unsigned char* lds) {
    using pg8::bf16_t;
    const LAS int* tab = (const LAS int*)(F.lds + MOETAB_OFF);
    {
        const int P = 2 + PPL * l;
        if (IN(P + 0)) {
            PHASE_ARGS;
            pg8::Gemm g{(const bf16_t*)(ws + WS_H), (const bf16_t*)(ws + WS_WIN), T_TOK, N_IN, 1024}; pg8::StaticOrder S; S.init(T_TOK, N_IN, FF.G, bx_); S.rot = 12;
            pg8::EpiIn E{(bf16_t*)(ws + WS_QA), (bf16_t*)(ws + WS_KA), (bf16_t*)(ws + WS_VA), (bf16_t*)(ws + WS_QD), (bf16_t*)(ws + WS_KD), (bf16_t*)(ws + WS_VDT), (bf16_t*)(ws + WS_G),
                         ap->in[5] + l * 64, ap->in[6] + l * 64, (const float*)(ws + WS_ROPE)};
#ifdef IN_STAGGER
            { const unsigned long long t0_ = __builtin_amdgcn_s_memrealtime(), dl_ = (unsigned long long)(FF.vcu & 3) * IN_STAGGER;
              while (__builtin_amdgcn_s_memrealtime() - t0_ < dl_) __builtin_amdgcn_s_sleep(8); }
#endif
            REPS(0) { pg8::gemm_phase<pg8::EpiIn, pg8::StaticOrder, true, false, true>(F.lds + RING_OFF, g, S, E, FF.wave);
#ifdef PROBE_BAR
              if (rep_ == 0) { XcdBarrier b3_ = bar; asm volatile("" : "+s"(b3_.x), "+s"(b3_.bar)); xcd_barrier(b3_, FF.wave == 0 && hw_lane() == 0); }
#endif
            }
            SEAM(P + 0);
        }
        if (IN(P + 1)) {
            PHASE_ARGS;
            { const attn_body::AttnTensors BT{(const attn_body::bf16*)(ws + WS_QD), (const attn_body::bf16*)(ws + WS_KD), (const attn_body::bf16*)(ws + WS_VDT), (attn_body::bf16*)(ws + WS_QD), ws + WS_H + 24 * MiB};
              const attn_body::OrderB S{FF.vcu, FF.G, BT, (float*)(ws + WS_LSE)};
              attn_body::attn_phase<attn_body::CfgB, attn_body::OrderB>((char*)lds + RING_OFF, S, FF.wave); }
            { const attn_body::AttnTensors AT{(const attn_body::bf16*)(ws + WS_QA), (const attn_body::bf16*)(ws + WS_KA), (const attn_body::bf16*)(ws + WS_VA), (attn_body::bf16*)(ws + WS_QA), ws + WS_H};
              const attn_body::OrderA S{FF.vcu, FF.G, AT};
              attn_body::attn_phase<attn_body::CfgA, attn_body::OrderA>((char*)lds + RING_OFF, S, FF.wave); }
            SEAM(P + 1);
        }
        if (IN(P + 2)) {
            PHASE_ARGS;
            gu32* const pcnt = F.ctl + CW_PANEL + 2048 * l;
            phase_combine(FF, (const bf16_t*)(ws + WS_H + 24 * MiB), (const float*)(ws + WS_LSE), (bf16_t*)(ws + WS_H), pcnt);
            { pg8::StaticOrder S; S.init(T_TOK, 1024, FF.G, bx_);
              if (FF.wave == 0) {
                  pg8::Unit u; unsigned sp = 0;
                  for (int i = 0; S.next(i, u); ++i)
                      while (__builtin_amdgcn_readfirstlane((int)__hip_atomic_load(pcnt + 16 * u.pm, __ATOMIC_RELAXED, __HIP_MEMORY_SCOPE_AGENT)) < 16) { __builtin_amdgcn_s_sleep(2); if (++sp > (1u << 22)) break; } }
              VM_WAIT(); __builtin_amdgcn_fence(__ATOMIC_ACQUIRE, "agent"); VM_WAIT(); __syncthreads();
              pg8::Gemm g{(const bf16_t*)(ws + WS_H), (const bf16_t*)(ws + WS_WPA), T_TOK, 1024, 768};
              pg8::EpiMergeF E{(const bf16_t*)(ws + WS_G), (bf16_t*)(ws + WS_MERGED)};
              pg8::gemm_phase<pg8::EpiMergeF, pg8::StaticOrder, true, false, true, true>(F.lds + RING_OFF, g, S, E, FF.wave); }
            SEAM(P + 2);
        }
        if (IN(P + 4)) {
            PHASE_ARGS;
            pg8::Gemm g{(const bf16_t*)(ws + WS_MERGED), (const bf16_t*)(ws + WS_WO), T_TOK, 1024, 1024}; pg8::StaticOrder S; S.init(T_TOK, 1024, FF.G, bx_);
            REPS(3) { pg8::EpiRes E{(bf16_t*)(ws + WS_GMIX), (const float*)(ws + WS_MOD) + (size_t)l * 16 * 6144 + 2 * 1024};
            pg8::gemm_phase<pg8::EpiRes, pg8::StaticOrder, true, false, true>(F.lds + RING_OFF, g, S, E, FF.wave); }
            SEAM(P + 4);
        }
        if (IN(P + 5)) {
            PHASE_ARGS;
            if ((PROBE_DUP) == 40) { phase_ln1<l == 0>(FF, l == 0 ? ap->in[0] : (const float*)(ws + WS_XS), (const bf16_t*)(ws + WS_GMIX), ap->in[10] + l * 1024, ap->in[11] + l * 1024, (const float*)(ws + WS_MOD) + (size_t)l * 16 * 6144, ap->in[12], ap->in[13], (bf16_t*)(ws + WS_QD),
                      (int*)(ws + WS_ROWLIST), (float*)(ws + WS_GATEW), F.ctl + CW_GCNT + 64 * l, (float*)(ws + WS_LSE), true); VM_WAIT(); __syncthreads(); }
            phase_ln1<l == 0>(FF, l == 0 ? ap->in[0] : (const float*)(ws + WS_XS), (const bf16_t*)(ws + WS_GMIX), ap->in[10] + l * 1024, ap->in[11] + l * 1024, (const float*)(ws + WS_MOD) + (size_t)l * 16 * 6144, ap->in[12], ap->in[13], (bf16_t*)(ws + WS_H),
                      (int*)(ws + WS_ROWLIST), (float*)(ws + WS_GATEW), F.ctl + CW_GCNT + 64 * l, (float*)(ws + WS_STATS));
            SEAM(P + 5);
        }
        if (IN(P + 6)) {
            PHASE_ARGS;
            moe_table(FF, F.ctl + CW_GCNT + 64 * l);
            pg8::Gemm g{(const bf16_t*)(ws + WS_H), (const bf16_t*)(ws + WS_WGU), T_TOK, 512, 1024};
            pg8::MoeOrder<true> S{tab, (const int*)(ws + WS_ROWLIST), 2, FF.G, bx_};
            pg8::EpiGU E{(bf16_t*)(ws + WS_ACT), (const float*)(ws + WS_GATEW), tab};
            REPS(5) pg8::gemm_phase<pg8::EpiGU, pg8::MoeOrder<true>, true, true, true>(F.lds + RING_OFF, g, S, E, FF.wave);
            SEAM(P + 6);
        }
        if (IN(P + 7)) {
            PHASE_ARGS;
            moe_table(FF, F.ctl + CW_GCNT + 64 * l);
            pg8::Gemm g{(const bf16_t*)(ws + WS_ACT), (const bf16_t*)(ws + WS_WDN), T_TOK, 1024, 256};
            pg8::MoeOrder<false> S{tab, (const int*)(ws + WS_ROWLIST), 4, FF.G, bx_};
            pg8::EpiDown E{(bf16_t*)(ws + WS_Y2), (const int*)(ws + WS_ROWLIST), tab};
            REPS(6) { pg8::gemm_phase<pg8::EpiDown, pg8::MoeOrder<false>, true, false, true>(F.lds + RING_OFF, g, S, E, FF.wave); VM_WAIT(); __syncthreads(); }
            SEAM(P + 7);
        }
        if (IN(P + 8)) {
            PHASE_ARGS;
            const float* modl = (const float*)(ws + WS_MOD) + (size_t)l * 16 * 6144;
            if ((PROBE_DUP) == 41) { phase_ln2<l == 0, true>(FF, l == 0 ? ap->in[0] : (const float*)(ws + WS_XS), (const bf16_t*)(ws + WS_GMIX), (const bf16_t*)(ws + WS_Y2), (const float*)(ws + WS_STATS), ap->in[10] + l * 1024, ap->in[11] + l * 1024, ap->in[17] + l * 1024, ap->in[18] + l * 1024, modl, l + 1 < DEPTH ? modl + 16 * 6144 : nullptr, (bf16_t*)(ws + WS_OUTB), (float*)(ws + WS_QA)); VM_WAIT(); __syncthreads(); }
            phase_ln2<l == 0, l + 1 == DEPTH>(FF, l == 0 ? ap->in[0] : (const float*)(ws + WS_XS), (const bf16_t*)(ws + WS_GMIX), (const bf16_t*)(ws + WS_Y2), (const float*)(ws + WS_STATS), ap->in[10] + l * 1024, ap->in[11] + l * 1024, ap->in[17] + l * 1024, ap->in[18] + l * 1024, modl, l + 1 < DEPTH ? modl + 16 * 6144 : nullptr, (bf16_t*)(ws + WS_H), l + 1 == DEPTH ? ap->out : (float*)(ws + WS_XS));
            if (l + 1 < DEPTH) { __syncthreads(); const Weights Wn = layer_weights(ap, l + 1); REPS(7) convert_layer(FF, Wn, ws); }
            SEAM(P + 8);
        }
    }
}
__global__ void __launch_bounds__(NWAVES * 64, 2) fwd_kernel(Args args_unused) {
    extern __shared__ __attribute__((aligned(16))) unsigned char lds[];
    Frame F;
    F.lds = (LAS unsigned char*)lds;
    F.MISC = (volatile LAS unsigned*)(F.lds + MISC_OFF);
    F.wave = __builtin_amdgcn_readfirstlane((int)threadIdx.x >> 6); F.lane = hw_lane(); F.tid = F.wave * 64 + F.lane;
    F.G = gridDim.x; { const int bx = blockIdx.x; F.vcu = (F.G % 8 == 0) ? (bx % 8) * (F.G / 8) + bx / 8 : bx; }
    const KArgs kargs = (KArgs)__builtin_amdgcn_kernarg_segment_ptr();
    F.ctl = (gu32*)(kargs->ws + WS_CTL);
    for (int u = F.tid; u < (LDS_BYTES - LDSCTL_OFF) / 4; u += NWAVES * 64) ((LAS unsigned*)(F.lds + LDSCTL_OFF))[u] = 0u;
    __syncthreads();
    const int lo = kargs->ph_lo, hi = kargs->ph_hi;
    XcdBarrier bar; bar.bar = (unsigned*)(F.ctl + CW_BAR); bar.x = 0; bar.st = nullptr;
    if (hi - lo > 1) bar = xcd_barrier_post((unsigned*)(F.ctl + CW_BAR), F.MISC + 8);
    using pg8::bf16_t;
    const LAS int* tab = (const LAS int*)(F.lds + MOETAB_OFF);

    if (IN(0)) { PHASE_ARGS; const Weights W0 = layer_weights(ap, 0); REPS(30) { phase_pr0(FF, ap->in[1], ap->in[2], ap->in[3], (float*)(ws + WS_MOD), (float*)(ws + WS_ROPE), W0, ws); VM_WAIT(); __syncthreads(); } SEAM(0); }
    if (IN(1)) { PHASE_ARGS; REPS(31) phase_pr1(FF, ap->in[0], (const float*)(ws + WS_MOD), (bf16_t*)(ws + WS_H)); SEAM(1); }

    layer_phases<0>(F, kargs, lo, hi, bar, lds); layer_phases<1>(F, kargs, lo, hi, bar, lds); layer_phases<2>(F, kargs, lo, hi, bar, lds); layer_phases<3>(F, kargs, lo, hi, bar, lds);
#undef IN
#undef SEAM
#undef PHASE_ARGS
}

extern "C" void kernel_launch(void* const* d_in, const int* in_sizes, int n_in, void* d_out, int out_size, void* d_ws, size_t ws_size, hipStream_t stream) {
    static int grid = 0;
    if (grid == 0) {
        if (n_in != 19 || in_sizes[0] != T_TOK * DM || out_size != T_TOK * DM || ws_size < WS_END) { fprintf(stderr, "kernel_launch: unexpected shapes/workspace (n_in %d, ws %zu); nothing launched\n", n_in, ws_size); grid = -1; return; }
        int dev = 0, cus = 0, per_cu = 0;
        if (hipGetDevice(&dev) != hipSuccess || hipDeviceGetAttribute(&cus, hipDeviceAttributeMultiprocessorCount, dev) != hipSuccess) { grid = -1; return; }
        if (hipFuncSetAttribute((const void*)fwd_kernel, hipFuncAttributeMaxDynamicSharedMemorySize, LDS_BYTES) != hipSuccess) { fprintf(stderr, "kernel_launch: hipFuncSetAttribute failed\n"); grid = -1; return; }
        if (hipOccupancyMaxActiveBlocksPerMultiprocessor(&per_cu, (const void*)fwd_kernel, NWAVES * 64, LDS_BYTES) != hipSuccess || per_cu < 1) { fprintf(stderr, "kernel_launch: occupancy query reports %d\n", per_cu); }
        (void)hipGetLastError();
        grid = cus;
    }
    if (grid < 0) return;
    if (hipMemsetAsync((char*)d_ws + WS_CTL, 0, CTL_ZERO_BYTES, stream) != hipSuccess) return;
    Args a{};
    for (int i = 0; i < 19; ++i) a.in[i] = (const float*)d_in[i];
    a.out = (float*)d_out; a.ws = (unsigned char*)d_ws;
#if MK_N_LAUNCHES == 1
    a.ph_lo = 0; a.ph_hi = N_PHASES;
    hipLaunchKernelGGL(fwd_kernel, dim3(grid), dim3(NWAVES * 64), LDS_BYTES, stream, a);
#else
    for (int p = 0; p < N_PHASES; ++p) { a.ph_lo = p; a.ph_hi = p + 1; hipLaunchKernelGGL(fwd_kernel, dim3(grid), dim3(NWAVES * 64), LDS_BYTES, stream, a); }
#endif
}
```
